# Optimizing an MI355X kernel written in HIP

```python
import jax, jax.numpy as jnp
from jax import lax
import numpy as np

D_MODEL = 1024
BATCH = 8
SEQ = 4096
DEPTH = 4

MIX_WIDTH = D_MODEL
RWKV_WIDTH = MIX_WIDTH // 2
RWKV_HEAD = 64
RWKV_HEADS = RWKV_WIDTH // RWKV_HEAD
DECAY_LORA = 64
ICLR_LORA = 64
VMIX_LORA = 32
MLA_WIDTH = MIX_WIDTH - RWKV_WIDTH
MLA_V_HEAD = 64
MLA_HEADS = MLA_WIDTH // MLA_V_HEAD
MLA_NOPE = 64
MLA_ROPE = 32
Q_LORA = 384
KV_LORA = 256
ROPE_THETA = 10000.0
Q_BLOCK = 128
NORM_EPS = 1e-6
GN_EPS = 64e-5

SHIFT_WIDTH = 3 * RWKV_WIDTH + DECAY_LORA + ICLR_LORA
O_GR = SHIFT_WIDTH
O_CQ = O_GR + RWKV_WIDTH
O_CKV = O_CQ + Q_LORA
O_KR = O_CKV + KV_LORA
O_GM = O_KR + MLA_ROPE
IN_WIDTH = O_GM + MLA_WIDTH

kernel_name = 'hymba_rwkv7_mla_adaln_block'


def rms_norm(x, g, eps=NORM_EPS):
    xf = x.astype(jnp.float32)
    y = xf * lax.rsqrt(jnp.mean(xf * xf, axis=-1, keepdims=True) + eps)
    return (y * g.astype(jnp.float32)).astype(x.dtype)


def token_shift_lerp(p, mu):
    prev = jnp.pad(p[:, :-1], ((0, 0), (1, 0), (0, 0)))
    return p + (prev - p) * mu


def rope_tables(positions):
    inv = ROPE_THETA ** (-jnp.arange(0, MLA_ROPE, 2, dtype=jnp.float32) / MLA_ROPE)
    ang = positions.astype(jnp.float32)[..., None] * inv
    ang = jnp.concatenate([ang, ang], axis=-1)
    return jnp.cos(ang), jnp.sin(ang)


def apply_rope(x, cos, sin):
    x1, x2 = jnp.split(x, 2, axis=-1)
    rot = jnp.concatenate([-x2, x1], axis=-1)
    return (x.astype(jnp.float32) * cos + rot.astype(jnp.float32) * sin).astype(x.dtype)


def rwkv7_scan(r, w, k, v, kk, a):
    B, S, H, N = r.shape

    def step(state, inp):
        r_t, w_t, k_t, v_t, kk_t, a_t = inp
        sa = jnp.einsum('bhvk,bhk->bhv', state, kk_t)
        state = (state * w_t[:, :, None, :]
                 - sa[..., None] * (kk_t * a_t)[:, :, None, :]
                 + v_t[..., None] * k_t[:, :, None, :])
        y = jnp.einsum('bhvk,bhk->bhv', state, r_t)
        return state, y

    xs = tuple(jnp.moveaxis(t, 1, 0) for t in (r, w, k, v, kk, a))
    s0 = jnp.zeros((B, H, N, N), jnp.float32)
    _, ys = lax.scan(step, s0, xs)
    return jnp.moveaxis(ys, 0, 1)


def group_norm_heads(y, w, b):
    mean = jnp.mean(y, axis=-1, keepdims=True)
    var = jnp.mean(jnp.square(y - mean), axis=-1, keepdims=True)
    yn = (y - mean) * lax.rsqrt(var + GN_EPS)
    return (yn * w.reshape(RWKV_HEADS, RWKV_HEAD).astype(jnp.float32)
            + b.reshape(RWKV_HEADS, RWKV_HEAD).astype(jnp.float32))


def rwkv7_time_mix(p, p_vmix, v_first, mu, mu_v, w0, w_dec_up, a0, w_icl_up, v0, w_vmix_up,
                   k_k, k_a, r_k, lnx_w, lnx_b):
    B, S, _ = p.shape
    H, N = RWKV_HEADS, RWKV_HEAD
    ps = token_shift_lerp(p, mu)
    r, k, v, w_lo, a_lo = jnp.split(
        ps, [RWKV_WIDTH, 2 * RWKV_WIDTH, 3 * RWKV_WIDTH, 3 * RWKV_WIDTH + DECAY_LORA], axis=-1)
    w_log = -jax.nn.softplus(-(w0 + jnp.tanh(w_lo) @ w_dec_up)) - 0.5
    decay = jnp.exp(-jnp.exp(w_log.astype(jnp.float32)))
    a = jax.nn.sigmoid(a0 + a_lo @ w_icl_up)
    if v_first is None:
        v_first = v
    else:
        v_lo = token_shift_lerp(p_vmix, mu_v)
        v = v + (v_first - v) * jax.nn.sigmoid(v0 + v_lo @ w_vmix_up)

    def heads(t):
        return t.reshape(B, S, H, N).astype(jnp.float32)

    kk = heads(k * k_k)
    kk = kk / jnp.maximum(jnp.sqrt(jnp.sum(kk * kk, axis=-1, keepdims=True)), 1e-12)
    k = k * (1 + (a - 1) * k_a)
    rh, kh, vh, ah = heads(r), heads(k), heads(v), heads(a)
    y = rwkv7_scan(rh, heads(decay), kh, vh, kk, ah)
    y = group_norm_heads(y, lnx_w, lnx_b)
    y = y + jnp.sum(rh * kh * r_k.astype(jnp.float32), axis=-1, keepdims=True) * vh
    return y.reshape(B, S, RWKV_WIDTH).astype(p.dtype), v_first


def causal_block_attention(q_nope, q_rope, k_nope, k_rope, v):
    B, S, H, _ = q_nope.shape
    nb = S // Q_BLOCK
    scale = (MLA_NOPE + MLA_ROPE) ** -0.5
    qn = q_nope.reshape(B, nb, Q_BLOCK, H, MLA_NOPE).transpose(1, 0, 2, 3, 4)
    qr = q_rope.reshape(B, nb, Q_BLOCK, H, MLA_ROPE).transpose(1, 0, 2, 3, 4)
    key_idx = jnp.arange(S)

    def block(args):
        qn_b, qr_b, start = args
        s = (jnp.einsum('bqhd,bkhd->bhqk', qn_b, k_nope)
             + jnp.einsum('bqhd,bkd->bhqk', qr_b, k_rope)).astype(jnp.float32) * scale
        q_idx = start + jnp.arange(Q_BLOCK)
        s = jnp.where(key_idx[None, :] <= q_idx[:, None], s, -jnp.inf)
        prob = jax.nn.softmax(s, axis=-1).astype(v.dtype)
        return jnp.einsum('bhqk,bkhd->bqhd', prob, v)

    starts = jnp.arange(nb) * Q_BLOCK
    out = lax.map(block, (qn, qr, starts))
    return out.transpose(1, 0, 2, 3, 4).reshape(B, S, H, MLA_V_HEAD)


def mla_branch(c_q, c_kv, k_rope_in, cos, sin, q_norm_g, kv_norm_g, w_uq, w_ukv):
    B, S, _ = c_q.shape
    H = MLA_HEADS
    q = (rms_norm(c_q, q_norm_g) @ w_uq).reshape(B, S, H, MLA_NOPE + MLA_ROPE)
    q_nope = q[..., :MLA_NOPE]
    q_rope = apply_rope(q[..., MLA_NOPE:], cos[:, :, None, :], sin[:, :, None, :])
    kv = (rms_norm(c_kv, kv_norm_g) @ w_ukv).reshape(B, S, H, MLA_NOPE + MLA_V_HEAD)
    k_nope, v = kv[..., :MLA_NOPE], kv[..., MLA_NOPE:]
    k_rope = apply_rope(k_rope_in, cos, sin)
    y = causal_block_attention(q_nope, q_rope, k_nope, k_rope, v)
    return y.reshape(B, S, MLA_WIDTH)


def setup_inputs(seed: int = 0) -> dict:
    key = jax.random.key(seed)
    ks = iter(jax.random.split(key, 40))
    L, D, Lv = DEPTH, D_MODEL, DEPTH - 1

    def nrm(shape, s):
        return jax.random.normal(next(ks), shape, jnp.float32) * s

    def uni(shape, lo, hi):
        return jax.random.uniform(next(ks), shape, jnp.float32, lo, hi)

    return {
        'x': nrm((BATCH, SEQ, D), 1.0),
        'c': nrm((BATCH, D), 1.0),
        'positions': jnp.broadcast_to(jnp.arange(SEQ, dtype=jnp.int32), (BATCH, SEQ)),
        'norm_g': 1.0 + nrm((L, D), 0.02),
        'w_ada': nrm((L, D, 3 * D), 0.5 * D ** -0.5),
        'b_ada': nrm((L, 3 * D), 0.01),
        'w_in': nrm((L, D, IN_WIDTH), D ** -0.5),
        'w_vmix_down': nrm((Lv, D, VMIX_LORA), D ** -0.5),
        'mu_shift': uni((L, SHIFT_WIDTH), 0.0, 1.0),
        'mu_vmix': uni((Lv, VMIX_LORA), 0.0, 1.0),
        'w0': uni((L, RWKV_WIDTH), -6.5, -1.5),
        'w_decay_up': nrm((L, DECAY_LORA, RWKV_WIDTH), 0.1 * DECAY_LORA ** -0.5),
        'a0': nrm((L, RWKV_WIDTH), 0.1),
        'w_iclr_up': nrm((L, ICLR_LORA, RWKV_WIDTH), 0.3 * ICLR_LORA ** -0.5),
        'v0': 1.0 + nrm((Lv, RWKV_WIDTH), 0.1),
        'w_vmix_up': nrm((Lv, VMIX_LORA, RWKV_WIDTH), 0.3 * VMIX_LORA ** -0.5),
        'k_k': 0.85 + nrm((L, RWKV_WIDTH), 0.02),
        'k_a': 1.0 + nrm((L, RWKV_WIDTH), 0.02),
        'r_k': nrm((L, RWKV_HEADS, RWKV_HEAD), 0.1),
        'lnx_w': 1.0 + nrm((L, RWKV_WIDTH), 0.02),
        'lnx_b': nrm((L, RWKV_WIDTH), 0.01),
        'q_norm_g': 1.0 + nrm((L, Q_LORA), 0.02),
        'kv_norm_g': 1.0 + nrm((L, KV_LORA), 0.02),
        'w_uq': nrm((L, Q_LORA, MLA_HEADS * (MLA_NOPE + MLA_ROPE)), Q_LORA ** -0.5),
        'w_ukv': nrm((L, KV_LORA, MLA_HEADS * (MLA_NOPE + MLA_V_HEAD)), KV_LORA ** -0.5),
        'w_out': nrm((L, MIX_WIDTH, D), MIX_WIDTH ** -0.5),
        'final_g': 1.0 + nrm((D,), 0.02),
    }


def reference(x, c, positions, norm_g, w_ada, b_ada, w_in, w_vmix_down, mu_shift, mu_vmix,
              w0, w_decay_up, a0, w_iclr_up, v0, w_vmix_up, k_k, k_a, r_k, lnx_w, lnx_b,
              q_norm_g, kv_norm_g, w_uq, w_ukv, w_out, final_g):
    cos, sin = rope_tables(positions)
    c_act = jax.nn.silu(c)
    v_first = None
    for l in range(DEPTH):
        mod = c_act @ w_ada[l] + b_ada[l]
        shift, scale, gate = jnp.split(mod, 3, axis=-1)
        h = rms_norm(x, norm_g[l]) * (1 + scale[:, None, :]) + shift[:, None, :]
        if l == 0:
            proj = h @ w_in[0]
            p_vmix, mu_v, v0_l, w_vu = None, None, None, None
        else:
            proj = h @ jnp.concatenate([w_in[l], w_vmix_down[l - 1]], axis=1)
            p_vmix, mu_v, v0_l, w_vu = proj[..., IN_WIDTH:], mu_vmix[l - 1], v0[l - 1], w_vmix_up[l - 1]
        y_rwkv, v_first = rwkv7_time_mix(
            proj[..., :SHIFT_WIDTH], p_vmix, v_first, mu_shift[l], mu_v, w0[l], w_decay_up[l],
            a0[l], w_iclr_up[l], v0_l, w_vu, k_k[l], k_a[l], r_k[l], lnx_w[l], lnx_b[l])
        y_mla = mla_branch(proj[..., O_CQ:O_CKV], proj[..., O_CKV:O_KR], proj[..., O_KR:O_GM],
                           cos, sin, q_norm_g[l], kv_norm_g[l], w_uq[l], w_ukv[l])
        y = jnp.concatenate([y_rwkv * jax.nn.silu(proj[..., O_GR:O_CQ]),
                             y_mla * jax.nn.silu(proj[..., O_GM:IN_WIDTH])], axis=-1)
        x = x + gate[:, None, :] * (y @ w_out[l])
    return rms_norm(x, final_g)
```

```cpp
#include <hip/hip_runtime.h>
#include <hip/hip_cooperative_groups.h>
#include <cstdio>
#include <cstdint>
namespace cg = cooperative_groups;
constexpr int REP_P1 = 1, REP_P2 = 1, REP_P3 = 1, REP_P4 = 1, REP_P5 = 1, REP_P6 = 1, REP_SYNC = 1, REP_P0 = 1;
#define GSYNC() do { for (int r_ = 0; r_ < REP_SYNC; ++r_) xcd_barrier(xb); } while (0)


typedef unsigned short bf16_t;
typedef short bf16x8 __attribute__((ext_vector_type(8)));
typedef float f32x4 __attribute__((ext_vector_type(4)));
typedef float f32x2 __attribute__((ext_vector_type(2)));
typedef unsigned u32x4 __attribute__((ext_vector_type(4)));
typedef unsigned u32x2 __attribute__((ext_vector_type(2)));
#define LAS __attribute__((address_space(3)))

constexpr int DM = 1024, NB = 8, SEQ = 4096, NT = NB * SEQ, TH = NT / 2, NL = 4;
constexpr int NP = 3456;
constexpr int O_GR = 1664, O_CQ = 2176, O_CKV = 2560, O_KR = 2816, O_GM = 2848, INW = 3360;
constexpr float QSCALE = 0.10206207261596577f * 1.4426950408889634f;

constexpr size_t al256(size_t x) { return (x + 255) & ~(size_t)255; }
constexpr size_t OFF_BAR = 0;
constexpr size_t OFF_CTRL = 16384;
constexpr size_t OFF_CUCNT = 16384 + 4096;
constexpr size_t OFF_MOD = 16384 + 4096 + 8192;
constexpr size_t OFF_COS = OFF_MOD + al256((size_t)NL * NB * 3072 * 4);
constexpr size_t OFF_SIN = OFF_COS + (size_t)NT * 16 * 4;
constexpr size_t OFF_WIN = OFF_SIN + (size_t)NT * 16 * 4;
constexpr size_t OFF_WOUT = OFF_WIN + (size_t)NL * NP * 1024 * 2;
constexpr size_t OFF_WUQ = OFF_WOUT + (size_t)NL * 1024 * 1024 * 2;
constexpr size_t OFF_WUKV = OFF_WUQ + (size_t)NL * 768 * 384 * 2;
constexpr size_t OFF_WDEC = OFF_WUKV + (size_t)NL * 1024 * 256 * 2;
constexpr size_t OFF_WICL = OFF_WDEC + (size_t)NL * 512 * 64 * 2;
constexpr size_t OFF_WVM = OFF_WICL + (size_t)NL * 512 * 64 * 2;
constexpr size_t OFF_VFIRST = OFF_WVM + (size_t)NL * 512 * 32 * 2;
constexpr size_t OFF_H = OFF_VFIRST + (size_t)NT * 512 * 2;
constexpr int COP_STRIDE = 11008;
constexpr size_t OFF_COPS = OFF_H;
constexpr size_t OFF_PROJ = OFF_H + (size_t)8192 * COP_STRIDE;
constexpr size_t OFF_SR = OFF_PROJ + (size_t)TH * NP * 2;
constexpr size_t OFF_SK = OFF_SR + (size_t)TH * 512 * 2;
constexpr size_t OFF_SV = OFF_SK + (size_t)TH * 512 * 2;
constexpr size_t OFF_SKK = OFF_SV + (size_t)TH * 512 * 2;
constexpr size_t OFF_SKKA = OFF_SKK + (size_t)TH * 512 * 2;
constexpr size_t OFF_SW = OFF_SKKA + (size_t)TH * 512 * 2;
constexpr size_t OFF_RSQ = OFF_SW + (size_t)TH * 512 * 4;
constexpr size_t OFF_RSKV = OFF_RSQ + (size_t)TH * 8 * 4;
constexpr size_t OFF_Q = OFF_RSKV + (size_t)TH * 4 * 4;
constexpr size_t OFF_K = OFF_Q + (size_t)TH * 768 * 2;
constexpr size_t OFF_VT = OFF_K + (size_t)TH * 768 * 2;
constexpr size_t OFF_YRAW = OFF_VT + (size_t)TH * 512 * 2;
constexpr size_t OFF_YCAT = OFF_YRAW + (size_t)TH * 512 * 4;
constexpr size_t WS_TOTAL = OFF_YCAT + (size_t)TH * 1024 * 2;
static_assert(WS_TOTAL <= (size_t)536870912, "workspace exceeds 512 MiB");

struct Params {
    const float *x, *c; const int* pos;
    const float *norm_g, *w_ada, *b_ada, *w_in, *w_vmd, *mu_shift, *mu_vmix, *w0, *w_dec, *a0, *w_icl, *v0, *w_vmu;
    const float *k_k, *k_a, *r_k, *lnx_w, *lnx_b, *qng, *kvng, *w_uq, *w_ukv, *w_out, *final_g;
    float* out; char* ws;
};

__device__ __forceinline__ int otid() { int t = threadIdx.x; asm volatile("" : "+v"(t)); return t; }
__device__ __forceinline__ unsigned pk_bf16(float lo, float hi) { unsigned r; asm("v_cvt_pk_bf16_f32 %0, %1, %2" : "=v"(r) : "v"(lo), "v"(hi)); return r; }
__device__ __forceinline__ float bf_lo(unsigned u) { return __uint_as_float(u << 16); }
__device__ __forceinline__ float bf_hi(unsigned u) { return __uint_as_float(u & 0xffff0000u); }
__device__ __forceinline__ float sigmoidf_(float x) { return 1.0f / (1.0f + __expf(-x)); }
__device__ __forceinline__ float siluf_(float x) { return x / (1.0f + __expf(-x)); }
__device__ __forceinline__ float tanhf_(float x) { const float t = __expf(2.0f * x); return 1.0f - 2.0f / (t + 1.0f); }
template <int CTRL> __device__ __forceinline__ float dpp_add(float x) {
    return x + __int_as_float(__builtin_amdgcn_update_dpp(0, __float_as_int(x), CTRL, 0xf, 0xf, true));
}
__device__ __forceinline__ float dpp_sum16(float x) {
    x = dpp_add<0xB1>(x);
    x = dpp_add<0x4E>(x);
    x = dpp_add<0x141>(x);
    x = dpp_add<0x140>(x);
    return x;
}
__device__ __forceinline__ void dpp_sum16x2(float& a, float& b) {
    a = dpp_add<0xB1>(a); b = dpp_add<0xB1>(b);
    a = dpp_add<0x4E>(a); b = dpp_add<0x4E>(b);
    a = dpp_add<0x141>(a); b = dpp_add<0x141>(b);
    a = dpp_add<0x140>(a); b = dpp_add<0x140>(b);
}
__device__ __forceinline__ float wave_sum64(float x) {
    x += __shfl_xor(x, 1); x += __shfl_xor(x, 2); x += __shfl_xor(x, 4); x += __shfl_xor(x, 8); x += __shfl_xor(x, 16); x += __shfl_xor(x, 32);
    return x;
}


#define XB_TMO      128
#define XB_XCNT(j)  (256  + 64 * (j))
#define XB_XSUB(j)  (1280 + 64 * (j))
#define XB_XGEN(j)  (2304 + 64 * (j))
#define XB_TOP      3328
#define XB_TOPGEN   3392
#define XCD_BAR_WORDS 3456
#define XB_SPIN_CAP (1u << 18)
__device__ __forceinline__ unsigned xb_ld(unsigned* p)              { return __hip_atomic_load(p, __ATOMIC_RELAXED, __HIP_MEMORY_SCOPE_AGENT); }
__device__ __forceinline__ unsigned xb_add(unsigned* p, unsigned v) { return __hip_atomic_fetch_add(p, v, __ATOMIC_RELAXED, __HIP_MEMORY_SCOPE_AGENT); }
__device__ __forceinline__ unsigned xb_xcc_id() { return (unsigned)__builtin_amdgcn_s_getreg((3 << 11) | 20) & 0xFu; }
#define XB_SPIN(cond, bar) do { unsigned _sp = 0; while (cond) { __builtin_amdgcn_s_sleep(1); \
    if ((++_sp & 255u) == 0u) { if (xb_ld(&(bar)[XB_TMO])) break; if (_sp > XB_SPIN_CAP) { atomicAdd(&(bar)[XB_TMO], 1u); break; } } } } while (0)
struct XcdBarrier { unsigned* bar; unsigned x; volatile LAS unsigned* st; };
__device__ __forceinline__ XcdBarrier xcd_barrier_post(unsigned* bar, volatile LAS unsigned* st) {
    XcdBarrier b; b.bar = bar; b.x = xb_xcc_id(); b.st = st;
    if (threadIdx.x == 0) (void)xb_add(&bar[XB_XCNT(b.x)], 1u);
    return b;
}
__device__ __forceinline__ void xcd_barrier_complete(unsigned* bar, unsigned x, unsigned& nloc, unsigned& nx) {
    const unsigned G = gridDim.x * gridDim.y * gridDim.z;
    unsigned sum, cnt, mine, sp = 0u;
    for (;;) {
        sum = 0u; cnt = 0u; mine = 0u;
#pragma unroll
        for (unsigned j = 0; j < 16; ++j) { const unsigned c = xb_ld(&bar[XB_XCNT(j)]); sum += c; cnt += (c > 0u) ? 1u : 0u; mine = (j == x) ? c : mine; }
        if (sum == G) break;
        __builtin_amdgcn_s_sleep(1);
        if ((++sp & 255u) == 0u) { if (xb_ld(&bar[XB_TMO])) break; if (sp > XB_SPIN_CAP) { atomicAdd(&bar[XB_TMO], 1u); break; } }
    }
    nloc = mine > 0u ? mine : 1u; nx = cnt > 0u ? cnt : 1u;
}
__device__ __forceinline__ void xcd_barrier(const XcdBarrier& b) {
    asm volatile("s_waitcnt vmcnt(0)" ::: "memory");
    __syncthreads();
    if (threadIdx.x == 0) {
        unsigned* bar = b.bar;
        __builtin_amdgcn_s_waitcnt(0);
        unsigned nloc = b.st[0], nx = b.st[1];
        if (nloc == 0u) { xcd_barrier_complete(bar, b.x, nloc, nx); b.st[0] = nloc; b.st[1] = nx; }
        const unsigned old = xb_add(&bar[XB_XSUB(b.x)], 1u);
        const unsigned gen = old / nloc;
        if (old + 1u == (gen + 1u) * nloc) {
            __builtin_amdgcn_fence(__ATOMIC_RELEASE, "agent");
            asm volatile("s_waitcnt vmcnt(0)" ::: "memory");
            const unsigned og = xb_add(&bar[XB_TOP], 1u);
            const unsigned tg = og / nx;
            if (og + 1u == (tg + 1u) * nx) xb_add(&bar[XB_TOPGEN], 1u);
            else XB_SPIN(xb_ld(&bar[XB_TOPGEN]) == tg, bar);
            __builtin_amdgcn_fence(__ATOMIC_ACQUIRE, "agent");
            xb_add(&bar[XB_XGEN(b.x)], 1u);
            asm volatile("s_waitcnt vmcnt(0)" ::: "memory");
        } else {
            XB_SPIN(xb_ld(&bar[XB_XGEN(b.x)]) == gen, bar);
            __builtin_amdgcn_fence(__ATOMIC_ACQUIRE, "agent");
            asm volatile("s_waitcnt vmcnt(0)" ::: "memory");
        }
    }
    __syncthreads();
}

__device__ void transpose_job(float* tile, const float* __restrict__ src, int ld, int K, int N, bf16_t* __restrict__ dst, int dst_rows,
                              const float* __restrict__ kscale, const float* __restrict__ src2, int ld2, int n2lo, int n2hi, int& rot, int idx, int nidx) {
    const int nkt = (K + 63) >> 6, nnt = (dst_rows + 63) >> 6, ntiles = nkt * nnt;
    const int tid_ = otid(); const int tx = tid_ & 63, ty = tid_ >> 6;
    const int first = (idx + nidx - rot % nidx) % nidx;
    rot += ntiles;
    for (int t = first; t < ntiles; t += nidx) {
        const int kt = t % nkt, nt = t / nkt, k0 = kt * 64, n0 = nt * 64;
#pragma unroll 4
        for (int i = 0; i < 16; ++i) {
            const int k = k0 + ty + 4 * i, n = n0 + tx; float v = 0.f;
            if (k < K) {
                if (n < N) { v = src[(size_t)k * ld + n]; if (kscale) v *= kscale[k]; }
                else if (src2 && n >= n2lo && n < n2hi) v = src2[(size_t)k * ld2 + (n - n2lo)];
            }
            tile[(ty + 4 * i) * 65 + tx] = v;
        }
        __syncthreads();
#pragma unroll 4
        for (int i = 0; i < 16; ++i) {
            const int n = n0 + ty + 4 * i, k = k0 + tx;
            if (n < dst_rows && k < K) dst[(size_t)n * K + k] = (bf16_t)(pk_bf16(tile[tx * 65 + ty + 4 * i], 0.f) & 0xffffu);
        }
        __syncthreads();
    }
}

__device__ void mod_job(float* lds, const Params& p, float* __restrict__ mod) {
    float* cact = lds;
    float* red = lds + 8192;
    const int tid = otid();
    bool have = false;
    for (int it = (int)gridDim.x - 1 - (int)blockIdx.x; it < 192; it += gridDim.x) {
        if (!have) {
            for (int i = tid; i < 8192; i += 256) cact[i] = siluf_(p.c[i]);
            have = true;
            __syncthreads();
        }
        const int l = it / 48, n0 = (it % 48) * 64, kg = tid >> 6, n = n0 + (tid & 63);
        float a0 = 0.f, a1 = 0.f, a2 = 0.f, a3 = 0.f, a4 = 0.f, a5 = 0.f, a6 = 0.f, a7 = 0.f;
        const float* wp = p.w_ada + ((size_t)l * 1024 + kg * 256) * 3072 + n;
#pragma unroll 8
        for (int k = 0; k < 256; ++k) {
            const float w = wp[(size_t)k * 3072]; const int kk = kg * 256 + k;
            a0 += cact[kk] * w; a1 += cact[1024 + kk] * w; a2 += cact[2048 + kk] * w; a3 += cact[3072 + kk] * w;
            a4 += cact[4096 + kk] * w; a5 += cact[5120 + kk] * w; a6 += cact[6144 + kk] * w; a7 += cact[7168 + kk] * w;
        }
        float* rp = red + (kg * 64 + (tid & 63)) * 8;
        rp[0] = a0; rp[1] = a1; rp[2] = a2; rp[3] = a3; rp[4] = a4; rp[5] = a5; rp[6] = a6; rp[7] = a7;
        __syncthreads();
        {
#pragma unroll
            for (int q = 0; q < 2; ++q) {
                const int o = tid + 256 * q, nn = o >> 3, b = o & 7;
                const float s = red[(0 * 64 + nn) * 8 + b] + red[(1 * 64 + nn) * 8 + b] + red[(2 * 64 + nn) * 8 + b] + red[(3 * 64 + nn) * 8 + b];
                mod[((size_t)l * 8 + b) * 3072 + n0 + nn] = s + p.b_ada[l * 3072 + n0 + nn];
            }
        }
        __syncthreads();
    }
}

__device__ void convert_layer(char* smem, const Params& p, int l, int idx, int nidx) {
    char* ws = p.ws; float* tile = (float*)smem; int rot = 0;
    transpose_job(tile, p.w_in + (size_t)l * 1024 * INW, INW, 1024, INW, (bf16_t*)(ws + OFF_WIN) + (size_t)l * NP * 1024, NP, nullptr,
                  l > 0 ? p.w_vmd + (size_t)(l - 1) * 1024 * 32 : nullptr, 32, INW, INW + 32, rot, idx, nidx);
    transpose_job(tile, p.w_out + (size_t)l * 1024 * 1024, 1024, 1024, 1024, (bf16_t*)(ws + OFF_WOUT) + (size_t)l * 1024 * 1024, 1024, nullptr, nullptr, 0, 0, 0, rot, idx, nidx);
    transpose_job(tile, p.w_uq + (size_t)l * 384 * 768, 768, 384, 768, (bf16_t*)(ws + OFF_WUQ) + (size_t)l * 768 * 384, 768, p.qng + l * 384, nullptr, 0, 0, 0, rot, idx, nidx);
    transpose_job(tile, p.w_ukv + (size_t)l * 256 * 1024, 1024, 256, 1024, (bf16_t*)(ws + OFF_WUKV) + (size_t)l * 1024 * 256, 1024, p.kvng + l * 256, nullptr, 0, 0, 0, rot, idx, nidx);
    transpose_job(tile, p.w_dec + (size_t)l * 64 * 512, 512, 64, 512, (bf16_t*)(ws + OFF_WDEC) + (size_t)l * 512 * 64, 512, nullptr, nullptr, 0, 0, 0, rot, idx, nidx);
    transpose_job(tile, p.w_icl + (size_t)l * 64 * 512, 512, 64, 512, (bf16_t*)(ws + OFF_WICL) + (size_t)l * 512 * 64, 512, nullptr, nullptr, 0, 0, 0, rot, idx, nidx);
    if (l > 0)
        transpose_job(tile, p.w_vmu + (size_t)(l - 1) * 32 * 512, 512, 32, 512, (bf16_t*)(ws + OFF_WVM) + (size_t)l * 512 * 32, 512, nullptr, nullptr, 0, 0, 0, rot, idx, nidx);
}

__device__ void prologue(char* smem, const Params& p) {
    char* ws = p.ws;
    float* tile = (float*)smem;
    { const int t0_ = otid(); if (blockIdx.x == 0 && t0_ < 64) ((int*)(ws + OFF_CTRL))[t0_] = 0; }
    {
        float* cs = (float*)(ws + OFF_COS); float* sn = (float*)(ws + OFF_SIN);
        const int gt = blockIdx.x * 256 + otid(), ng = gridDim.x * 256;
        for (int e = gt; e < NT * 16; e += ng) {
            const int t = e >> 4, i = e & 15;
            const float inv = exp2f(-(float)i * (13.287712379549449f / 16.0f));
            const float ang = (float)p.pos[t] * inv;
            cs[e] = cosf(ang); sn[e] = sinf(ang);
        }
    }
    mod_job(tile, p, (float*)(ws + OFF_MOD));
    __syncthreads();
    convert_layer(smem, p, 0, blockIdx.x, gridDim.x);
}

__device__ void norm_phase(const float* __restrict__ xin, const float* __restrict__ g, const float* __restrict__ modl, bf16_t* __restrict__ h, int tbase) {
    const int tid_ = otid(); const int lane = tid_ & 63, gw = blockIdx.x * 4 + (tid_ >> 6), nw = gridDim.x * 4;
    for (int t = tbase + gw; t < tbase + TH; t += nw) {
        const float* xr = xin + (size_t)t * 1024;
        f32x4 v[4]; float ss = 0.f;
#pragma unroll
        for (int i = 0; i < 4; ++i) { v[i] = *(const f32x4*)(xr + i * 256 + lane * 4); ss += v[i].x * v[i].x + v[i].y * v[i].y + v[i].z * v[i].z + v[i].w * v[i].w; }
        ss = wave_sum64(ss);
        const float rstd = rsqrtf(ss * (1.0f / 1024.0f) + 1e-6f);
        const float* mb = modl + (size_t)(t >> 12) * 3072;
#pragma unroll
        for (int i = 0; i < 4; ++i) {
            const int col = i * 256 + lane * 4;
            const f32x4 gg = *(const f32x4*)(g + col), sh = *(const f32x4*)(mb + col), sc = *(const f32x4*)(mb + 1024 + col);
            const f32x4 o = v[i] * rstd * gg * (sc + 1.0f) + sh;
            u32x2 w; w.x = pk_bf16(o.x, o.y); w.y = pk_bf16(o.z, o.w);
            *(u32x2*)(h + (size_t)(t - tbase) * 1024 + col) = w;
        }
    }
}

__device__ void final_norm(float* __restrict__ xio, const float* __restrict__ g) {
    const int tid_ = otid(); const int lane = tid_ & 63, gw = blockIdx.x * 4 + (tid_ >> 6), nw = gridDim.x * 4;
    for (int t = gw; t < NT; t += nw) {
        float* xr = xio + (size_t)t * 1024;
        f32x4 v[4]; float ss = 0.f;
#pragma unroll
        for (int i = 0; i < 4; ++i) { v[i] = *(const f32x4*)(xr + i * 256 + lane * 4); ss += v[i].x * v[i].x + v[i].y * v[i].y + v[i].z * v[i].z + v[i].w * v[i].w; }
        ss = wave_sum64(ss);
        const float rstd = rsqrtf(ss * (1.0f / 1024.0f) + 1e-6f);
#pragma unroll
        for (int i = 0; i < 4; ++i) {
            const int col = i * 256 + lane * 4;
            const f32x4 gg = *(const f32x4*)(g + col);
            *(f32x4*)(xr + col) = v[i] * rstd * gg;
        }
    }
}

template <class Epi>
__device__ __forceinline__ void gemm_tile(char* smem, const bf16_t* __restrict__ A, int lda, const bf16_t* __restrict__ Bt, int ldb, int K, int row0, int col0, const Epi& epi) {
    const int tid = otid(), lane = tid & 63, wid = tid >> 6, wr = wid >> 1, wc = wid & 1, fr = lane & 15, fq = lane >> 4;
    f32x4 acc[4][4];
#pragma unroll
    for (int i = 0; i < 4; ++i)
#pragma unroll
        for (int j = 0; j < 4; ++j) acc[i][j] = (f32x4){0.f, 0.f, 0.f, 0.f};
    const int lrow = lane >> 3, lp = lane & 7;
    const int srow0 = wid * 32 + lrow;
    const bf16_t* gA = A + (size_t)(row0 + srow0) * lda;
    const bf16_t* gB = Bt + (size_t)(col0 + srow0) * ldb;
    int gc[4];
#pragma unroll
    for (int i = 0; i < 4; ++i) gc[i] = (lp ^ (((srow0 + 8 * i) >> 1) & 7)) * 8;
    LAS char* lbase = (LAS char*)smem + wid * 4096;
#define GEMM_STAGE(buf, kofs) do { _Pragma("unroll") for (int i = 0; i < 4; ++i) { \
        __builtin_amdgcn_global_load_lds((const unsigned*)(gA + (size_t)(8 * i) * lda + (kofs) + gc[i]), (LAS unsigned*)(lbase + (buf) * 32768 + i * 1024), 16, 0, 0); \
        __builtin_amdgcn_global_load_lds((const unsigned*)(gB + (size_t)(8 * i) * ldb + (kofs) + gc[i]), (LAS unsigned*)(lbase + (buf) * 32768 + 16384 + i * 1024), 16, 0, 0); } } while (0)
    GEMM_STAGE(0, 0);
    __syncthreads();
    const int nk = K >> 6;
    const int fsw = (fr >> 1) & 7;
    const int aoff = (wr * 64 + fr) * 128, boff = 16384 + (wc * 64 + fr) * 128;
#define GEMM_STEP(CB, NB_) do { \
        const char* cur = smem + (CB) * 32768; \
        bf16x8 af[2][4], bfr[2][4]; \
        _Pragma("unroll") for (int kk = 0; kk < 2; ++kk) { \
            const int csw = (((kk * 4 + fq) ^ fsw) << 4); \
            _Pragma("unroll") for (int i = 0; i < 4; ++i) { af[kk][i] = *(const bf16x8*)(cur + aoff + i * 2048 + csw); bfr[kk][i] = *(const bf16x8*)(cur + boff + i * 2048 + csw); } \
        } \
        __builtin_amdgcn_sched_barrier(0); \
        if (ks + 1 < nk) GEMM_STAGE(NB_, (ks + 1) * 64); \
        __builtin_amdgcn_sched_barrier(0); \
        _Pragma("unroll") for (int kk = 0; kk < 2; ++kk) \
            _Pragma("unroll") for (int mi = 0; mi < 4; ++mi) \
                _Pragma("unroll") for (int ni = 0; ni < 4; ++ni) acc[mi][ni] = __builtin_amdgcn_mfma_f32_16x16x32_bf16(bfr[kk][ni], af[kk][mi], acc[mi][ni], 0, 0, 0); \
        __builtin_amdgcn_sched_barrier(0); \
        __syncthreads(); \
        ++ks; } while (0)
#pragma unroll 1
    for (int ks = 0; ks < nk;) {
        GEMM_STEP(0, 1);
        GEMM_STEP(1, 0);
    }
#undef GEMM_STEP
#undef GEMM_STAGE
    epi(acc, row0 + wr * 64, col0 + wc * 64, fr, fq);
}

struct EpiProj {
    bf16_t* proj; float* rsq; float* rskv; char* smem;
    __device__ __forceinline__ void operator()(const f32x4 (&acc)[4][4], int rbase, int cbase, int fr, int fq) const {
        const bool isq = cbase >= O_CQ && cbase < O_CKV, iskv = cbase >= O_CKV && cbase < O_KR;
        const int row0 = rbase & ~127, col0 = cbase & ~127, wr = (rbase >> 6) & 1, wc = (cbase >> 6) & 1;
        const int tid = (wr * 2 + wc) * 64 + fq * 16 + fr;
#pragma unroll
        for (int mi = 0; mi < 4; ++mi) {
            const int tl = rbase + mi * 16 + fr; float ss = 0.f;
#pragma unroll
            for (int ni = 0; ni < 4; ++ni) {
                u32x2 w; w.x = pk_bf16(acc[mi][ni][0], acc[mi][ni][1]); w.y = pk_bf16(acc[mi][ni][2], acc[mi][ni][3]);
                *(u32x2*)(smem + (wr * 64 + mi * 16 + fr) * 272 + (wc * 64 + ni * 16 + fq * 4) * 2) = w;
                const float a = bf_lo(w.x), b = bf_hi(w.x), c = bf_lo(w.y), d = bf_hi(w.y);
                ss += a * a + b * b + c * c + d * d;
            }
            if (isq || iskv) {
                ss += __shfl_xor(ss, 16); ss += __shfl_xor(ss, 32);
                if (fq == 0) { if (isq) rsq[(size_t)tl * 8 + ((cbase - O_CQ) >> 6)] = ss; else rskv[(size_t)tl * 4 + ((cbase - O_CKV) >> 6)] = ss; }
            }
        }
        __syncthreads();
#pragma unroll
        for (int i = 0; i < 8; ++i) {
            const int q = tid + 256 * i, r = q >> 4, c = q & 15;
            *(u32x4*)(proj + (size_t)(row0 + r) * NP + col0 + c * 8) = *(const u32x4*)(smem + r * 272 + c * 16);
        }
        __syncthreads();
    }
};
struct EpiQ {
    bf16_t* Q; const float* rsq; const float* cs; const float* sn; int tgbase; char* smem;
    __device__ __forceinline__ void operator()(const f32x4 (&acc)[4][4], int rbase, int cbase, int fr, int fq) const {
        const int g0 = cbase >> 4;
        char* stg = smem + ((((rbase >> 6) & 1) * 2 + ((cbase >> 6) & 1)) * 9216);
#pragma unroll
        for (int mi = 0; mi < 4; ++mi) {
            const int tl = rbase + mi * 16 + fr;
            const f32x4 s0 = *(const f32x4*)(rsq + (size_t)tl * 8); const f32x2 s1 = *(const f32x2*)(rsq + (size_t)tl * 8 + 4);
            const float rs = rsqrtf((s0.x + s0.y + s0.z + s0.w + s1.x + s1.y) * (1.0f / 384.0f) + 1e-6f) * QSCALE;
            const f32x4 cc = *(const f32x4*)(cs + (size_t)(tgbase + tl) * 16 + fq * 4), sv = *(const f32x4*)(sn + (size_t)(tgbase + tl) * 16 + fq * 4);
            f32x4 v[4];
#pragma unroll
            for (int ni = 0; ni < 4; ++ni) v[ni] = acc[mi][ni] * rs;
#pragma unroll
            for (int ni = 0; ni < 4; ni += 2)
                if ((g0 + ni) % 6 == 4) { const f32x4 x1 = v[ni], x2 = v[ni + 1]; v[ni] = x1 * cc - x2 * sv; v[ni + 1] = x2 * cc + x1 * sv; }
#pragma unroll
            for (int ni = 0; ni < 4; ++ni) {
                u32x2 w; w.x = pk_bf16(v[ni][0], v[ni][1]); w.y = pk_bf16(v[ni][2], v[ni][3]);
                *(u32x2*)(stg + (mi * 16 + fr) * 144 + (ni * 16 + fq * 4) * 2) = w;
            }
        }
        {
            const int lane = fq * 16 + fr;
#pragma unroll
            for (int i = 0; i < 8; ++i) {
                const int q = lane + 64 * i, tk = q >> 3, c = q & 7;
                *(u32x4*)(Q + (size_t)(rbase + tk) * 768 + cbase + c * 8) = *(const u32x4*)(stg + tk * 144 + c * 16);
            }
        }
        __syncthreads();
    }
};
struct EpiKV {
    bf16_t* Kh; bf16_t* Vt; const float* rskv; char* smem;
    __device__ __forceinline__ void operator()(const f32x4 (&acc)[4][4], int rbase, int cbase, int fr, int fq) const {
        const int hh = cbase >> 7, part = (cbase >> 6) & 1, lane = fq * 16 + fr;
        char* stg = smem + ((((rbase >> 6) & 1) * 2 + part) * 9216);
#pragma unroll
        for (int mi = 0; mi < 4; ++mi) {
            const int tl = rbase + mi * 16 + fr;
            const f32x4 s0 = *(const f32x4*)(rskv + (size_t)tl * 4);
            const float rs = rsqrtf((s0.x + s0.y + s0.z + s0.w) * (1.0f / 256.0f) + 1e-6f);
#pragma unroll
            for (int ni = 0; ni < 4; ++ni) {
                const unsigned w0 = pk_bf16(acc[mi][ni][0] * rs, acc[mi][ni][1] * rs), w1 = pk_bf16(acc[mi][ni][2] * rs, acc[mi][ni][3] * rs);
                if (part == 0) { u32x2 w; w.x = w0; w.y = w1; *(u32x2*)(stg + (mi * 16 + fr) * 144 + (ni * 16 + fq * 4) * 2) = w; }
                else {
                    bf16_t* sp = (bf16_t*)(stg + (ni * 16 + fq * 4) * 144) + mi * 16 + fr;
                    sp[0] = (bf16_t)(w0 & 0xffffu); sp[72] = (bf16_t)(w0 >> 16); sp[144] = (bf16_t)(w1 & 0xffffu); sp[216] = (bf16_t)(w1 >> 16);
                }
            }
        }
        if (part == 0) {
#pragma unroll
            for (int i = 0; i < 8; ++i) {
                const int q = lane + 64 * i, tk = q >> 3, c = q & 7;
                *(u32x4*)(Kh + (size_t)(rbase + tk) * 768 + hh * 96 + c * 8) = *(const u32x4*)(stg + tk * 144 + c * 16);
            }
        } else {
            const int bl = rbase >> 12, s0 = rbase & 4095;
            bf16_t* vb = Vt + ((size_t)(bl * 8 + hh) * 64) * 4096 + s0;
#pragma unroll
            for (int i = 0; i < 8; ++i) {
                const int q = lane + 64 * i, dv = q >> 3, c = q & 7;
                *(u32x4*)(vb + (size_t)dv * 4096 + c * 8) = *(const u32x4*)(stg + dv * 144 + c * 16);
            }
        }
        __syncthreads();
    }
};
struct EpiOut {
    const float* xold; float* xnew; const float* modl; int tgbase; float fac;
    __device__ __forceinline__ void operator()(const f32x4 (&acc)[4][4], int rbase, int cbase, int fr, int fq) const {
#pragma unroll
        for (int mi = 0; mi < 4; ++mi) {
            const int tg = tgbase + rbase + mi * 16 + fr; const float* gp = modl + (size_t)(tg >> 12) * 3072 + 2048;
#pragma unroll
            for (int ni = 0; ni < 4; ++ni) {
                const int col = cbase + ni * 16 + fq * 4;
                const f32x4 xo = *(const f32x4*)(xold + (size_t)tg * 1024 + col), gt = *(const f32x4*)(gp + col);
                *(f32x4*)(xnew + (size_t)tg * 1024 + col) = xo + gt * acc[mi][ni] * fac;
            }
        }
    }
};

struct PrepArgs {
    const bf16_t* proj; const float* mu; const float* muv; const bf16_t* wdec; const bf16_t* wicl; const bf16_t* wvm;
    const float *w0, *a0, *v0, *k_k, *k_a; const float *cs, *sn;
    bf16_t *sr, *sk, *sv, *skk, *skka; float* sw; bf16_t* vfirst; bf16_t* Kh; int layer; int tgbase;
};
__device__ __forceinline__ void lerp8(const bf16_t* cur, const bf16_t* prv, bool hp, const float* mu, float (&o)[8]) {
    const u32x4 c = *(const u32x4*)cur; u32x4 q = (u32x4){0u, 0u, 0u, 0u}; if (hp) q = *(const u32x4*)prv;
    const f32x4 m0 = *(const f32x4*)mu, m1 = *(const f32x4*)(mu + 4);
    const float cv[8] = {bf_lo(c.x), bf_hi(c.x), bf_lo(c.y), bf_hi(c.y), bf_lo(c.z), bf_hi(c.z), bf_lo(c.w), bf_hi(c.w)};
    const float pv[8] = {bf_lo(q.x), bf_hi(q.x), bf_lo(q.y), bf_hi(q.y), bf_lo(q.z), bf_hi(q.z), bf_lo(q.w), bf_hi(q.w)};
    const float mv[8] = {m0.x, m0.y, m0.z, m0.w, m1.x, m1.y, m1.z, m1.w};
#pragma unroll
    for (int j = 0; j < 8; ++j) o[j] = cv[j] + (pv[j] - cv[j]) * mv[j];
}
__device__ __forceinline__ f32x4 lerp4(const bf16_t* cur, const bf16_t* prv, bool hp, const float* mu) {
    const u32x2 c = *(const u32x2*)cur; u32x2 q = (u32x2){0u, 0u}; if (hp) q = *(const u32x2*)prv;
    const f32x4 m = *(const f32x4*)mu;
    const f32x4 cv = (f32x4){bf_lo(c.x), bf_hi(c.x), bf_lo(c.y), bf_hi(c.y)}, pv = (f32x4){bf_lo(q.x), bf_hi(q.x), bf_lo(q.y), bf_hi(q.y)};
    return cv + (pv - cv) * m;
}
__device__ __forceinline__ bf16x8 pack8(const float (&v)[8]) {
    u32x4 w; w.x = pk_bf16(v[0], v[1]); w.y = pk_bf16(v[2], v[3]); w.z = pk_bf16(v[4], v[5]); w.w = pk_bf16(v[6], v[7]);
    return __builtin_bit_cast(bf16x8, w);
}
__device__ __forceinline__ void store4(bf16_t* dst, const f32x4 v) { u32x2 w; w.x = pk_bf16(v.x, v.y); w.y = pk_bf16(v.z, v.w); *(u32x2*)dst = w; }

__device__ __forceinline__ void prep_tile(char* smem, const PrepArgs& a, int tile, int hg) {
    const int tid = otid(), lane = tid & 63, wid = tid >> 6, fr = lane & 15, fq = lane >> 4;
    const int tl = tile * 64 + wid * 16 + fr, tg = a.tgbase + tl;
    char* stg = smem + wid * 15872;
    const int tlw = tile * 64 + wid * 16;
    const bool hp = (tg & 4095) != 0;
    const bf16_t* pr = a.proj + (size_t)tl * NP; const bf16_t* pp = pr - NP;
    if (hg == 0) {
        const u32x2 u1 = *(const u32x2*)(pr + O_KR + fq * 4), u2 = *(const u32x2*)(pr + O_KR + 16 + fq * 4);
        const f32x4 x1 = (f32x4){bf_lo(u1.x), bf_hi(u1.x), bf_lo(u1.y), bf_hi(u1.y)}, x2 = (f32x4){bf_lo(u2.x), bf_hi(u2.x), bf_lo(u2.y), bf_hi(u2.y)};
        const f32x4 cc = *(const f32x4*)(a.cs + (size_t)tg * 16 + fq * 4), sv = *(const f32x4*)(a.sn + (size_t)tg * 16 + fq * 4);
        const f32x4 o1 = x1 * cc - x2 * sv, o2 = x2 * cc + x1 * sv;
        u32x2 w1, w2; w1.x = pk_bf16(o1.x, o1.y); w1.y = pk_bf16(o1.z, o1.w); w2.x = pk_bf16(o2.x, o2.y); w2.y = pk_bf16(o2.z, o2.w);
#pragma unroll
        for (int hh = 0; hh < 8; ++hh) { *(u32x2*)(a.Kh + (size_t)tl * 768 + hh * 96 + 64 + fq * 4) = w1; *(u32x2*)(a.Kh + (size_t)tl * 768 + hh * 96 + 80 + fq * 4) = w2; }
    }
    bf16x8 bw[2], ba[2], bv;
#pragma unroll
    for (int ks = 0; ks < 2; ++ks) {
        float t[8];
        lerp8(pr + 1536 + ks * 32 + fq * 8, pp + 1536 + ks * 32 + fq * 8, hp, a.mu + 1536 + ks * 32 + fq * 8, t);
#pragma unroll
        for (int j = 0; j < 8; ++j) t[j] = tanhf_(t[j]);
        bw[ks] = pack8(t);
        lerp8(pr + 1600 + ks * 32 + fq * 8, pp + 1600 + ks * 32 + fq * 8, hp, a.mu + 1600 + ks * 32 + fq * 8, t);
        ba[ks] = pack8(t);
    }
    const bool hasv = a.layer > 0;
    if (hasv) { float t[8]; lerp8(pr + INW + fq * 8, pp + INW + fq * 8, hp, a.muv + fq * 8, t); bv = pack8(t); }
    else bv = (bf16x8){0, 0, 0, 0, 0, 0, 0, 0};
#pragma unroll 1
    for (int hh = hg * 2; hh < hg * 2 + 2; ++hh) {
        float ss = 0.f;
#pragma unroll
        for (int nt = 0; nt < 4; ++nt) {
            const int ch = hh * 64 + nt * 16 + fq * 4;
            const f32x4 k4 = lerp4(pr + 512 + ch, pp + 512 + ch, hp, a.mu + 512 + ch);
            const f32x4 kr = k4 * *(const f32x4*)(a.k_k + ch);
            ss += kr.x * kr.x + kr.y * kr.y + kr.z * kr.z + kr.w * kr.w;
        }
        ss += __shfl_xor(ss, 16); ss += __shfl_xor(ss, 32);
        const float inv = 1.0f / fmaxf(sqrtf(ss), 1e-12f);
#pragma unroll
        for (int nt = 0; nt < 4; ++nt) {
            const int cb = hh * 64 + nt * 16, ch = cb + fq * 4;
            f32x4 accw = (f32x4){0.f, 0.f, 0.f, 0.f}, acca = accw, accv = accw;
#pragma unroll
            for (int ks = 0; ks < 2; ++ks) {
                const bf16x8 aw = *(const bf16x8*)(a.wdec + (size_t)(cb + fr) * 64 + ks * 32 + fq * 8);
                const bf16x8 ai = *(const bf16x8*)(a.wicl + (size_t)(cb + fr) * 64 + ks * 32 + fq * 8);
                accw = __builtin_amdgcn_mfma_f32_16x16x32_bf16(aw, bw[ks], accw, 0, 0, 0);
                acca = __builtin_amdgcn_mfma_f32_16x16x32_bf16(ai, ba[ks], acca, 0, 0, 0);
            }
            if (hasv) {
                const bf16x8 avm = *(const bf16x8*)(a.wvm + (size_t)(cb + fr) * 32 + fq * 8);
                accv = __builtin_amdgcn_mfma_f32_16x16x32_bf16(avm, bv, accv, 0, 0, 0);
            }
            const f32x4 r4 = lerp4(pr + ch, pp + ch, hp, a.mu + ch);
            const f32x4 k4 = lerp4(pr + 512 + ch, pp + 512 + ch, hp, a.mu + 512 + ch);
            f32x4 v4 = lerp4(pr + 1024 + ch, pp + 1024 + ch, hp, a.mu + 1024 + ch);
            const f32x4 w0v = *(const f32x4*)(a.w0 + ch), a0v = *(const f32x4*)(a.a0 + ch), kkv = *(const f32x4*)(a.k_k + ch), kav = *(const f32x4*)(a.k_a + ch);
            f32x4 dec, aa;
#pragma unroll
            for (int j = 0; j < 4; ++j) {
                dec[j] = __expf(-0.6065306597126334f * sigmoidf_(w0v[j] + accw[j]));
                aa[j] = sigmoidf_(a0v[j] + acca[j]);
            }
            if (hasv) {
                const f32x4 v0v = *(const f32x4*)(a.v0 + ch);
                const u32x2 uf = *(const u32x2*)(a.vfirst + (size_t)tg * 512 + ch);
                const f32x4 vf = (f32x4){bf_lo(uf.x), bf_hi(uf.x), bf_lo(uf.y), bf_hi(uf.y)};
#pragma unroll
                for (int j = 0; j < 4; ++j) v4[j] = v4[j] + (vf[j] - v4[j]) * sigmoidf_(v0v[j] + accv[j]);
            } else {
                store4(a.vfirst + (size_t)tg * 512 + ch, v4);
            }
            const f32x4 kk = k4 * kkv * inv;
            const f32x4 kp = k4 * ((aa - 1.0f) * kav + 1.0f);
            {
                const int so = fr * 144 + nt * 32 + fq * 8;
                store4((bf16_t*)(stg + so), r4); store4((bf16_t*)(stg + 2304 + so), kp); store4((bf16_t*)(stg + 4608 + so), v4);
                store4((bf16_t*)(stg + 6912 + so), kk); store4((bf16_t*)(stg + 9216 + so), kk * aa);
                *(f32x4*)(stg + 11520 + fr * 272 + nt * 64 + fq * 16) = dec;
            }
        }
        {
#pragma unroll
            for (int i = 0; i < 2; ++i) {
                const int q = lane + 64 * i, tk = q >> 3, c = q & 7;
                const size_t go = (size_t)(tlw + tk) * 512 + hh * 64 + c * 8; const int lo = tk * 144 + c * 16;
                *(u32x4*)(a.sr + go) = *(const u32x4*)(stg + lo); *(u32x4*)(a.sk + go) = *(const u32x4*)(stg + 2304 + lo); *(u32x4*)(a.sv + go) = *(const u32x4*)(stg + 4608 + lo);
                *(u32x4*)(a.skk + go) = *(const u32x4*)(stg + 6912 + lo); *(u32x4*)(a.skka + go) = *(const u32x4*)(stg + 9216 + lo);
            }
#pragma unroll
            for (int i = 0; i < 4; ++i) {
                const int q = lane + 64 * i, tk = q >> 4, c = q & 15;
                *(u32x4*)(a.sw + (size_t)(tlw + tk) * 512 + hh * 64 + c * 4) = *(const u32x4*)(stg + 11520 + tk * 272 + c * 16);
            }
        }
    }
    __syncthreads();
}

struct ScanArgs { const bf16_t *sr, *sk, *sv, *skk, *skka; const float* sw; float* yraw; float* zbuf; float* sfin; };
__device__ __forceinline__ void cvt_store8(float* dst, const u32x4 u) {
    *(f32x4*)dst = (f32x4){bf_lo(u.x), bf_hi(u.x), bf_lo(u.y), bf_hi(u.y)};
    *(f32x4*)(dst + 4) = (f32x4){bf_lo(u.z), bf_hi(u.z), bf_lo(u.w), bf_hi(u.w)};
}
__device__ __forceinline__ void scan_tile(char* smem, const ScanArgs& a, int mode, int bl, int hh, int g) {
    const int tid = otid(), lane = tid & 63, wid = tid >> 6, rl = lane >> 4, c = lane & 15;
    float* L = (float*)smem;
    float* ybuf = L + 2 * 5376;
    const size_t tokbase = (size_t)bl * 4096 + (mode ? 2048 : 0);
    const int colh = hh * 64, i0 = g * 16;
    const bf16_t* src0 = (tid < 128) ? a.skk : a.skka;
    const bf16_t* src1 = (tid < 128) ? a.sk : a.sr;
    const int rem = tid & 127, tokA = rem >> 3, chA = rem & 7;
    const size_t gofsA = (size_t)tokA * 512 + colh + chA * 8;
    const int ldsA0 = (1 + (tid >> 7)) * 1024 + tokA * 64 + chA * 8, ldsA1 = (3 + (tid >> 7)) * 1024 + tokA * 64 + chA * 8;
    const size_t gofsW = (size_t)(tid >> 4) * 512 + colh + (tid & 15) * 4;
    const int ldsW = (tid >> 4) * 64 + (tid & 15) * 4;
    const size_t gofsV = (size_t)((tid & 31) >> 1) * 512 + colh + i0 + (tid & 1) * 8;
    const int ldsV = 5120 + ((tid & 31) >> 1) * 16 + (tid & 1) * 8;
    const bool ldv = tid < 32 && mode != 2;
    f32x2 S01 = (f32x2){0.f, 0.f}, S23 = (f32x2){0.f, 0.f};
    if (mode == 2) { const int d = (i0 + wid * 4 + rl) - c * 4; S01.x = d == 0 ? 1.f : 0.f; S01.y = d == 1 ? 1.f : 0.f; S23.x = d == 2 ? 1.f : 0.f; S23.y = d == 3 ? 1.f : 0.f; }
    u32x4 qa, qb, qv = (u32x4){0u, 0u, 0u, 0u}; f32x4 qw;
    {
        const size_t tb = tokbase * 512;
        qa = *(const u32x4*)(src0 + tb + gofsA); qb = *(const u32x4*)(src1 + tb + gofsA); qw = *(const f32x4*)(a.sw + tb + gofsW);
        if (ldv) qv = *(const u32x4*)(a.sv + tb + gofsV);
        cvt_store8(L + ldsA0, qa); cvt_store8(L + ldsA1, qb); *(f32x4*)(L + ldsW) = qw; if (tid < 32) { cvt_store8(L + ldsV, qv); if (mode == 2) cvt_store8(L + 5376 + ldsV, qv); }
    }
    __syncthreads();
    const int vofs = 5120 + wid * 4 + rl;
#pragma unroll 1
    for (int ch = 0; ch < 128; ++ch) {
        const float* cur = L + (ch & 1) * 5376;
        if (ch + 1 < 128) {
            const size_t tb = (tokbase + (size_t)(ch + 1) * 16) * 512;
            qa = *(const u32x4*)(src0 + tb + gofsA); qb = *(const u32x4*)(src1 + tb + gofsA); qw = *(const f32x4*)(a.sw + tb + gofsW);
            if (ldv) qv = *(const u32x4*)(a.sv + tb + gofsV);
        }
        float* yb = ybuf + (ch & 1) * 256;
        float ykeep = 0.f;
        f32x4 w4 = *(const f32x4*)(cur + c * 4), kk4 = *(const f32x4*)(cur + 1024 + c * 4), ka4 = *(const f32x4*)(cur + 2048 + c * 4);
        f32x4 k4 = *(const f32x4*)(cur + 3072 + c * 4), r4 = *(const f32x4*)(cur + 4096 + c * 4);
        float v = cur[vofs];
        float prevq = 0.f;
#pragma unroll
        for (int s = 0; s < 16; ++s) {
            f32x4 nw4 = w4, nkk4 = kk4, nka4 = ka4, nk4 = k4, nr4 = r4; float nv = v;
            if (s + 1 < 16) {
                nw4 = *(const f32x4*)(cur + (s + 1) * 64 + c * 4); nkk4 = *(const f32x4*)(cur + 1024 + (s + 1) * 64 + c * 4); nka4 = *(const f32x4*)(cur + 2048 + (s + 1) * 64 + c * 4);
                nk4 = *(const f32x4*)(cur + 3072 + (s + 1) * 64 + c * 4); nr4 = *(const f32x4*)(cur + 4096 + (s + 1) * 64 + c * 4);
                nv = cur[vofs + (s + 1) * 16];
            }
            const f32x2 pp = S01 * kk4.xy + S23 * kk4.zw;
            float sa = pp.x + pp.y;
            if (s > 0) { float yq = prevq; dpp_sum16x2(sa, yq); ykeep = (c == s - 1) ? yq : ykeep; }
            else sa = dpp_sum16(sa);
            const f32x2 sa2 = (f32x2){sa, sa}, v2 = (f32x2){v, v};
            S01 = S01 * w4.xy + (v2 * k4.xy - sa2 * ka4.xy);
            S23 = S23 * w4.zw + (v2 * k4.zw - sa2 * ka4.zw);
            const f32x2 qq = S01 * r4.xy + S23 * r4.zw;
            prevq = qq.x + qq.y;
            __builtin_amdgcn_sched_barrier(0);
            w4 = nw4; kk4 = nkk4; ka4 = nka4; k4 = nk4; r4 = nr4; v = nv;
        }
        { const float yq = dpp_sum16(prevq); ykeep = (c == 15) ? yq : ykeep; }
        yb[c * 16 + wid * 4 + rl] = ykeep;
        if (ch + 1 < 128) {
            float* nx = L + ((ch + 1) & 1) * 5376;
            cvt_store8(nx + ldsA0, qa); cvt_store8(nx + ldsA1, qb); *(f32x4*)(nx + ldsW) = qw; if (ldv) cvt_store8(nx + ldsV, qv);
        }
        __syncthreads();
        if (mode != 2) a.yraw[(tokbase + (size_t)ch * 16 + (tid >> 4)) * 512 + colh + i0 + (tid & 15)] = yb[tid];
        else a.zbuf[((size_t)bl * 2048 + (size_t)ch * 16 + (tid >> 4)) * 512 + colh + i0 + (tid & 15)] = yb[tid];
    }
    if (mode == 0) *(f32x4*)(a.sfin + ((size_t)((bl * 8 + hh) * 64 + i0 + wid * 4 + rl)) * 64 + c * 4) = (f32x4){S01.x, S01.y, S23.x, S23.y};
}

__device__ __forceinline__ void attn_tile(char* smem, const bf16_t* __restrict__ Qh, const bf16_t* __restrict__ Kh, const bf16_t* __restrict__ Vt,
                                          const bf16_t* __restrict__ proj, bf16_t* __restrict__ ycat, int bl, int hh, int qt) {
    const int tid = otid(), lane = tid & 63, wid = tid >> 6, fr = lane & 15, fq = lane >> 4;
    const int q0 = qt * 128, tok0 = bl * 4096, qw0 = q0 + wid * 32;
    bf16x8 qf[2][3];
#pragma unroll
    for (int qi = 0; qi < 2; ++qi)
#pragma unroll
        for (int ks = 0; ks < 3; ++ks) qf[qi][ks] = *(const bf16x8*)(Qh + (size_t)(tok0 + qw0 + qi * 16 + fr) * 768 + hh * 96 + ks * 32 + fq * 8);
    f32x4 o[4][2];
#pragma unroll
    for (int i = 0; i < 4; ++i) { o[i][0] = (f32x4){0.f, 0.f, 0.f, 0.f}; o[i][1] = o[i][0]; }
    float m[2] = {-1e30f, -1e30f}, lsum[2] = {0.f, 0.f};
    const int nkv = 2 * (qt + 1);
    const bf16_t* Kb = Kh + (size_t)tok0 * 768 + hh * 96;
    const bf16_t* Vb = Vt + ((size_t)((bl * 8 + hh) * 64)) * 4096;
    int gK[3], lK[3];
#pragma unroll
    for (int i = 0; i < 3; ++i) { const int cid = tid + 256 * i, key = cid / 12, cc = cid - key * 12; gK[i] = key * 768 + cc * 8; lK[i] = key * 224 + cc * 16; }
    int gV[2], lV[2];
#pragma unroll
    for (int i = 0; i < 2; ++i) { const int cid = tid + 256 * i, dv = cid >> 3, cc = cid & 7; gV[i] = dv * 4096 + cc * 8; lV[i] = 14336 + dv * 144 + cc * 16; }
    u32x4 rkA[3], rvA[2], rkB[3], rvB[2];
#define ATT_LOAD(RK, RV, T) do { _Pragma("unroll") for (int i = 0; i < 3; ++i) RK[i] = *(const u32x4*)(Kb + (size_t)((T) * 64) * 768 + gK[i]); \
                                 _Pragma("unroll") for (int i = 0; i < 2; ++i) RV[i] = *(const u32x4*)(Vb + (T) * 64 + gV[i]); } while (0)
#define ATT_WRITE(RK, RV, BUF) do { _Pragma("unroll") for (int i = 0; i < 3; ++i) *(u32x4*)(smem + (BUF) * 23552 + lK[i]) = RK[i]; \
                                    _Pragma("unroll") for (int i = 0; i < 2; ++i) *(u32x4*)(smem + (BUF) * 23552 + lV[i]) = RV[i]; } while (0)
    ATT_LOAD(rkA, rvA, 0);
    ATT_WRITE(rkA, rvA, 0);
    ATT_LOAD(rkA, rvA, 1);
    __syncthreads();
    auto compute = [&](const int j, const char* cur) {
        const int kv0 = j * 64;
        if (kv0 <= qw0 + 31) {
            f32x4 s[4][2];
            {
                bf16x8 kf[4][3];
#pragma unroll
                for (int kt = 0; kt < 4; ++kt)
#pragma unroll
                    for (int ks = 0; ks < 3; ++ks) kf[kt][ks] = *(const bf16x8*)(cur + (kt * 16 + fr) * 224 + (ks * 4 + fq) * 16);
                __builtin_amdgcn_sched_barrier(0);
#pragma unroll
                for (int kt = 0; kt < 4; ++kt)
#pragma unroll
                    for (int qi = 0; qi < 2; ++qi) {
                        f32x4 acc = (f32x4){0.f, 0.f, 0.f, 0.f};
#pragma unroll
                        for (int ks = 0; ks < 3; ++ks) acc = __builtin_amdgcn_mfma_f32_16x16x32_bf16(kf[kt][ks], qf[qi][ks], acc, 0, 0, 0);
                        s[kt][qi] = acc;
                    }
                __builtin_amdgcn_sched_barrier(0);
            }
            bf16x8 vfr[4][2];
#pragma unroll
            for (int dvt = 0; dvt < 4; ++dvt)
#pragma unroll
                for (int kb = 0; kb < 2; ++kb) {
                    const char* vp = cur + 14336 + (dvt * 16 + fr) * 144 + kb * 64 + fq * 8;
                    const u32x2 lo = *(const u32x2*)vp, hi = *(const u32x2*)(vp + 32);
                    vfr[dvt][kb] = __builtin_bit_cast(bf16x8, ((u32x4){lo.x, lo.y, hi.x, hi.y}));
                }
            __builtin_amdgcn_sched_barrier(0);
            if (kv0 + 63 > qw0) {
#pragma unroll
                for (int kt = 0; kt < 4; ++kt)
#pragma unroll
                    for (int qi = 0; qi < 2; ++qi)
#pragma unroll
                        for (int jj = 0; jj < 4; ++jj) { const int kpos = kv0 + kt * 16 + fq * 4 + jj, qpos = qw0 + qi * 16 + fr; if (kpos > qpos) s[kt][qi][jj] = -1e30f; }
            }
#pragma unroll
            for (int qi = 0; qi < 2; ++qi) {
                float mx = -1e30f;
#pragma unroll
                for (int kt = 0; kt < 4; ++kt) mx = fmaxf(mx, fmaxf(fmaxf(s[kt][qi][0], s[kt][qi][1]), fmaxf(s[kt][qi][2], s[kt][qi][3])));
                mx = fmaxf(mx, __shfl_xor(mx, 16)); mx = fmaxf(mx, __shfl_xor(mx, 32));
                const float mnew = fmaxf(m[qi], mx), alpha = __builtin_amdgcn_exp2f(m[qi] - mnew);
                m[qi] = mnew;
                float rs = 0.f;
#pragma unroll
                for (int kt = 0; kt < 4; ++kt)
#pragma unroll
                    for (int jj = 0; jj < 4; ++jj) { const float pexp = __builtin_amdgcn_exp2f(s[kt][qi][jj] - mnew); s[kt][qi][jj] = pexp; rs += pexp; }
                lsum[qi] = lsum[qi] * alpha + rs;
#pragma unroll
                for (int dvt = 0; dvt < 4; ++dvt) o[dvt][qi] = o[dvt][qi] * alpha;
            }
            bf16x8 pf[2][2];
#pragma unroll
            for (int kb = 0; kb < 2; ++kb)
#pragma unroll
                for (int qi = 0; qi < 2; ++qi) {
                    u32x4 t;
                    t.x = pk_bf16(s[2 * kb][qi][0], s[2 * kb][qi][1]); t.y = pk_bf16(s[2 * kb][qi][2], s[2 * kb][qi][3]);
                    t.z = pk_bf16(s[2 * kb + 1][qi][0], s[2 * kb + 1][qi][1]); t.w = pk_bf16(s[2 * kb + 1][qi][2], s[2 * kb + 1][qi][3]);
                    pf[kb][qi] = __builtin_bit_cast(bf16x8, t);
                }
            __builtin_amdgcn_sched_barrier(0);
#pragma unroll
            for (int dvt = 0; dvt < 4; ++dvt)
#pragma unroll
                for (int kb = 0; kb < 2; ++kb)
#pragma unroll
                    for (int qi = 0; qi < 2; ++qi) o[dvt][qi] = __builtin_amdgcn_mfma_f32_16x16x32_bf16(vfr[dvt][kb], pf[kb][qi], o[dvt][qi], 0, 0, 0);
        }
    };
#pragma unroll 1
    for (int j = 0; j < nkv; j += 2) {
        if (j + 2 < nkv) ATT_LOAD(rkB, rvB, j + 2);
        compute(j, smem);
        ATT_WRITE(rkA, rvA, 1);
        __syncthreads();
        if (j + 3 < nkv) ATT_LOAD(rkA, rvA, j + 3);
        compute(j + 1, smem + 23552);
        if (j + 2 < nkv) ATT_WRITE(rkB, rvB, 0);
        __syncthreads();
    }
#undef ATT_LOAD
#undef ATT_WRITE
#pragma unroll
    for (int qi = 0; qi < 2; ++qi) {
        float lt = lsum[qi]; lt += __shfl_xor(lt, 16); lt += __shfl_xor(lt, 32);
        const float inv = 1.0f / lt;
        const int tl = tok0 + qw0 + qi * 16 + fr;
#pragma unroll
        for (int dvt = 0; dvt < 4; ++dvt) {
            const int dv = dvt * 16 + fq * 4;
            const u32x2 gu = *(const u32x2*)(proj + (size_t)tl * NP + O_GM + hh * 64 + dv);
            const f32x4 gg = (f32x4){bf_lo(gu.x), bf_hi(gu.x), bf_lo(gu.y), bf_hi(gu.y)};
            f32x4 r;
#pragma unroll
            for (int jj = 0; jj < 4; ++jj) r[jj] = o[dvt][qi][jj] * inv * siluf_(gg[jj]);
            store4((bf16_t*)(smem + wid * 4608 + (qi * 16 + fr) * 144 + dv * 2), r);
        }
    }
#pragma unroll
    for (int i = 0; i < 4; ++i) {
        const int q = lane + 64 * i, row = q >> 3, c = q & 7;
        *(u32x4*)(ycat + (size_t)(tok0 + qw0 + row) * 1024 + 512 + hh * 64 + c * 8) = *(const u32x4*)(smem + wid * 4608 + row * 144 + c * 16);
    }
}

struct FinArgs { const float* yraw; const bf16_t *sr, *sk, *sv; const bf16_t* proj; const float *lnw, *lnb, *rk; bf16_t* ycat; const float* zbuf; const float* sfin; };
__device__ void rwkv_finalize(const FinArgs& a) {
    const int tid_ = otid(); const int lane = tid_ & 63, gw = blockIdx.x * 4 + (tid_ >> 6), nw = gridDim.x * 4;
    for (int u = gw; u < TH * 2; u += nw) {
        const int tl = u >> 1, ch = ((u & 1) * 4 + (lane >> 4)) * 64 + (lane & 15) * 4;
        f32x4 y = *(const f32x4*)(a.yraw + (size_t)tl * 512 + ch);
        const float mean = dpp_sum16(y.x + y.y + y.z + y.w) * (1.0f / 64.0f);
        const f32x4 d = y - mean;
        const float var = dpp_sum16(d.x * d.x + d.y * d.y + d.z * d.z + d.w * d.w) * (1.0f / 64.0f);
        const float rstd = rsqrtf(var + 64e-5f);
        const u32x2 ur = *(const u32x2*)(a.sr + (size_t)tl * 512 + ch), uk = *(const u32x2*)(a.sk + (size_t)tl * 512 + ch), uv = *(const u32x2*)(a.sv + (size_t)tl * 512 + ch);
        const f32x4 r4 = (f32x4){bf_lo(ur.x), bf_hi(ur.x), bf_lo(ur.y), bf_hi(ur.y)}, k4 = (f32x4){bf_lo(uk.x), bf_hi(uk.x), bf_lo(uk.y), bf_hi(uk.y)};
        const f32x4 v4 = (f32x4){bf_lo(uv.x), bf_hi(uv.x), bf_lo(uv.y), bf_hi(uv.y)};
        const f32x4 rkv = *(const f32x4*)(a.rk + ch), lw = *(const f32x4*)(a.lnw + ch), lb = *(const f32x4*)(a.lnb + ch);
        const f32x4 t = r4 * k4 * rkv;
        const float bon = dpp_sum16(t.x + t.y + t.z + t.w);
        const u32x2 gu = *(const u32x2*)(a.proj + (size_t)tl * NP + O_GR + ch);
        const f32x4 gg = (f32x4){bf_lo(gu.x), bf_hi(gu.x), bf_lo(gu.y), bf_hi(gu.y)};
        f32x4 o = d * rstd * lw + lb + v4 * bon;
#pragma unroll
        for (int j = 0; j < 4; ++j) o[j] *= siluf_(gg[j]);
        store4(a.ycat + (size_t)tl * 1024 + ch, o);
    }
}


struct CopArgs { const bf16_t *sr, *sk, *sv, *skk, *skka; const float* sw; char* cops; };
__device__ __forceinline__ float mm16(const float* A, float sa, float ia, const float* B, float sb, float ib, int t, int j) {
    float acc = 0.f;
#pragma unroll
    for (int i = 0; i < 16; ++i) { const float av = sa * A[t * 17 + i] + (i == t ? ia : 0.f); const float bv = sb * B[i * 17 + j] + (i == j ? ib : 0.f); acc += av * bv; }
    return acc;
}
__device__ __forceinline__ float mm16p(const float* A, const float* B, int t, int j) {
    float acc = 0.f;
#pragma unroll
    for (int q = 0; q < 4; ++q) {
        const f32x4 a4 = *(const f32x4*)(A + t * 20 + q * 4);
        acc += a4.x * B[(q * 4 + 0) * 20 + j] + a4.y * B[(q * 4 + 1) * 20 + j] + a4.z * B[(q * 4 + 2) * 20 + j] + a4.w * B[(q * 4 + 3) * 20 + j];
    }
    return acc;
}
__device__ __forceinline__ f32x4 unpk4(const u32x2 u) { return (f32x4){bf_lo(u.x), bf_hi(u.x), bf_lo(u.y), bf_hi(u.y)}; }
__device__ __forceinline__ bf16_t bf1(float x) { return (bf16_t)(pk_bf16(x, 0.f) & 0xffffu); }
struct CopIn { f32x4 w4; u32x2 ukk, uka, uk, ur, uv; };
__device__ __forceinline__ void cop_in_load(CopIn& r, const CopArgs& a, int unit, int t, int cq) {
    const int c = unit & 255, bh = unit >> 8;
    const size_t gofs = ((size_t)(bh >> 3) * 4096 + c * 16 + t) * 512 + (bh & 7) * 64 + cq * 4;
    r.w4 = *(const f32x4*)(a.sw + gofs);
    r.ukk = *(const u32x2*)(a.skk + gofs); r.uka = *(const u32x2*)(a.skka + gofs); r.uk = *(const u32x2*)(a.sk + gofs); r.ur = *(const u32x2*)(a.sr + gofs); r.uv = *(const u32x2*)(a.sv + gofs);
}
__device__ void cop_phase(char* smem, const CopArgs& a) {
    const int tid = otid(), t = tid >> 4, cq = tid & 15, j = cq;
    float* F = (float*)smem;
    float* Wc = F; float* KAP = F + 1088; float* RT = F + 2176; float* KT = F + 3264; float* BT = F + 4352;
    float* SM = F + 5440;
    bf16_t* STG = (bf16_t*)(F + 5440 + 15 * 320);
#define SMAT(i) (SM + (i) * 320)
    int unit = blockIdx.x;
    if (unit >= 8192) return;
    CopIn cur, nxt;
    cop_in_load(cur, a, unit, t, cq);
    nxt = cur;
#pragma unroll 1
    for (; unit < 8192; unit += gridDim.x) {
        if (unit + (int)gridDim.x < 8192) cop_in_load(nxt, a, unit + gridDim.x, t, cq);
        __syncthreads();
        *(f32x4*)(Wc + t * 68 + cq * 4) = cur.w4;
        __syncthreads();
        if (tid < 64) {
            float x[16];
#pragma unroll
            for (int i = 0; i < 16; ++i) x[i] = Wc[i * 68 + tid];
#pragma unroll
            for (int i = 1; i < 16; ++i) x[i] *= x[i - 1];
#pragma unroll
            for (int i = 0; i < 16; ++i) Wc[i * 68 + tid] = x[i];
        }
        __syncthreads();
        const f32x4 Wt = *(const f32x4*)(Wc + t * 68 + cq * 4);
        f32x4 Wp = (f32x4){1.f, 1.f, 1.f, 1.f}; if (t > 0) Wp = *(const f32x4*)(Wc + (t - 1) * 68 + cq * 4);
        const f32x4 WC = *(const f32x4*)(Wc + 15 * 68 + cq * 4);
        {
            const f32x4 rW = (f32x4){1.0f / Wt.x, 1.0f / Wt.y, 1.0f / Wt.z, 1.0f / Wt.w};
            *(f32x4*)(KAP + t * 68 + cq * 4) = unpk4(cur.ukk) * Wp;
            *(f32x4*)(RT + t * 68 + cq * 4) = unpk4(cur.ur) * Wt;
            *(f32x4*)(KT + t * 68 + cq * 4) = unpk4(cur.uk) * rW;
            *(f32x4*)(BT + t * 68 + cq * 4) = unpk4(cur.uka) * rW;
        }
        __syncthreads();
        {
            float m1 = 0.f, m2 = 0.f, m3 = 0.f, m4 = 0.f;
#pragma unroll 4
            for (int i = 0; i < 16; ++i) {
                const f32x4 ka = *(const f32x4*)(KAP + t * 68 + i * 4), rt = *(const f32x4*)(RT + t * 68 + i * 4), kt = *(const f32x4*)(KT + j * 68 + i * 4), bt = *(const f32x4*)(BT + j * 68 + i * 4);
                m1 += ka.x * kt.x + ka.y * kt.y + ka.z * kt.z + ka.w * kt.w; m2 += ka.x * bt.x + ka.y * bt.y + ka.z * bt.z + ka.w * bt.w;
                m3 += rt.x * kt.x + rt.y * kt.y + rt.z * kt.z + rt.w * kt.w; m4 += rt.x * bt.x + rt.y * bt.y + rt.z * bt.z + rt.w * bt.w;
            }
            const float idv = t == j ? 1.f : 0.f;
            SMAT(0)[t * 20 + j] = j < t ? m1 : 0.f; SMAT(1)[t * 20 + j] = j < t ? m2 : 0.f; SMAT(2)[t * 20 + j] = j <= t ? m3 : 0.f; SMAT(3)[t * 20 + j] = j <= t ? m4 : 0.f;
            SMAT(12)[t * 20 + j] = idv - (j < t ? m2 : 0.f);
        }
        __syncthreads();
        const float idv = t == j ? 1.f : 0.f;
        { const float v = mm16p(SMAT(1), SMAT(1), t, j); SMAT(4)[t * 20 + j] = v; SMAT(13)[t * 20 + j] = v + idv; } __syncthreads();
        { const float v = mm16p(SMAT(4), SMAT(4), t, j); SMAT(5)[t * 20 + j] = v; SMAT(14)[t * 20 + j] = v + idv;
          SMAT(7)[t * 20 + j] = mm16p(SMAT(12), SMAT(13), t, j); } __syncthreads();
        SMAT(6)[t * 20 + j] = mm16p(SMAT(5), SMAT(5), t, j) + idv;
        SMAT(8)[t * 20 + j] = mm16p(SMAT(7), SMAT(14), t, j); __syncthreads();
        SMAT(9)[t * 20 + j] = mm16p(SMAT(8), SMAT(6), t, j); __syncthreads();
        SMAT(10)[t * 20 + j] = mm16p(SMAT(9), SMAT(0), t, j);
        SMAT(11)[t * 20 + j] = mm16p(SMAT(3), SMAT(9), t, j); __syncthreads();
        char* U = a.cops + (size_t)unit * COP_STRIDE;
        ((bf16_t*)(U + 4096))[t * 16 + j] = bf1(SMAT(2)[t * 20 + j] - mm16p(SMAT(11), SMAT(0), t, j));
        f32x4 q3 = (f32x4){0.f, 0.f, 0.f, 0.f}, q1 = *(const f32x4*)(RT + t * 68 + cq * 4), kh = *(const f32x4*)(KT + t * 68 + cq * 4);
#pragma unroll 4
        for (int i = 0; i < 16; ++i) {
            const f32x4 kap = *(const f32x4*)(KAP + i * 68 + cq * 4), bt = *(const f32x4*)(BT + i * 68 + cq * 4);
            q3 += kap * SMAT(9)[t * 20 + i]; q1 -= kap * SMAT(11)[t * 20 + i]; kh -= bt * SMAT(10)[i * 20 + t];
        }
        kh = kh * WC;
        const f32x4 bhv = *(const f32x4*)(BT + t * 68 + cq * 4) * WC;
        const int p0 = 32 * (cq >> 3) + 8 * (cq & 3) + 4 * ((cq >> 2) & 1);
        store4((bf16_t*)U + t * 64 + p0, q3);
        store4((bf16_t*)U + (16 + t) * 64 + p0, q1);
        const int so = (t >> 2) * 8 + (t & 3);
#pragma unroll
        for (int jj = 0; jj < 4; ++jj) { STG[(cq * 4 + jj) * 32 + so] = bf1(bhv[jj]); STG[(cq * 4 + jj) * 32 + so + 4] = bf1(kh[jj]); }
        STG[2048 + (cq * 4 + 0) * 16 + t] = (bf16_t)(cur.uv.x & 0xffffu); STG[2048 + (cq * 4 + 1) * 16 + t] = (bf16_t)(cur.uv.x >> 16);
        STG[2048 + (cq * 4 + 2) * 16 + t] = (bf16_t)(cur.uv.y & 0xffffu); STG[2048 + (cq * 4 + 3) * 16 + t] = (bf16_t)(cur.uv.y >> 16);
        if (tid < 64) ((float*)(U + 10752))[tid] = Wc[15 * 68 + tid];
        __syncthreads();
        *(u32x4*)(U + 4608 + tid * 16) = *(const u32x4*)((const char*)STG + tid * 16);
        if (tid < 128) *(u32x4*)(U + 8704 + tid * 16) = *(const u32x4*)((const char*)STG + 4096 + tid * 16);
        cur = nxt;
    }
#undef SMAT
}

__device__ __forceinline__ int cop_lds_of(int q) {
    if (q < 256) { const int row = q >> 3, pos = q & 7; return row * 128 + ((pos ^ ((row >> 1) & 7)) << 4); }
    if (q < 288) return q * 16;
    if (q < 544) { const int q2 = q - 288; return 4608 + (q2 & 3) * 1024 + (q2 >> 2) * 16; }
    return q * 16;
}
struct CopOps { u32x4 qc[2][2]; u32x2 q2; u32x4 bk[4]; u32x2 vt; f32x4 wc[4]; };
__device__ void chunk_scan(char* smem, const char* cops, float* yraw, int bl, int hh) {
    const int tid = otid(), lane = tid & 63, w = tid >> 6, fr = lane & 15, fq = lane >> 4;
    f32x4 st[4];
#pragma unroll
    for (int kt = 0; kt < 4; ++kt) st[kt] = (f32x4){0.f, 0.f, 0.f, 0.f};
    const char* U = cops + (size_t)((bl * 8 + hh) * 256) * COP_STRIDE + tid * 16;
    float* yp = yraw + ((size_t)bl * 4096 + fq * 4) * 512 + hh * 64 + w * 16 + fr;
    const int l0 = cop_lds_of(tid), l1 = cop_lds_of(tid + 256), l2 = cop_lds_of(tid < 176 ? tid + 512 : 0);
    const bool has2 = tid < 176;
    const int qo0 = fr * 128 + (((0 * 4 + fq) ^ ((fr >> 1) & 7)) << 4), qo1 = fr * 128 + (((1 * 4 + fq) ^ ((fr >> 1) & 7)) << 4);
    const int q2o = 4096 + fr * 32 + fq * 8, bko = 4608 + fq * 1024 + fr * 16, vto = 8704 + (w * 16 + fr) * 32 + fq * 8, wco = 10752 + fq * 16;
    u32x4 sA[3], sB[3], sC[3], sD[3];
    __builtin_amdgcn_s_setprio(3);
#define CS_LOAD(S, C) do { const char* g_ = U + (size_t)(C) * COP_STRIDE; S[0] = *(const u32x4*)g_; S[1] = *(const u32x4*)(g_ + 4096); if (has2) S[2] = *(const u32x4*)(g_ + 8192); } while (0)
#define CS_WRITE(S, SLOT) do { char* d_ = smem + (SLOT) * 11008; *(u32x4*)(d_ + l0) = S[0]; *(u32x4*)(d_ + l1) = S[1]; if (has2) *(u32x4*)(d_ + l2) = S[2]; } while (0)
    sA[2] = (u32x4){0u, 0u, 0u, 0u}; sB[2] = sA[2]; sC[2] = sA[2]; sD[2] = sA[2];
    CS_LOAD(sA, 0); CS_LOAD(sB, 1); CS_LOAD(sC, 2); CS_LOAD(sD, 3);
    CopOps R0, R1;
    auto ldsload = [&](CopOps& r, const char* L) {
        r.qc[0][0] = *(const u32x4*)(L + qo0); r.qc[0][1] = *(const u32x4*)(L + qo1); r.qc[1][0] = *(const u32x4*)(L + 2048 + qo0); r.qc[1][1] = *(const u32x4*)(L + 2048 + qo1);
        r.q2 = *(const u32x2*)(L + q2o); r.vt = *(const u32x2*)(L + vto);
#pragma unroll
        for (int kt = 0; kt < 4; ++kt) { r.bk[kt] = *(const u32x4*)(L + bko + kt * 256); r.wc[kt] = *(const f32x4*)(L + wco + kt * 64); }
    };
    auto compute = [&](const int c, const CopOps& r) {
        const u32x4 (&qc)[2][2] = r.qc; const u32x4 (&bk)[4] = r.bk; const f32x4 (&wc)[4] = r.wc; const u32x2 q2 = r.q2, vt = r.vt;
        u32x4 hi[2], lo[2];
#pragma unroll
        for (int s = 0; s < 2; ++s) {
            const f32x4 a0 = st[2 * s], a1 = st[2 * s + 1];
            hi[s].x = pk_bf16(a0.x, a0.y); hi[s].y = pk_bf16(a0.z, a0.w); hi[s].z = pk_bf16(a1.x, a1.y); hi[s].w = pk_bf16(a1.z, a1.w);
            lo[s].x = pk_bf16(a0.x - bf_lo(hi[s].x), a0.y - bf_hi(hi[s].x)); lo[s].y = pk_bf16(a0.z - bf_lo(hi[s].y), a0.w - bf_hi(hi[s].y));
            lo[s].z = pk_bf16(a1.x - bf_lo(hi[s].z), a1.y - bf_hi(hi[s].z)); lo[s].w = pk_bf16(a1.z - bf_lo(hi[s].w), a1.w - bf_hi(hi[s].w));
        }
        f32x4 p1 = (f32x4){0.f, 0.f, 0.f, 0.f}, p2 = p1;
#pragma unroll
        for (int s = 0; s < 2; ++s) {
            p1 = __builtin_amdgcn_mfma_f32_16x16x32_bf16(__builtin_bit_cast(bf16x8, qc[0][s]), __builtin_bit_cast(bf16x8, hi[s]), p1, 0, 0, 0);
            p2 = __builtin_amdgcn_mfma_f32_16x16x32_bf16(__builtin_bit_cast(bf16x8, qc[1][s]), __builtin_bit_cast(bf16x8, hi[s]), p2, 0, 0, 0);
            p1 = __builtin_amdgcn_mfma_f32_16x16x32_bf16(__builtin_bit_cast(bf16x8, qc[0][s]), __builtin_bit_cast(bf16x8, lo[s]), p1, 0, 0, 0);
            p2 = __builtin_amdgcn_mfma_f32_16x16x32_bf16(__builtin_bit_cast(bf16x8, qc[1][s]), __builtin_bit_cast(bf16x8, lo[s]), p2, 0, 0, 0);
        }
        p2 = __builtin_amdgcn_mfma_f32_16x16x32_bf16(__builtin_bit_cast(bf16x8, ((u32x4){q2.x, q2.y, 0u, 0u})), __builtin_bit_cast(bf16x8, ((u32x4){vt.x, vt.y, 0u, 0u})), p2, 0, 0, 0);
#pragma unroll
        for (int j = 0; j < 4; ++j) yp[(size_t)(c * 16 + j) * 512] = p2[j];
        u32x4 xh, xl;
        xh.x = pk_bf16(-p1.x, -p1.y); xh.y = pk_bf16(-p1.z, -p1.w); xh.z = vt.x; xh.w = vt.y;
        xl.x = pk_bf16(-p1.x - bf_lo(xh.x), -p1.y - bf_hi(xh.x)); xl.y = pk_bf16(-p1.z - bf_lo(xh.y), -p1.w - bf_hi(xh.y)); xl.z = 0u; xl.w = 0u;
#pragma unroll
        for (int kt = 0; kt < 4; ++kt) {
            f32x4 acc = st[kt] * wc[kt];
            acc = __builtin_amdgcn_mfma_f32_16x16x32_bf16(__builtin_bit_cast(bf16x8, bk[kt]), __builtin_bit_cast(bf16x8, xh), acc, 0, 0, 0);
            acc = __builtin_amdgcn_mfma_f32_16x16x32_bf16(__builtin_bit_cast(bf16x8, bk[kt]), __builtin_bit_cast(bf16x8, xl), acc, 0, 0, 0);
            st[kt] = acc;
        }
    };
    CS_WRITE(sA, 0); CS_LOAD(sA, 4);
    __syncthreads();
    ldsload(R0, smem);
#define CS_STEP(S, C, RC, RN) do { if ((C) + 1 < 256) CS_WRITE(S, ((C) + 1) & 1); if ((C) + 5 < 256) CS_LOAD(S, (C) + 5); __syncthreads(); \
        if ((C) + 1 < 256) ldsload(RN, smem + (((C) + 1) & 1) * 11008); compute((C), RC); } while (0)
#pragma unroll 1
    for (int c = 0; c < 256; c += 4) { CS_STEP(sB, c, R0, R1); CS_STEP(sC, c + 1, R1, R0); CS_STEP(sD, c + 2, R0, R1); CS_STEP(sA, c + 3, R1, R0); }
#undef CS_STEP
#undef CS_LOAD
#undef CS_WRITE
    __builtin_amdgcn_s_setprio(0);
    __syncthreads();
}

__global__ void __launch_bounds__(256, 2) fwd_megakernel(Params p) {
    __shared__ __attribute__((aligned(16))) char smem[65536 + 64];
    cg::grid_group grid = cg::this_grid();
    if (threadIdx.x == 0) { ((volatile LAS unsigned*)(smem + 65536))[0] = 0u; ((volatile LAS unsigned*)(smem + 65536))[1] = 0u; }
    __syncthreads();
    const XcdBarrier xb = xcd_barrier_post((unsigned*)(p.ws + OFF_BAR), (volatile LAS unsigned*)(smem + 65536));
    const unsigned cu_key = (xb.x & 7u) * 256u + ((unsigned)__builtin_amdgcn_s_getreg((7 << 11) | (8 << 6) | 4) & 0xffu);
    if (threadIdx.x == 0) (void)xb_add((unsigned*)(p.ws + OFF_CUCNT) + cu_key, 1u);
    char* ws = p.ws;
    float* mod = (float*)(ws + OFF_MOD);
    const float* cs = (const float*)(ws + OFF_COS); const float* sn = (const float*)(ws + OFF_SIN);
    bf16_t* hbuf = (bf16_t*)(ws + OFF_H);
    bf16_t* proj = (bf16_t*)(ws + OFF_PROJ);
    bf16_t *sr = (bf16_t*)(ws + OFF_SR), *sk = (bf16_t*)(ws + OFF_SK), *sv = (bf16_t*)(ws + OFF_SV), *skk = (bf16_t*)(ws + OFF_SKK), *skka = (bf16_t*)(ws + OFF_SKKA);
    float* sw = (float*)(ws + OFF_SW);
    float *rsq = (float*)(ws + OFF_RSQ), *rskv = (float*)(ws + OFF_RSKV);
    bf16_t *Qh = (bf16_t*)(ws + OFF_Q), *Kh = (bf16_t*)(ws + OFF_K), *Vt = (bf16_t*)(ws + OFF_VT);
    float* yraw = (float*)(ws + OFF_YRAW);
    bf16_t* ycat = (bf16_t*)(ws + OFF_YCAT);
    bf16_t* vfirst = (bf16_t*)(ws + OFF_VFIRST);
    int* ctrl = (int*)(ws + OFF_CTRL);
    volatile int* s_item = (volatile int*)(smem + 65536 + 16);

    for (int rep = 0; rep < REP_P0; ++rep) prologue(smem, p);
    grid.sync();
    bool scan_role;
    {
        const unsigned k2 = (cu_key & ~255u) + threadIdx.x;
        const int lidx = __syncthreads_count(k2 < cu_key && xb_ld((unsigned*)(p.ws + OFF_CUCNT) + k2) > 0u);
        scan_role = lidx < 24;
    }

    norm_phase(p.x, p.norm_g, mod, hbuf, 0);
    GSYNC();
#pragma unroll 1
    for (int l = 0; l < NL; ++l) {
        const float* modl = mod + (size_t)l * 8 * 3072;
#pragma unroll 1
        for (int half = 0; half < 2; ++half) {
            const int tgbase = half * TH;
            {
                EpiProj e{proj, rsq, rskv, smem};
                const bf16_t* A = hbuf; const bf16_t* Bt = (const bf16_t*)(ws + OFF_WIN) + (size_t)l * NP * 1024;
                const int xcd = blockIdx.x & 7, loc = blockIdx.x >> 3, nloc = gridDim.x >> 3;
                for (int rep = 0; rep < REP_P2; ++rep) {
                if (rep) xcd_barrier(xb);
                for (int jn = loc; jn < 432; jn += nloc) {
                    const int mg = jn / 216, rem = jn - mg * 216, nt = rem >> 3, mi = rem & 7, mt = xcd * 16 + mg * 8 + mi;
                    gemm_tile(smem, A, 1024, Bt, 1024, 1024, mt * 128, nt * 128, e);
                }
                }
            }
            GSYNC();
            {
                PrepArgs pa;
                pa.proj = proj; pa.mu = p.mu_shift + l * 1664; pa.muv = p.mu_vmix + (l > 0 ? (l - 1) * 32 : 0);
                pa.wdec = (const bf16_t*)(ws + OFF_WDEC) + (size_t)l * 512 * 64; pa.wicl = (const bf16_t*)(ws + OFF_WICL) + (size_t)l * 512 * 64;
                pa.wvm = (const bf16_t*)(ws + OFF_WVM) + (size_t)l * 512 * 32;
                pa.w0 = p.w0 + l * 512; pa.a0 = p.a0 + l * 512; pa.v0 = p.v0 + (l > 0 ? (l - 1) * 512 : 0); pa.k_k = p.k_k + l * 512; pa.k_a = p.k_a + l * 512;
                pa.cs = cs; pa.sn = sn; pa.sr = sr; pa.sk = sk; pa.sv = sv; pa.skk = skk; pa.skka = skka; pa.sw = sw; pa.vfirst = vfirst; pa.Kh = Kh;
                pa.layer = l; pa.tgbase = tgbase;
                EpiKV ekv{Kh, Vt, rskv, smem};
                EpiQ eq{Qh, rsq, cs, sn, tgbase, smem};
                const bf16_t* Bkv = (const bf16_t*)(ws + OFF_WUKV) + (size_t)l * 1024 * 256; const bf16_t* Bq = (const bf16_t*)(ws + OFF_WUQ) + (size_t)l * 768 * 384;
                for (int rep = 0; rep < REP_P3; ++rep) {
                if (rep) xcd_barrier(xb);
                {
                    for (int it = blockIdx.x; it < 1024; it += gridDim.x) prep_tile(smem, pa, it >> 2, it & 3);
                    const int xcd = blockIdx.x & 7, loc = blockIdx.x >> 3, nloc = gridDim.x >> 3;
                    for (int j = loc; j < 128; j += nloc) gemm_tile(smem, proj + O_CKV, NP, Bkv, 256, 256, (xcd * 16 + (j >> 3)) * 128, (j & 7) * 128, ekv);
                    for (int j = loc; j < 96; j += nloc) { const int ml = j / 6, nt = j - ml * 6; gemm_tile(smem, proj + O_CQ, NP, Bq, 384, 384, (xcd * 16 + ml) * 128, nt * 128, eq); }
                }
                }
            }
            GSYNC();
            {
                CopArgs ca{sr, sk, sv, skk, skka, sw, ws + OFF_COPS};
                cop_phase(smem, ca);
            }
            GSYNC();
            {
                int* ctr = ctrl + (l * 2 + half);
                for (;;) {
                    __syncthreads();
                    if (threadIdx.x == 0) *s_item = atomicAdd(ctr, 1);
                    __syncthreads();
                    const int item = *s_item;
                    const int nconv = (half == 0 && l + 1 < NL) ? 512 : 0;
                    if (item >= 32 + 1024 + nconv) break;
                    if (item < 32) chunk_scan(smem, ws + OFF_COPS, yraw, item >> 3, item & 7);
                    else if (item < 32 + 1024) { const int t = item - 32, qt = 31 - (t >> 5), bh = t & 31; attn_tile(smem, Qh, Kh, Vt, proj, ycat, bh >> 3, bh & 7, qt); }
                    else convert_layer(smem, p, l + 1, item - (32 + 1024), 512);
                }
            }
            GSYNC();
            {
                FinArgs fa{yraw, sr, sk, sv, proj, p.lnx_w + l * 512, p.lnx_b + l * 512, p.r_k + l * 512, ycat, nullptr, nullptr};
                for (int rep = 0; rep < REP_P5; ++rep) { if (rep) xcd_barrier(xb); rwkv_finalize(fa); }
                const int ln = half == 0 ? l : l + 1, hn = half ^ 1;
                if (ln < NL) norm_phase(ln == 0 ? p.x : p.out, p.norm_g + ln * 1024, mod + (size_t)ln * 8 * 3072, hbuf, hn * TH);
            }
            GSYNC();
            {
                for (int rep = 0; rep < REP_P6; ++rep) {
                if (rep) xcd_barrier(xb);
                EpiOut eo{l == 0 ? p.x : p.out, p.out, modl, tgbase, rep == REP_P6 - 1 ? 1.0f : 0.0f};
                const bf16_t* Bo = (const bf16_t*)(ws + OFF_WOUT) + (size_t)l * 1024 * 1024;
                {
                    const int xcd = blockIdx.x & 7, loc = blockIdx.x >> 3, nloc = gridDim.x >> 3;
                    for (int j = loc; j < 128; j += nloc) gemm_tile(smem, ycat, 1024, Bo, 1024, 1024, (xcd * 16 + (j >> 3)) * 128, (j & 7) * 128, eo);
                }
                }
            }
        }
    }
    GSYNC();
    final_norm(p.out, p.final_g);
}

extern "C" void kernel_launch(void* const* d_in, const int* in_sizes, int n_in, void* d_out, int out_size, void* d_ws, size_t ws_size, hipStream_t stream) {
    static int grid_blocks = 0;
    if (!grid_blocks) {
        int dev = 0, cus = 0, per_cu = 0;
        (void)hipGetDevice(&dev);
        (void)hipDeviceGetAttribute(&cus, hipDeviceAttributeMultiprocessorCount, dev);
        (void)hipOccupancyMaxActiveBlocksPerMultiprocessor(&per_cu, fwd_megakernel, 256, 0);
        if (per_cu > 2) per_cu = 2;
        if (per_cu < 1) per_cu = 1;
        grid_blocks = cus * per_cu;
        if (grid_blocks % 8) grid_blocks -= grid_blocks % 8;
    }
    Params p{};
    p.x = (const float*)d_in[0]; p.c = (const float*)d_in[1]; p.pos = (const int*)d_in[2];
    p.norm_g = (const float*)d_in[3]; p.w_ada = (const float*)d_in[4]; p.b_ada = (const float*)d_in[5]; p.w_in = (const float*)d_in[6];
    p.w_vmd = (const float*)d_in[7]; p.mu_shift = (const float*)d_in[8]; p.mu_vmix = (const float*)d_in[9]; p.w0 = (const float*)d_in[10];
    p.w_dec = (const float*)d_in[11]; p.a0 = (const float*)d_in[12]; p.w_icl = (const float*)d_in[13]; p.v0 = (const float*)d_in[14];
    p.w_vmu = (const float*)d_in[15]; p.k_k = (const float*)d_in[16]; p.k_a = (const float*)d_in[17]; p.r_k = (const float*)d_in[18];
    p.lnx_w = (const float*)d_in[19]; p.lnx_b = (const float*)d_in[20]; p.qng = (const float*)d_in[21]; p.kvng = (const float*)d_in[22];
    p.w_uq = (const float*)d_in[23]; p.w_ukv = (const float*)d_in[24]; p.w_out = (const float*)d_in[25]; p.final_g = (const float*)d_in[26];
    p.out = (float*)d_out; p.ws = (char*)d_ws;
    (void)hipMemsetAsync((char*)d_ws + OFF_BAR, 0, 16384 + 4096 + 8192, stream);
    void* args[] = {&p};
    hipError_t e = hipLaunchCooperativeKernel((void*)fwd_megakernel, dim3(grid_blocks), dim3(256), args, 0, stream);
    if (e != hipSuccess) fprintf(stderr, "cooperative launch failed: %s (grid %d)\n", hipGetErrorString(e), grid_blocks);
}
```

```cpp
#include <hip/hip_runtime.h>
#include <hip/hip_cooperative_groups.h>
#include <cstdio>
#include <cstdint>
namespace cg = cooperative_groups;
constexpr int REP_P1 = 1, REP_P2 = 1, REP_P3 = 1, REP_P4 = 1, REP_P5 = 1, REP_P6 = 1, REP_SYNC = 1, REP_P0 = 1;
#define GSYNC() do { for (int r_ = 0; r_ < REP_SYNC; ++r_) xcd_barrier(xb); } while (0)


typedef unsigned short bf16_t;
typedef short bf16x8 __attribute__((ext_vector_type(8)));
typedef float f32x4 __attribute__((ext_vector_type(4)));
typedef float f32x2 __attribute__((ext_vector_type(2)));
typedef unsigned u32x4 __attribute__((ext_vector_type(4)));
typedef unsigned u32x2 __attribute__((ext_vector_type(2)));
#define LAS __attribute__((address_space(3)))

constexpr int DM = 1024, NB = 8, SEQ = 4096, NT = NB * SEQ, TH = NT / 2, NL = 4;
constexpr int NP = 3456;
constexpr int O_GR = 1664, O_CQ = 2176, O_CKV = 2560, O_KR = 2816, O_GM = 2848, INW = 3360;
constexpr float QSCALE = 0.10206207261596577f * 1.4426950408889634f;

constexpr size_t al256(size_t x) { return (x + 255) & ~(size_t)255; }
constexpr size_t OFF_BAR = 0;
constexpr size_t OFF_CTRL = 16384;
constexpr size_t OFF_CUCNT = 16384 + 4096;
constexpr size_t OFF_MOD = 16384 + 4096 + 8192;
constexpr size_t OFF_COS = OFF_MOD + al256((size_t)NL * NB * 3072 * 4);
constexpr size_t OFF_SIN = OFF_COS + (size_t)NT * 16 * 4;
constexpr size_t OFF_WIN = OFF_SIN + (size_t)NT * 16 * 4;
constexpr size_t OFF_WOUT = OFF_WIN + (size_t)NL * NP * 1024 * 2;
constexpr size_t OFF_WUQ = OFF_WOUT + (size_t)NL * 1024 * 1024 * 2;
constexpr size_t OFF_WUKV = OFF_WUQ + (size_t)NL * 768 * 384 * 2;
constexpr size_t OFF_WDEC = OFF_WUKV + (size_t)NL * 1024 * 256 * 2;
constexpr size_t OFF_WICL = OFF_WDEC + (size_t)NL * 512 * 64 * 2;
constexpr size_t OFF_WVM = OFF_WICL + (size_t)NL * 512 * 64 * 2;
constexpr size_t OFF_VFIRST = OFF_WVM + (size_t)NL * 512 * 32 * 2;
constexpr size_t OFF_H = OFF_VFIRST + (size_t)NT * 512 * 2;
constexpr int COP_STRIDE = 11008;
constexpr size_t OFF_COPS = OFF_H;
constexpr size_t OFF_PROJ = OFF_H + (size_t)8192 * COP_STRIDE;
constexpr size_t OFF_SR = OFF_PROJ + (size_t)TH * NP * 2;
constexpr size_t OFF_SK = OFF_SR + (size_t)TH * 512 * 2;
constexpr size_t OFF_SV = OFF_SK + (size_t)TH * 512 * 2;
constexpr size_t OFF_SKK = OFF_SV + (size_t)TH * 512 * 2;
constexpr size_t OFF_SKKA = OFF_SKK + (size_t)TH * 512 * 2;
constexpr size_t OFF_SW = OFF_SKKA + (size_t)TH * 512 * 2;
constexpr size_t OFF_RSQ = OFF_SW + (size_t)TH * 512 * 4;
constexpr size_t OFF_RSKV = OFF_RSQ + (size_t)TH * 8 * 4;
constexpr size_t OFF_Q = OFF_RSKV + (size_t)TH * 4 * 4;
constexpr size_t OFF_K = OFF_Q + (size_t)TH * 768 * 2;
constexpr size_t OFF_VT = OFF_K + (size_t)TH * 768 * 2;
constexpr size_t OFF_YRAW = OFF_VT + (size_t)TH * 512 * 2;
constexpr size_t OFF_YCAT = OFF_YRAW + (size_t)TH * 512 * 4;
constexpr size_t WS_TOTAL = OFF_YCAT + (size_t)TH * 1024 * 2;
static_assert(WS_TOTAL <= (size_t)536870912, "workspace exceeds 512 MiB");

struct Params {
    const float *x, *c; const int* pos;
    const float *norm_g, *w_ada, *b_ada, *w_in, *w_vmd, *mu_shift, *mu_vmix, *w0, *w_dec, *a0, *w_icl, *v0, *w_vmu;
    const float *k_k, *k_a, *r_k, *lnx_w, *lnx_b, *qng, *kvng, *w_uq, *w_ukv, *w_out, *final_g;
    float* out; char* ws;
};

__device__ __forceinline__ int otid() { int t = threadIdx.x; asm volatile("" : "+v"(t)); return t; }
__device__ __forceinline__ unsigned pk_bf16(float lo, float hi) { unsigned r; asm("v_cvt_pk_bf16_f32 %0, %1, %2" : "=v"(r) : "v"(lo), "v"(hi)); return r; }
__device__ __forceinline__ float bf_lo(unsigned u) { return __uint_as_float(u << 16); }
__device__ __forceinline__ float bf_hi(unsigned u) { return __uint_as_float(u & 0xffff0000u); }
__device__ __forceinline__ float sigmoidf_(float x) { return 1.0f / (1.0f + __expf(-x)); }
__device__ __forceinline__ float siluf_(float x) { return x / (1.0f + __expf(-x)); }
__device__ __forceinline__ float tanhf_(float x) { const float t = __expf(2.0f * x); return 1.0f - 2.0f / (t + 1.0f); }
template <int CTRL> __device__ __forceinline__ float dpp_add(float x) {
    return x + __int_as_float(__builtin_amdgcn_update_dpp(0, __float_as_int(x), CTRL, 0xf, 0xf, true));
}
__device__ __forceinline__ float dpp_sum16(float x) {
    x = dpp_add<0xB1>(x);
    x = dpp_add<0x4E>(x);
    x = dpp_add<0x141>(x);
    x = dpp_add<0x140>(x);
    return x;
}
__device__ __forceinline__ void dpp_sum16x2(float& a, float& b) {
    a = dpp_add<0xB1>(a); b = dpp_add<0xB1>(b);
    a = dpp_add<0x4E>(a); b = dpp_add<0x4E>(b);
    a = dpp_add<0x141>(a); b = dpp_add<0x141>(b);
    a = dpp_add<0x140>(a); b = dpp_add<0x140>(b);
}
__device__ __forceinline__ float wave_sum64(float x) {
    x += __shfl_xor(x, 1); x += __shfl_xor(x, 2); x += __shfl_xor(x, 4); x += __shfl_xor(x, 8); x += __shfl_xor(x, 16); x += __shfl_xor(x, 32);
    return x;
}


#define XB_TMO      128
#define XB_XCNT(j)  (256  + 64 * (j))
#define XB_XSUB(j)  (1280 + 64 * (j))
#define XB_XGEN(j)  (2304 + 64 * (j))
#define XB_TOP      3328
#define XB_TOPGEN   3392
#define XCD_BAR_WORDS 3456
#define XB_SPIN_CAP (1u << 18)
__device__ __forceinline__ unsigned xb_ld(unsigned* p)              { return __hip_atomic_load(p, __ATOMIC_RELAXED, __HIP_MEMORY_SCOPE_AGENT); }
__device__ __forceinline__ unsigned xb_add(unsigned* p, unsigned v) { return __hip_atomic_fetch_add(p, v, __ATOMIC_RELAXED, __HIP_MEMORY_SCOPE_AGENT); }
__device__ __forceinline__ unsigned xb_xcc_id() { return (unsigned)__builtin_amdgcn_s_getreg((3 << 11) | 20) & 0xFu; }
#define XB_SPIN(cond, bar) do { unsigned _sp = 0; while (cond) { __builtin_amdgcn_s_sleep(1); \
    if ((++_sp & 255u) == 0u) { if (xb_ld(&(bar)[XB_TMO])) break; if (_sp > XB_SPIN_CAP) { atomicAdd(&(bar)[XB_TMO], 1u); break; } } } } while (0)
struct XcdBarrier { unsigned* bar; unsigned x; volatile LAS unsigned* st; };
__device__ __forceinline__ XcdBarrier xcd_barrier_post(unsigned* bar, volatile LAS unsigned* st) {
    XcdBarrier b; b.bar = bar; b.x = xb_xcc_id(); b.st = st;
    if (threadIdx.x == 0) (void)xb_add(&bar[XB_XCNT(b.x)], 1u);
    return b;
}
__device__ __forceinline__ void xcd_barrier_complete(unsigned* bar, unsigned x, unsigned& nloc, unsigned& nx) {
    const unsigned G = gridDim.x * gridDim.y * gridDim.z;
    unsigned sum, cnt, mine, sp = 0u;
    for (;;) {
        sum = 0u; cnt = 0u; mine = 0u;
#pragma unroll
        for (unsigned j = 0; j < 16; ++j) { const unsigned c = xb_ld(&bar[XB_XCNT(j)]); sum += c; cnt += (c > 0u) ? 1u : 0u; mine = (j == x) ? c : mine; }
        if (sum == G) break;
        __builtin_amdgcn_s_sleep(1);
        if ((++sp & 255u) == 0u) { if (xb_ld(&bar[XB_TMO])) break; if (sp > XB_SPIN_CAP) { atomicAdd(&bar[XB_TMO], 1u); break; } }
    }
    nloc = mine > 0u ? mine : 1u; nx = cnt > 0u ? cnt : 1u;
}
__device__ __forceinline__ void xcd_barrier(const XcdBarrier& b) {
    asm volatile("s_waitcnt vmcnt(0)" ::: "memory");
    __syncthreads();
    if (threadIdx.x == 0) {
        unsigned* bar = b.bar;
        __builtin_amdgcn_s_waitcnt(0);
        unsigned nloc = b.st[0], nx = b.st[1];
        if (nloc == 0u) { xcd_barrier_complete(bar, b.x, nloc, nx); b.st[0] = nloc; b.st[1] = nx; }
        const unsigned old = xb_add(&bar[XB_XSUB(b.x)], 1u);
        const unsigned gen = old / nloc;
        if (old + 1u == (gen + 1u) * nloc) {
            __builtin_amdgcn_fence(__ATOMIC_RELEASE, "agent");
            asm volatile("s_waitcnt vmcnt(0)" ::: "memory");
            const unsigned og = xb_add(&bar[XB_TOP], 1u);
            const unsigned tg = og / nx;
            if (og + 1u == (tg + 1u) * nx) xb_add(&bar[XB_TOPGEN], 1u);
            else XB_SPIN(xb_ld(&bar[XB_TOPGEN]) == tg, bar);
            __builtin_amdgcn_fence(__ATOMIC_ACQUIRE, "agent");
            xb_add(&bar[XB_XGEN(b.x)], 1u);
            asm volatile("s_waitcnt vmcnt(0)" ::: "memory");
        } else {
            XB_SPIN(xb_ld(&bar[XB_XGEN(b.x)]) == gen, bar);
            __builtin_amdgcn_fence(__ATOMIC_ACQUIRE, "agent");
            asm volatile("s_waitcnt vmcnt(0)" ::: "memory");
        }
    }
    __syncthreads();
}

__device__ void transpose_job(float* tile, const float* __restrict__ src, int ld, int K, int N, bf16_t* __restrict__ dst, int dst_rows,
                              const float* __restrict__ kscale, const float* __restrict__ src2, int ld2, int n2lo, int n2hi, int& rot, int idx, int nidx) {
    const int nkt = (K + 63) >> 6, nnt = (dst_rows + 63) >> 6, ntiles = nkt * nnt;
    const int tid_ = otid(); const int tx = tid_ & 63, ty = tid_ >> 6;
    const int first = (idx + nidx - rot % nidx) % nidx;
    rot += ntiles;
    for (int t = first; t < ntiles; t += nidx) {
        const int kt = t % nkt, nt = t / nkt, k0 = kt * 64, n0 = nt * 64;
#pragma unroll 4
        for (int i = 0; i < 16; ++i) {
            const int k = k0 + ty + 4 * i, n = n0 + tx; float v = 0.f;
            if (k < K) {
                if (n < N) { v = src[(size_t)k * ld + n]; if (kscale) v *= kscale[k]; }
                else if (src2 && n >= n2lo && n < n2hi) v = src2[(size_t)k * ld2 + (n - n2lo)];
            }
            tile[(ty + 4 * i) * 65 + tx] = v;
        }
        __syncthreads();
#pragma unroll 4
        for (int i = 0; i < 16; ++i) {
            const int n = n0 + ty + 4 * i, k = k0 + tx;
            if (n < dst_rows && k < K) dst[(size_t)n * K + k] = (bf16_t)(pk_bf16(tile[tx * 65 + ty + 4 * i], 0.f) & 0xffffu);
        }
        __syncthreads();
    }
}

__device__ void mod_job(float* lds, const Params& p, float* __restrict__ mod) {
    float* cact = lds;
    float* red = lds + 8192;
    const int tid = otid();
    bool have = false;
    for (int it = (int)gridDim.x - 1 - (int)blockIdx.x; it < 192; it += gridDim.x) {
        if (!have) {
            for (int i = tid; i < 8192; i += 256) cact[i] = siluf_(p.c[i]);
            have = true;
            __syncthreads();
        }
        const int l = it / 48, n0 = (it % 48) * 64, kg = tid >> 6, n = n0 + (tid & 63);
        float a0 = 0.f, a1 = 0.f, a2 = 0.f, a3 = 0.f, a4 = 0.f, a5 = 0.f, a6 = 0.f, a7 = 0.f;
        const float* wp = p.w_ada + ((size_t)l * 1024 + kg * 256) * 3072 + n;
#pragma unroll 8
        for (int k = 0; k < 256; ++k) {
            const float w = wp[(size_t)k * 3072]; const int kk = kg * 256 + k;
            a0 += cact[kk] * w; a1 += cact[1024 + kk] * w; a2 += cact[2048 + kk] * w; a3 += cact[3072 + kk] * w;
            a4 += cact[4096 + kk] * w; a5 += cact[5120 + kk] * w; a6 += cact[6144 + kk] * w; a7 += cact[7168 + kk] * w;
        }
        float* rp = red + (kg * 64 + (tid & 63)) * 8;
        rp[0] = a0; rp[1] = a1; rp[2] = a2; rp[3] = a3; rp[4] = a4; rp[5] = a5; rp[6] = a6; rp[7] = a7;
        __syncthreads();
        {
#pragma unroll
            for (int q = 0; q < 2; ++q) {
                const int o = tid + 256 * q, nn = o >> 3, b = o & 7;
                const float s = red[(0 * 64 + nn) * 8 + b] + red[(1 * 64 + nn) * 8 + b] + red[(2 * 64 + nn) * 8 + b] + red[(3 * 64 + nn) * 8 + b];
                mod[((size_t)l * 8 + b) * 3072 + n0 + nn] = s + p.b_ada[l * 3072 + n0 + nn];
            }
        }
        __syncthreads();
    }
}

__device__ void convert_layer(char* smem, const Params& p, int l, int idx, int nidx) {
    char* ws = p.ws; float* tile = (float*)smem; int rot = 0;
    transpose_job(tile, p.w_in + (size_t)l * 1024 * INW, INW, 1024, INW, (bf16_t*)(ws + OFF_WIN) + (size_t)l * NP * 1024, NP, nullptr,
                  l > 0 ? p.w_vmd + (size_t)(l - 1) * 1024 * 32 : nullptr, 32, INW, INW + 32, rot, idx, nidx);
    transpose_job(tile, p.w_out + (size_t)l * 1024 * 1024, 1024, 1024, 1024, (bf16_t*)(ws + OFF_WOUT) + (size_t)l * 1024 * 1024, 1024, nullptr, nullptr, 0, 0, 0, rot, idx, nidx);
    transpose_job(tile, p.w_uq + (size_t)l * 384 * 768, 768, 384, 768, (bf16_t*)(ws + OFF_WUQ) + (size_t)l * 768 * 384, 768, p.qng + l * 384, nullptr, 0, 0, 0, rot, idx, nidx);
    transpose_job(tile, p.w_ukv + (size_t)l * 256 * 1024, 1024, 256, 1024, (bf16_t*)(ws + OFF_WUKV) + (size_t)l * 1024 * 256, 1024, p.kvng + l * 256, nullptr, 0, 0, 0, rot, idx, nidx);
    transpose_job(tile, p.w_dec + (size_t)l * 64 * 512, 512, 64, 512, (bf16_t*)(ws + OFF_WDEC) + (size_t)l * 512 * 64, 512, nullptr, nullptr, 0, 0, 0, rot, idx, nidx);
    transpose_job(tile, p.w_icl + (size_t)l * 64 * 512, 512, 64, 512, (bf16_t*)(ws + OFF_WICL) + (size_t)l * 512 * 64, 512, nullptr, nullptr, 0, 0, 0, rot, idx, nidx);
    if (l > 0)
        transpose_job(tile, p.w_vmu + (size_t)(l - 1) * 32 * 512, 512, 32, 512, (bf16_t*)(ws + OFF_WVM) + (size_t)l * 512 * 32, 512, nullptr, nullptr, 0, 0, 0, rot, idx, nidx);
}

__device__ void prologue(char* smem, const Params& p) {
    char* ws = p.ws;
    float* tile = (float*)smem;
    { const int t0_ = otid(); if (blockIdx.x == 0 && t0_ < 64) ((int*)(ws + OFF_CTRL))[t0_] = 0; }
    {
        float* cs = (float*)(ws + OFF_COS); float* sn = (float*)(ws + OFF_SIN);
        const int gt = blockIdx.x * 256 + otid(), ng = gridDim.x * 256;
        for (int e = gt; e < NT * 16; e += ng) {
            const int t = e >> 4, i = e & 15;
            const float inv = exp2f(-(float)i * (13.287712379549449f / 16.0f));
            const float ang = (float)p.pos[t] * inv;
            cs[e] = cosf(ang); sn[e] = sinf(ang);
        }
    }
    mod_job(tile, p, (float*)(ws + OFF_MOD));
    __syncthreads();
    convert_layer(smem, p, 0, blockIdx.x, gridDim.x);
}

__device__ void norm_phase(const float* __restrict__ xin, const float* __restrict__ g, const float* __restrict__ modl, bf16_t* __restrict__ h, int tbase) {
    const int tid_ = otid(); const int lane = tid_ & 63, gw = blockIdx.x * 4 + (tid_ >> 6), nw = gridDim.x * 4;
    for (int t = tbase + gw; t < tbase + TH; t += nw) {
        const float* xr = xin + (size_t)t * 1024;
        f32x4 v[4]; float ss = 0.f;
#pragma unroll
        for (int i = 0; i < 4; ++i) { v[i] = *(const f32x4*)(xr + i * 256 + lane * 4); ss += v[i].x * v[i].x + v[i].y * v[i].y + v[i].z * v[i].z + v[i].w * v[i].w; }
        ss = wave_sum64(ss);
        const float rstd = rsqrtf(ss * (1.0f / 1024.0f) + 1e-6f);
        const float* mb = modl + (size_t)(t >> 12) * 3072;
#pragma unroll
        for (int i = 0; i < 4; ++i) {
            const int col = i * 256 + lane * 4;
            const f32x4 gg = *(const f32x4*)(g + col), sh = *(const f32x4*)(mb + col), sc = *(const f32x4*)(mb + 1024 + col);
            const f32x4 o = v[i] * rstd * gg * (sc + 1.0f) + sh;
            u32x2 w; w.x = pk_bf16(o.x, o.y); w.y = pk_bf16(o.z, o.w);
            *(u32x2*)(h + (size_t)(t - tbase) * 1024 + col) = w;
        }
    }
}

__device__ void final_norm(float* __restrict__ xio, const float* __restrict__ g) {
    const int tid_ = otid(); const int lane = tid_ & 63, gw = blockIdx.x * 4 + (tid_ >> 6), nw = gridDim.x * 4;
    for (int t = gw; t < NT; t += nw) {
        float* xr = xio + (size_t)t * 1024;
        f32x4 v[4]; float ss = 0.f;
#pragma unroll
        for (int i = 0; i < 4; ++i) { v[i] = *(const f32x4*)(xr + i * 256 + lane * 4); ss += v[i].x * v[i].x + v[i].y * v[i].y + v[i].z * v[i].z + v[i].w * v[i].w; }
        ss = wave_sum64(ss);
        const float rstd = rsqrtf(ss * (1.0f / 1024.0f) + 1e-6f);
#pragma unroll
        for (int i = 0; i < 4; ++i) {
            const int col = i * 256 + lane * 4;
            const f32x4 gg = *(const f32x4*)(g + col);
            *(f32x4*)(xr + col) = v[i] * rstd * gg;
        }
    }
}

template <class Epi>
__device__ __forceinline__ void gemm_tile(char* smem, const bf16_t* __restrict__ A, int lda, const bf16_t* __restrict__ Bt, int ldb, int K, int row0, int col0, const Epi& epi) {
    const int tid = otid(), lane = tid & 63, wid = tid >> 6, wr = wid >> 1, wc = wid & 1, fr = lane & 15, fq = lane >> 4;
    f32x4 acc[4][4];
#pragma unroll
    for (int i = 0; i < 4; ++i)
#pragma unroll
        for (int j = 0; j < 4; ++j) acc[i][j] = (f32x4){0.f, 0.f, 0.f, 0.f};
    const int lrow = lane >> 3, lp = lane & 7;
    const int srow0 = wid * 32 + lrow;
    const bf16_t* gA = A + (size_t)(row0 + srow0) * lda;
    const bf16_t* gB = Bt + (size_t)(col0 + srow0) * ldb;
    int gc[4];
#pragma unroll
    for (int i = 0; i < 4; ++i) gc[i] = (lp ^ (((srow0 + 8 * i) >> 1) & 7)) * 8;
    LAS char* lbase = (LAS char*)smem + wid * 4096;
#define GEMM_STAGE(buf, kofs) do { _Pragma("unroll") for (int i = 0; i < 4; ++i) { \
        __builtin_amdgcn_global_load_lds((const unsigned*)(gA + (size_t)(8 * i) * lda + (kofs) + gc[i]), (LAS unsigned*)(lbase + (buf) * 32768 + i * 1024), 16, 0, 0); \
        __builtin_amdgcn_global_load_lds((const unsigned*)(gB + (size_t)(8 * i) * ldb + (kofs) + gc[i]), (LAS unsigned*)(lbase + (buf) * 32768 + 16384 + i * 1024), 16, 0, 0); } } while (0)
    GEMM_STAGE(0, 0);
    __syncthreads();
    const int nk = K >> 6;
    const int fsw = (fr >> 1) & 7;
    const int aoff = (wr * 64 + fr) * 128, boff = 16384 + (wc * 64 + fr) * 128;
#define GEMM_STEP(CB, NB_) do { \
        const char* cur = smem + (CB) * 32768; \
        bf16x8 af[2][4], bfr[2][4]; \
        _Pragma("unroll") for (int kk = 0; kk < 2; ++kk) { \
            const int csw = (((kk * 4 + fq) ^ fsw) << 4); \
            _Pragma("unroll") for (int i = 0; i < 4; ++i) { af[kk][i] = *(const bf16x8*)(cur + aoff + i * 2048 + csw); bfr[kk][i] = *(const bf16x8*)(cur + boff + i * 2048 + csw); } \
        } \
        __builtin_amdgcn_sched_barrier(0); \
        if (ks + 1 < nk) GEMM_STAGE(NB_, (ks + 1) * 64); \
        __builtin_amdgcn_sched_barrier(0); \
        _Pragma("unroll") for (int kk = 0; kk < 2; ++kk) \
            _Pragma("unroll") for (int mi = 0; mi < 4; ++mi) \
                _Pragma("unroll") for (int ni = 0; ni < 4; ++ni) acc[mi][ni] = __builtin_amdgcn_mfma_f32_16x16x32_bf16(bfr[kk][ni], af[kk][mi], acc[mi][ni], 0, 0, 0); \
        __builtin_amdgcn_sched_barrier(0); \
        __syncthreads(); \
        ++ks; } while (0)
#pragma unroll 1
    for (int ks = 0; ks < nk;) {
        GEMM_STEP(0, 1);
        GEMM_STEP(1, 0);
    }
#undef GEMM_STEP
#undef GEMM_STAGE
    epi(acc, row0 + wr * 64, col0 + wc * 64, fr, fq);
}

struct EpiProj {
    bf16_t* proj; float* rsq; float* rskv; char* smem;
    __device__ __forceinline__ void operator()(const f32x4 (&acc)[4][4], int rbase, int cbase, int fr, int fq) const {
        const bool isq = cbase >= O_CQ && cbase < O_CKV, iskv = cbase >= O_CKV && cbase < O_KR;
        const int row0 = rbase & ~127, col0 = cbase & ~127, wr = (rbase >> 6) & 1, wc = (cbase >> 6) & 1;
        const int tid = (wr * 2 + wc) * 64 + fq * 16 + fr;
#pragma unroll
        for (int mi = 0; mi < 4; ++mi) {
            const int tl = rbase + mi * 16 + fr; float ss = 0.f;
#pragma unroll
            for (int ni = 0; ni < 4; ++ni) {
                u32x2 w; w.x = pk_bf16(acc[mi][ni][0], acc[mi][ni][1]); w.y = pk_bf16(acc[mi][ni][2], acc[mi][ni][3]);
                *(u32x2*)(smem + (wr * 64 + mi * 16 + fr) * 272 + (wc * 64 + ni * 16 + fq * 4) * 2) = w;
                const float a = bf_lo(w.x), b = bf_hi(w.x), c = bf_lo(w.y), d = bf_hi(w.y);
                ss += a * a + b * b + c * c + d * d;
            }
            if (isq || iskv) {
                ss += __shfl_xor(ss, 16); ss += __shfl_xor(ss, 32);
                if (fq == 0) { if (isq) rsq[(size_t)tl * 8 + ((cbase - O_CQ) >> 6)] = ss; else rskv[(size_t)tl * 4 + ((cbase - O_CKV) >> 6)] = ss; }
            }
        }
        __syncthreads();
#pragma unroll
        for (int i = 0; i < 8; ++i) {
            const int q = tid + 256 * i, r = q >> 4, c = q & 15;
            *(u32x4*)(proj + (size_t)(row0 + r) * NP + col0 + c * 8) = *(const u32x4*)(smem + r * 272 + c * 16);
        }
        __syncthreads();
    }
};
struct EpiQ {
    bf16_t* Q; const float* rsq; const float* cs; const float* sn; int tgbase; char* smem;
    __device__ __forceinline__ void operator()(const f32x4 (&acc)[4][4], int rbase, int cbase, int fr, int fq) const {
        const int g0 = cbase >> 4;
        char* stg = smem + ((((rbase >> 6) & 1) * 2 + ((cbase >> 6) & 1)) * 9216);
#pragma unroll
        for (int mi = 0; mi < 4; ++mi) {
            const int tl = rbase + mi * 16 + fr;
            const f32x4 s0 = *(const f32x4*)(rsq + (size_t)tl * 8); const f32x2 s1 = *(const f32x2*)(rsq + (size_t)tl * 8 + 4);
            const float rs = rsqrtf((s0.x + s0.y + s0.z + s0.w + s1.x + s1.y) * (1.0f / 384.0f) + 1e-6f) * QSCALE;
            const f32x4 cc = *(const f32x4*)(cs + (size_t)(tgbase + tl) * 16 + fq * 4), sv = *(const f32x4*)(sn + (size_t)(tgbase + tl) * 16 + fq * 4);
            f32x4 v[4];
#pragma unroll
            for (int ni = 0; ni < 4; ++ni) v[ni] = acc[mi][ni] * rs;
#pragma unroll
            for (int ni = 0; ni < 4; ni += 2)
                if ((g0 + ni) % 6 == 4) { const f32x4 x1 = v[ni], x2 = v[ni + 1]; v[ni] = x1 * cc - x2 * sv; v[ni + 1] = x2 * cc + x1 * sv; }
#pragma unroll
            for (int ni = 0; ni < 4; ++ni) {
                u32x2 w; w.x = pk_bf16(v[ni][0], v[ni][1]); w.y = pk_bf16(v[ni][2], v[ni][3]);
                *(u32x2*)(stg + (mi * 16 + fr) * 144 + (ni * 16 + fq * 4) * 2) = w;
            }
        }
        {
            const int lane = fq * 16 + fr;
#pragma unroll
            for (int i = 0; i < 8; ++i) {
                const int q = lane + 64 * i, tk = q >> 3, c = q & 7;
                *(u32x4*)(Q + (size_t)(rbase + tk) * 768 + cbase + c * 8) = *(const u32x4*)(stg + tk * 144 + c * 16);
            }
        }
        __syncthreads();
    }
};
struct EpiKV {
    bf16_t* Kh; bf16_t* Vt; const float* rskv; char* smem;
    __device__ __forceinline__ void operator()(const f32x4 (&acc)[4][4], int rbase, int cbase, int fr, int fq) const {
        const int hh = cbase >> 7, part = (cbase >> 6) & 1, lane = fq * 16 + fr;
        char* stg = smem + ((((rbase >> 6) & 1) * 2 + part) * 9216);
#pragma unroll
        for (int mi = 0; mi < 4; ++mi) {
            const int tl = rbase + mi * 16 + fr;
            const f32x4 s0 = *(const f32x4*)(rskv + (size_t)tl * 4);
            const float rs = rsqrtf((s0.x + s0.y + s0.z + s0.w) * (1.0f / 256.0f) + 1e-6f);
#pragma unroll
            for (int ni = 0; ni < 4; ++ni) {
                const unsigned w0 = pk_bf16(acc[mi][ni][0] * rs, acc[mi][ni][1] * rs), w1 = pk_bf16(acc[mi][ni][2] * rs, acc[mi][ni][3] * rs);
                if (part == 0) { u32x2 w; w.x = w0; w.y = w1; *(u32x2*)(stg + (mi * 16 + fr) * 144 + (ni * 16 + fq * 4) * 2) = w; }
                else {
                    bf16_t* sp = (bf16_t*)(stg + (ni * 16 + fq * 4) * 144) + mi * 16 + fr;
                    sp[0] = (bf16_t)(w0 & 0xffffu); sp[72] = (bf16_t)(w0 >> 16); sp[144] = (bf16_t)(w1 & 0xffffu); sp[216] = (bf16_t)(w1 >> 16);
                }
            }
        }
        if (part == 0) {
#pragma unroll
            for (int i = 0; i < 8; ++i) {
                const int q = lane + 64 * i, tk = q >> 3, c = q & 7;
                *(u32x4*)(Kh + (size_t)(rbase + tk) * 768 + hh * 96 + c * 8) = *(const u32x4*)(stg + tk * 144 + c * 16);
            }
        } else {
            const int bl = rbase >> 12, s0 = rbase & 4095;
            bf16_t* vb = Vt + ((size_t)(bl * 8 + hh) * 64) * 4096 + s0;
#pragma unroll
            for (int i = 0; i < 8; ++i) {
                const int q = lane + 64 * i, dv = q >> 3, c = q & 7;
                *(u32x4*)(vb + (size_t)dv * 4096 + c * 8) = *(const u32x4*)(stg + dv * 144 + c * 16);
            }
        }
        __syncthreads();
    }
};
struct EpiOut {
    const float* xold; float* xnew; const float* modl; int tgbase; float fac;
    __device__ __forceinline__ void operator()(const f32x4 (&acc)[4][4], int rbase, int cbase, int fr, int fq) const {
#pragma unroll
        for (int mi = 0; mi < 4; ++mi) {
            const int tg = tgbase + rbase + mi * 16 + fr; const float* gp = modl + (size_t)(tg >> 12) * 3072 + 2048;
#pragma unroll
            for (int ni = 0; ni < 4; ++ni) {
                const int col = cbase + ni * 16 + fq * 4;
                const f32x4 xo = *(const f32x4*)(xold + (size_t)tg * 1024 + col), gt = *(const f32x4*)(gp + col);
                *(f32x4*)(xnew + (size_t)tg * 1024 + col) = xo + gt * acc[mi][ni] * fac;
            }
        }
    }
};

struct PrepArgs {
    const bf16_t* proj; const float* mu; const float* muv; const bf16_t* wdec; const bf16_t* wicl; const bf16_t* wvm;
    const float *w0, *a0, *v0, *k_k, *k_a; const float *cs, *sn;
    bf16_t *sr, *sk, *sv, *skk, *skka; bf16_t* se; bf16_t* vfirst; bf16_t* Kh; int layer; int tgbase;
};
__device__ __forceinline__ void lerp8(const bf16_t* cur, const bf16_t* prv, bool hp, const float* mu, float (&o)[8]) {
    const u32x4 c = *(const u32x4*)cur; u32x4 q = (u32x4){0u, 0u, 0u, 0u}; if (hp) q = *(const u32x4*)prv;
    const f32x4 m0 = *(const f32x4*)mu, m1 = *(const f32x4*)(mu + 4);
    const float cv[8] = {bf_lo(c.x), bf_hi(c.x), bf_lo(c.y), bf_hi(c.y), bf_lo(c.z), bf_hi(c.z), bf_lo(c.w), bf_hi(c.w)};
    const float pv[8] = {bf_lo(q.x), bf_hi(q.x), bf_lo(q.y), bf_hi(q.y), bf_lo(q.z), bf_hi(q.z), bf_lo(q.w), bf_hi(q.w)};
    const float mv[8] = {m0.x, m0.y, m0.z, m0.w, m1.x, m1.y, m1.z, m1.w};
#pragma unroll
    for (int j = 0; j < 8; ++j) o[j] = cv[j] + (pv[j] - cv[j]) * mv[j];
}
__device__ __forceinline__ f32x4 lerp4(const bf16_t* cur, const bf16_t* prv, bool hp, const float* mu) {
    const u32x2 c = *(const u32x2*)cur; u32x2 q = (u32x2){0u, 0u}; if (hp) q = *(const u32x2*)prv;
    const f32x4 m = *(const f32x4*)mu;
    const f32x4 cv = (f32x4){bf_lo(c.x), bf_hi(c.x), bf_lo(c.y), bf_hi(c.y)}, pv = (f32x4){bf_lo(q.x), bf_hi(q.x), bf_lo(q.y), bf_hi(q.y)};
    return cv + (pv - cv) * m;
}
__device__ __forceinline__ bf16x8 pack8(const float (&v)[8]) {
    u32x4 w; w.x = pk_bf16(v[0], v[1]); w.y = pk_bf16(v[2], v[3]); w.z = pk_bf16(v[4], v[5]); w.w = pk_bf16(v[6], v[7]);
    return __builtin_bit_cast(bf16x8, w);
}
__device__ __forceinline__ void store4(bf16_t* dst, const f32x4 v) { u32x2 w; w.x = pk_bf16(v.x, v.y); w.y = pk_bf16(v.z, v.w); *(u32x2*)dst = w; }

__device__ __forceinline__ void prep_tile(char* smem, const PrepArgs& a, int tile, int hg) {
    const int tid = otid(), lane = tid & 63, wid = tid >> 6, fr = lane & 15, fq = lane >> 4;
    const int tl = tile * 64 + wid * 16 + fr, tg = a.tgbase + tl;
    char* stg = smem + wid * 15872;
    const int tlw = tile * 64 + wid * 16;
    const bool hp = (tg & 4095) != 0;
    const bf16_t* pr = a.proj + (size_t)tl * NP; const bf16_t* pp = pr - NP;
    if (hg == 0) {
        const u32x2 u1 = *(const u32x2*)(pr + O_KR + fq * 4), u2 = *(const u32x2*)(pr + O_KR + 16 + fq * 4);
        const f32x4 x1 = (f32x4){bf_lo(u1.x), bf_hi(u1.x), bf_lo(u1.y), bf_hi(u1.y)}, x2 = (f32x4){bf_lo(u2.x), bf_hi(u2.x), bf_lo(u2.y), bf_hi(u2.y)};
        const f32x4 cc = *(const f32x4*)(a.cs + (size_t)tg * 16 + fq * 4), sv = *(const f32x4*)(a.sn + (size_t)tg * 16 + fq * 4);
        const f32x4 o1 = x1 * cc - x2 * sv, o2 = x2 * cc + x1 * sv;
        u32x2 w1, w2; w1.x = pk_bf16(o1.x, o1.y); w1.y = pk_bf16(o1.z, o1.w); w2.x = pk_bf16(o2.x, o2.y); w2.y = pk_bf16(o2.z, o2.w);
#pragma unroll
        for (int hh = 0; hh < 8; ++hh) { *(u32x2*)(a.Kh + (size_t)tl * 768 + hh * 96 + 64 + fq * 4) = w1; *(u32x2*)(a.Kh + (size_t)tl * 768 + hh * 96 + 80 + fq * 4) = w2; }
    }
    bf16x8 bw[2], ba[2], bv;
#pragma unroll
    for (int ks = 0; ks < 2; ++ks) {
        float t[8];
        lerp8(pr + 1536 + ks * 32 + fq * 8, pp + 1536 + ks * 32 + fq * 8, hp, a.mu + 1536 + ks * 32 + fq * 8, t);
#pragma unroll
        for (int j = 0; j < 8; ++j) t[j] = tanhf_(t[j]);
        bw[ks] = pack8(t);
        lerp8(pr + 1600 + ks * 32 + fq * 8, pp + 1600 + ks * 32 + fq * 8, hp, a.mu + 1600 + ks * 32 + fq * 8, t);
        ba[ks] = pack8(t);
    }
    const bool hasv = a.layer > 0;
    if (hasv) { float t[8]; lerp8(pr + INW + fq * 8, pp + INW + fq * 8, hp, a.muv + fq * 8, t); bv = pack8(t); }
    else bv = (bf16x8){0, 0, 0, 0, 0, 0, 0, 0};
#pragma unroll 1
    for (int hh = hg * 2; hh < hg * 2 + 2; ++hh) {
        float ss = 0.f;
#pragma unroll
        for (int nt = 0; nt < 4; ++nt) {
            const int ch = hh * 64 + nt * 16 + fq * 4;
            const f32x4 k4 = lerp4(pr + 512 + ch, pp + 512 + ch, hp, a.mu + 512 + ch);
            const f32x4 kr = k4 * *(const f32x4*)(a.k_k + ch);
            ss += kr.x * kr.x + kr.y * kr.y + kr.z * kr.z + kr.w * kr.w;
        }
        ss += __shfl_xor(ss, 16); ss += __shfl_xor(ss, 32);
        const float inv = 1.0f / fmaxf(sqrtf(ss), 1e-12f);
#pragma unroll
        for (int nt = 0; nt < 4; ++nt) {
            const int cb = hh * 64 + nt * 16, ch = cb + fq * 4;
            f32x4 accw = (f32x4){0.f, 0.f, 0.f, 0.f}, acca = accw, accv = accw;
#pragma unroll
            for (int ks = 0; ks < 2; ++ks) {
                const bf16x8 aw = *(const bf16x8*)(a.wdec + (size_t)(cb + fr) * 64 + ks * 32 + fq * 8);
                const bf16x8 ai = *(const bf16x8*)(a.wicl + (size_t)(cb + fr) * 64 + ks * 32 + fq * 8);
                accw = __builtin_amdgcn_mfma_f32_16x16x32_bf16(aw, bw[ks], accw, 0, 0, 0);
                acca = __builtin_amdgcn_mfma_f32_16x16x32_bf16(ai, ba[ks], acca, 0, 0, 0);
            }
            if (hasv) {
                const bf16x8 avm = *(const bf16x8*)(a.wvm + (size_t)(cb + fr) * 32 + fq * 8);
                accv = __builtin_amdgcn_mfma_f32_16x16x32_bf16(avm, bv, accv, 0, 0, 0);
            }
            const f32x4 r4 = lerp4(pr + ch, pp + ch, hp, a.mu + ch);
            const f32x4 k4 = lerp4(pr + 512 + ch, pp + 512 + ch, hp, a.mu + 512 + ch);
            f32x4 v4 = lerp4(pr + 1024 + ch, pp + 1024 + ch, hp, a.mu + 1024 + ch);
            const f32x4 w0v = *(const f32x4*)(a.w0 + ch), a0v = *(const f32x4*)(a.a0 + ch), kkv = *(const f32x4*)(a.k_k + ch), kav = *(const f32x4*)(a.k_a + ch);
            f32x4 dec, aa;
#pragma unroll
            for (int j = 0; j < 4; ++j) {
                dec[j] = 0.6065306597126334f * sigmoidf_(w0v[j] + accw[j]);
                aa[j] = sigmoidf_(a0v[j] + acca[j]);
            }
            if (hasv) {
                const f32x4 v0v = *(const f32x4*)(a.v0 + ch);
                const u32x2 uf = *(const u32x2*)(a.vfirst + (size_t)tg * 512 + ch);
                const f32x4 vf = (f32x4){bf_lo(uf.x), bf_hi(uf.x), bf_lo(uf.y), bf_hi(uf.y)};
#pragma unroll
                for (int j = 0; j < 4; ++j) v4[j] = v4[j] + (vf[j] - v4[j]) * sigmoidf_(v0v[j] + accv[j]);
            } else {
                store4(a.vfirst + (size_t)tg * 512 + ch, v4);
            }
            const f32x4 kk = k4 * kkv * inv;
            const f32x4 kp = k4 * ((aa - 1.0f) * kav + 1.0f);
            {
                const int so = fr * 144 + nt * 32 + fq * 8;
                store4((bf16_t*)(stg + so), r4); store4((bf16_t*)(stg + 2304 + so), kp); store4((bf16_t*)(stg + 4608 + so), v4);
                store4((bf16_t*)(stg + 6912 + so), kk); store4((bf16_t*)(stg + 9216 + so), kk * aa);
                store4((bf16_t*)(stg + 11520 + so), dec);
            }
        }
        {
#pragma unroll
            for (int i = 0; i < 2; ++i) {
                const int q = lane + 64 * i, tk = q >> 3, c = q & 7;
                const size_t go = (size_t)(tlw + tk) * 512 + hh * 64 + c * 8; const int lo = tk * 144 + c * 16;
                *(u32x4*)(a.sr + go) = *(const u32x4*)(stg + lo); *(u32x4*)(a.sk + go) = *(const u32x4*)(stg + 2304 + lo); *(u32x4*)(a.sv + go) = *(const u32x4*)(stg + 4608 + lo);
                *(u32x4*)(a.skk + go) = *(const u32x4*)(stg + 6912 + lo); *(u32x4*)(a.skka + go) = *(const u32x4*)(stg + 9216 + lo);
                *(u32x4*)(a.se + go) = *(const u32x4*)(stg + 11520 + lo);
            }
        }
    }
    __syncthreads();
}

struct ScanArgs { const bf16_t *sr, *sk, *sv, *skk, *skka; const float* sw; float* yraw; float* zbuf; float* sfin; };
__device__ __forceinline__ void cvt_store8(float* dst, const u32x4 u) {
    *(f32x4*)dst = (f32x4){bf_lo(u.x), bf_hi(u.x), bf_lo(u.y), bf_hi(u.y)};
    *(f32x4*)(dst + 4) = (f32x4){bf_lo(u.z), bf_hi(u.z), bf_lo(u.w), bf_hi(u.w)};
}
__device__ __forceinline__ void scan_tile(char* smem, const ScanArgs& a, int mode, int bl, int hh, int g) {
    const int tid = otid(), lane = tid & 63, wid = tid >> 6, rl = lane >> 4, c = lane & 15;
    float* L = (float*)smem;
    float* ybuf = L + 2 * 5376;
    const size_t tokbase = (size_t)bl * 4096 + (mode ? 2048 : 0);
    const int colh = hh * 64, i0 = g * 16;
    const bf16_t* src0 = (tid < 128) ? a.skk : a.skka;
    const bf16_t* src1 = (tid < 128) ? a.sk : a.sr;
    const int rem = tid & 127, tokA = rem >> 3, chA = rem & 7;
    const size_t gofsA = (size_t)tokA * 512 + colh + chA * 8;
    const int ldsA0 = (1 + (tid >> 7)) * 1024 + tokA * 64 + chA * 8, ldsA1 = (3 + (tid >> 7)) * 1024 + tokA * 64 + chA * 8;
    const size_t gofsW = (size_t)(tid >> 4) * 512 + colh + (tid & 15) * 4;
    const int ldsW = (tid >> 4) * 64 + (tid & 15) * 4;
    const size_t gofsV = (size_t)((tid & 31) >> 1) * 512 + colh + i0 + (tid & 1) * 8;
    const int ldsV = 5120 + ((tid & 31) >> 1) * 16 + (tid & 1) * 8;
    const bool ldv = tid < 32 && mode != 2;
    f32x2 S01 = (f32x2){0.f, 0.f}, S23 = (f32x2){0.f, 0.f};
    if (mode == 2) { const int d = (i0 + wid * 4 + rl) - c * 4; S01.x = d == 0 ? 1.f : 0.f; S01.y = d == 1 ? 1.f : 0.f; S23.x = d == 2 ? 1.f : 0.f; S23.y = d == 3 ? 1.f : 0.f; }
    u32x4 qa, qb, qv = (u32x4){0u, 0u, 0u, 0u}; f32x4 qw;
    {
        const size_t tb = tokbase * 512;
        qa = *(const u32x4*)(src0 + tb + gofsA); qb = *(const u32x4*)(src1 + tb + gofsA); qw = *(const f32x4*)(a.sw + tb + gofsW);
        if (ldv) qv = *(const u32x4*)(a.sv + tb + gofsV);
        cvt_store8(L + ldsA0, qa); cvt_store8(L + ldsA1, qb); *(f32x4*)(L + ldsW) = qw; if (tid < 32) { cvt_store8(L + ldsV, qv); if (mode == 2) cvt_store8(L + 5376 + ldsV, qv); }
    }
    __syncthreads();
    const int vofs = 5120 + wid * 4 + rl;
#pragma unroll 1
    for (int ch = 0; ch < 128; ++ch) {
        const float* cur = L + (ch & 1) * 5376;
        if (ch + 1 < 128) {
            const size_t tb = (tokbase + (size_t)(ch + 1) * 16) * 512;
            qa = *(const u32x4*)(src0 + tb + gofsA); qb = *(const u32x4*)(src1 + tb + gofsA); qw = *(const f32x4*)(a.sw + tb + gofsW);
            if (ldv) qv = *(const u32x4*)(a.sv + tb + gofsV);
        }
        float* yb = ybuf + (ch & 1) * 256;
        float ykeep = 0.f;
        f32x4 w4 = *(const f32x4*)(cur + c * 4), kk4 = *(const f32x4*)(cur + 1024 + c * 4), ka4 = *(const f32x4*)(cur + 2048 + c * 4);
        f32x4 k4 = *(const f32x4*)(cur + 3072 + c * 4), r4 = *(const f32x4*)(cur + 4096 + c * 4);
        float v = cur[vofs];
        float prevq = 0.f;
#pragma unroll
        for (int s = 0; s < 16; ++s) {
            f32x4 nw4 = w4, nkk4 = kk4, nka4 = ka4, nk4 = k4, nr4 = r4; float nv = v;
            if (s + 1 < 16) {
                nw4 = *(const f32x4*)(cur + (s + 1) * 64 + c * 4); nkk4 = *(const f32x4*)(cur + 1024 + (s + 1) * 64 + c * 4); nka4 = *(const f32x4*)(cur + 2048 + (s + 1) * 64 + c * 4);
                nk4 = *(const f32x4*)(cur + 3072 + (s + 1) * 64 + c * 4); nr4 = *(const f32x4*)(cur + 4096 + (s + 1) * 64 + c * 4);
                nv = cur[vofs + (s + 1) * 16];
            }
            const f32x2 pp = S01 * kk4.xy + S23 * kk4.zw;
            float sa = pp.x + pp.y;
            if (s > 0) { float yq = prevq; dpp_sum16x2(sa, yq); ykeep = (c == s - 1) ? yq : ykeep; }
            else sa = dpp_sum16(sa);
            const f32x2 sa2 = (f32x2){sa, sa}, v2 = (f32x2){v, v};
            S01 = S01 * w4.xy + (v2 * k4.xy - sa2 * ka4.xy);
            S23 = S23 * w4.zw + (v2 * k4.zw - sa2 * ka4.zw);
            const f32x2 qq = S01 * r4.xy + S23 * r4.zw;
            prevq = qq.x + qq.y;
            __builtin_amdgcn_sched_barrier(0);
            w4 = nw4; kk4 = nkk4; ka4 = nka4; k4 = nk4; r4 = nr4; v = nv;
        }
        { const float yq = dpp_sum16(prevq); ykeep = (c == 15) ? yq : ykeep; }
        yb[c * 16 + wid * 4 + rl] = ykeep;
        if (ch + 1 < 128) {
            float* nx = L + ((ch + 1) & 1) * 5376;
            cvt_store8(nx + ldsA0, qa); cvt_store8(nx + ldsA1, qb); *(f32x4*)(nx + ldsW) = qw; if (ldv) cvt_store8(nx + ldsV, qv);
        }
        __syncthreads();
        if (mode != 2) a.yraw[(tokbase + (size_t)ch * 16 + (tid >> 4)) * 512 + colh + i0 + (tid & 15)] = yb[tid];
        else a.zbuf[((size_t)bl * 2048 + (size_t)ch * 16 + (tid >> 4)) * 512 + colh + i0 + (tid & 15)] = yb[tid];
    }
    if (mode == 0) *(f32x4*)(a.sfin + ((size_t)((bl * 8 + hh) * 64 + i0 + wid * 4 + rl)) * 64 + c * 4) = (f32x4){S01.x, S01.y, S23.x, S23.y};
}

__device__ __forceinline__ void attn_tile(char* smem, const bf16_t* __restrict__ Qh, const bf16_t* __restrict__ Kh, const bf16_t* __restrict__ Vt,
                                          const bf16_t* __restrict__ proj, bf16_t* __restrict__ ycat, int bl, int hh, int qt) {
    const int tid = otid(), lane = tid & 63, wid = tid >> 6, fr = lane & 15, fq = lane >> 4;
    const int q0 = qt * 128, tok0 = bl * 4096, qw0 = q0 + wid * 32;
    bf16x8 qf[2][3];
#pragma unroll
    for (int qi = 0; qi < 2; ++qi)
#pragma unroll
        for (int ks = 0; ks < 3; ++ks) qf[qi][ks] = *(const bf16x8*)(Qh + (size_t)(tok0 + qw0 + qi * 16 + fr) * 768 + hh * 96 + ks * 32 + fq * 8);
    f32x4 o[4][2];
#pragma unroll
    for (int i = 0; i < 4; ++i) { o[i][0] = (f32x4){0.f, 0.f, 0.f, 0.f}; o[i][1] = o[i][0]; }
    float m[2] = {-1e30f, -1e30f}, lsum[2] = {0.f, 0.f};
    const int nkv = 2 * (qt + 1);
    const bf16_t* Kb = Kh + (size_t)tok0 * 768 + hh * 96;
    const bf16_t* Vb = Vt + ((size_t)((bl * 8 + hh) * 64)) * 4096;
    int gK[3], lK[3];
#pragma unroll
    for (int i = 0; i < 3; ++i) { const int cid = tid + 256 * i, key = cid / 12, cc = cid - key * 12; gK[i] = key * 768 + cc * 8; lK[i] = key * 224 + cc * 16; }
    int gV[2], lV[2];
#pragma unroll
    for (int i = 0; i < 2; ++i) { const int cid = tid + 256 * i, dv = cid >> 3, cc = cid & 7; gV[i] = dv * 4096 + cc * 8; lV[i] = 14336 + dv * 144 + cc * 16; }
    u32x4 rkA[3], rvA[2], rkB[3], rvB[2];
#define ATT_LOAD(RK, RV, T) do { _Pragma("unroll") for (int i = 0; i < 3; ++i) RK[i] = *(const u32x4*)(Kb + (size_t)((T) * 64) * 768 + gK[i]); \
                                 _Pragma("unroll") for (int i = 0; i < 2; ++i) RV[i] = *(const u32x4*)(Vb + (T) * 64 + gV[i]); } while (0)
#define ATT_WRITE(RK, RV, BUF) do { _Pragma("unroll") for (int i = 0; i < 3; ++i) *(u32x4*)(smem + (BUF) * 23552 + lK[i]) = RK[i]; \
                                    _Pragma("unroll") for (int i = 0; i < 2; ++i) *(u32x4*)(smem + (BUF) * 23552 + lV[i]) = RV[i]; } while (0)
    ATT_LOAD(rkA, rvA, 0);
    ATT_WRITE(rkA, rvA, 0);
    ATT_LOAD(rkA, rvA, 1);
    __syncthreads();
    auto compute = [&](const int j, const char* cur) {
        const int kv0 = j * 64;
        if (kv0 <= qw0 + 31) {
            f32x4 s[4][2];
            {
                bf16x8 kf[4][3];
#pragma unroll
                for (int kt = 0; kt < 4; ++kt)
#pragma unroll
                    for (int ks = 0; ks < 3; ++ks) kf[kt][ks] = *(const bf16x8*)(cur + (kt * 16 + fr) * 224 + (ks * 4 + fq) * 16);
                __builtin_amdgcn_sched_barrier(0);
#pragma unroll
                for (int kt = 0; kt < 4; ++kt)
#pragma unroll
                    for (int qi = 0; qi < 2; ++qi) {
                        f32x4 acc = (f32x4){0.f, 0.f, 0.f, 0.f};
#pragma unroll
                        for (int ks = 0; ks < 3; ++ks) acc = __builtin_amdgcn_mfma_f32_16x16x32_bf16(kf[kt][ks], qf[qi][ks], acc, 0, 0, 0);
                        s[kt][qi] = acc;
                    }
                __builtin_amdgcn_sched_barrier(0);
            }
            bf16x8 vfr[4][2];
#pragma unroll
            for (int dvt = 0; dvt < 4; ++dvt)
#pragma unroll
                for (int kb = 0; kb < 2; ++kb) {
                    const char* vp = cur + 14336 + (dvt * 16 + fr) * 144 + kb * 64 + fq * 8;
                    const u32x2 lo = *(const u32x2*)vp, hi = *(const u32x2*)(vp + 32);
                    vfr[dvt][kb] = __builtin_bit_cast(bf16x8, ((u32x4){lo.x, lo.y, hi.x, hi.y}));
                }
            __builtin_amdgcn_sched_barrier(0);
            if (kv0 + 63 > qw0) {
#pragma unroll
                for (int kt = 0; kt < 4; ++kt)
#pragma unroll
                    for (int qi = 0; qi < 2; ++qi)
#pragma unroll
                        for (int jj = 0; jj < 4; ++jj) { const int kpos = kv0 + kt * 16 + fq * 4 + jj, qpos = qw0 + qi * 16 + fr; if (kpos > qpos) s[kt][qi][jj] = -1e30f; }
            }
#pragma unroll
            for (int qi = 0; qi < 2; ++qi) {
                float mx = -1e30f;
#pragma unroll
                for (int kt = 0; kt < 4; ++kt) mx = fmaxf(mx, fmaxf(fmaxf(s[kt][qi][0], s[kt][qi][1]), fmaxf(s[kt][qi][2], s[kt][qi][3])));
                mx = fmaxf(mx, __shfl_xor(mx, 16)); mx = fmaxf(mx, __shfl_xor(mx, 32));
                const float mnew = fmaxf(m[qi], mx), alpha = __builtin_amdgcn_exp2f(m[qi] - mnew);
                m[qi] = mnew;
                float rs = 0.f;
#pragma unroll
                for (int kt = 0; kt < 4; ++kt)
#pragma unroll
                    for (int jj = 0; jj < 4; ++jj) { const float pexp = __builtin_amdgcn_exp2f(s[kt][qi][jj] - mnew); s[kt][qi][jj] = pexp; rs += pexp; }
                lsum[qi] = lsum[qi] * alpha + rs;
#pragma unroll
                for (int dvt = 0; dvt < 4; ++dvt) o[dvt][qi] = o[dvt][qi] * alpha;
            }
            bf16x8 pf[2][2];
#pragma unroll
            for (int kb = 0; kb < 2; ++kb)
#pragma unroll
                for (int qi = 0; qi < 2; ++qi) {
                    u32x4 t;
                    t.x = pk_bf16(s[2 * kb][qi][0], s[2 * kb][qi][1]); t.y = pk_bf16(s[2 * kb][qi][2], s[2 * kb][qi][3]);
                    t.z = pk_bf16(s[2 * kb + 1][qi][0], s[2 * kb + 1][qi][1]); t.w = pk_bf16(s[2 * kb + 1][qi][2], s[2 * kb + 1][qi][3]);
                    pf[kb][qi] = __builtin_bit_cast(bf16x8, t);
                }
            __builtin_amdgcn_sched_barrier(0);
#pragma unroll
            for (int dvt = 0; dvt < 4; ++dvt)
#pragma unroll
                for (int kb = 0; kb < 2; ++kb)
#pragma unroll
                    for (int qi = 0; qi < 2; ++qi) o[dvt][qi] = __builtin_amdgcn_mfma_f32_16x16x32_bf16(vfr[dvt][kb], pf[kb][qi], o[dvt][qi], 0, 0, 0);
        }
    };
#pragma unroll 1
    for (int j = 0; j < nkv; j += 2) {
        if (j + 2 < nkv) ATT_LOAD(rkB, rvB, j + 2);
        compute(j, smem);
        ATT_WRITE(rkA, rvA, 1);
        __syncthreads();
        if (j + 3 < nkv) ATT_LOAD(rkA, rvA, j + 3);
        compute(j + 1, smem + 23552);
        if (j + 2 < nkv) ATT_WRITE(rkB, rvB, 0);
        __syncthreads();
    }
#undef ATT_LOAD
#undef ATT_WRITE
#pragma unroll
    for (int qi = 0; qi < 2; ++qi) {
        float lt = lsum[qi]; lt += __shfl_xor(lt, 16); lt += __shfl_xor(lt, 32);
        const float inv = 1.0f / lt;
        const int tl = tok0 + qw0 + qi * 16 + fr;
#pragma unroll
        for (int dvt = 0; dvt < 4; ++dvt) {
            const int dv = dvt * 16 + fq * 4;
            const u32x2 gu = *(const u32x2*)(proj + (size_t)tl * NP + O_GM + hh * 64 + dv);
            const f32x4 gg = (f32x4){bf_lo(gu.x), bf_hi(gu.x), bf_lo(gu.y), bf_hi(gu.y)};
            f32x4 r;
#pragma unroll
            for (int jj = 0; jj < 4; ++jj) r[jj] = o[dvt][qi][jj] * inv * siluf_(gg[jj]);
            store4(ycat + (size_t)tl * 1024 + 512 + hh * 64 + dv, r);
        }
    }
}

struct FinArgs { const float* yraw; const bf16_t *sr, *sk, *sv; const bf16_t* proj; const float *lnw, *lnb, *rk; bf16_t* ycat; const float* zbuf; const float* sfin; };
__device__ void rwkv_finalize(const FinArgs& a) {
    const int tid_ = otid(); const int lane = tid_ & 63, gw = blockIdx.x * 4 + (tid_ >> 6), nw = gridDim.x * 4;
    for (int u = gw; u < TH * 2; u += nw) {
        const int tl = u >> 1, ch = ((u & 1) * 4 + (lane >> 4)) * 64 + (lane & 15) * 4;
        f32x4 y = *(const f32x4*)(a.yraw + (size_t)tl * 512 + ch);
        const float mean = dpp_sum16(y.x + y.y + y.z + y.w) * (1.0f / 64.0f);
        const f32x4 d = y - mean;
        const float var = dpp_sum16(d.x * d.x + d.y * d.y + d.z * d.z + d.w * d.w) * (1.0f / 64.0f);
        const float rstd = rsqrtf(var + 64e-5f);
        const u32x2 ur = *(const u32x2*)(a.sr + (size_t)tl * 512 + ch), uk = *(const u32x2*)(a.sk + (size_t)tl * 512 + ch), uv = *(const u32x2*)(a.sv + (size_t)tl * 512 + ch);
        const f32x4 r4 = (f32x4){bf_lo(ur.x), bf_hi(ur.x), bf_lo(ur.y), bf_hi(ur.y)}, k4 = (f32x4){bf_lo(uk.x), bf_hi(uk.x), bf_lo(uk.y), bf_hi(uk.y)};
        const f32x4 v4 = (f32x4){bf_lo(uv.x), bf_hi(uv.x), bf_lo(uv.y), bf_hi(uv.y)};
        const f32x4 rkv = *(const f32x4*)(a.rk + ch), lw = *(const f32x4*)(a.lnw + ch), lb = *(const f32x4*)(a.lnb + ch);
        const f32x4 t = r4 * k4 * rkv;
        const float bon = dpp_sum16(t.x + t.y + t.z + t.w);
        const u32x2 gu = *(const u32x2*)(a.proj + (size_t)tl * NP + O_GR + ch);
        const f32x4 gg = (f32x4){bf_lo(gu.x), bf_hi(gu.x), bf_lo(gu.y), bf_hi(gu.y)};
        f32x4 o = d * rstd * lw + lb + v4 * bon;
#pragma unroll
        for (int j = 0; j < 4; ++j) o[j] *= siluf_(gg[j]);
        store4(a.ycat + (size_t)tl * 1024 + ch, o);
    }
}


struct CopArgs { const bf16_t *sr, *sk, *sv, *skk, *skka; const bf16_t* se; char* cops; };
__device__ __forceinline__ float mm16(const float* A, float sa, float ia, const float* B, float sb, float ib, int t, int j) {
    float acc = 0.f;
#pragma unroll
    for (int i = 0; i < 16; ++i) { const float av = sa * A[t * 17 + i] + (i == t ? ia : 0.f); const float bv = sb * B[i * 17 + j] + (i == j ? ib : 0.f); acc += av * bv; }
    return acc;
}
__device__ __forceinline__ float mm16p(const float* A, const float* B, int t, int j) {
    float acc = 0.f;
#pragma unroll
    for (int q = 0; q < 4; ++q) {
        const f32x4 a4 = *(const f32x4*)(A + t * 20 + q * 4);
        acc += a4.x * B[(q * 4 + 0) * 20 + j] + a4.y * B[(q * 4 + 1) * 20 + j] + a4.z * B[(q * 4 + 2) * 20 + j] + a4.w * B[(q * 4 + 3) * 20 + j];
    }
    return acc;
}
__device__ __forceinline__ f32x4 unpk4(const u32x2 u) { return (f32x4){bf_lo(u.x), bf_hi(u.x), bf_lo(u.y), bf_hi(u.y)}; }
__device__ __forceinline__ bf16_t bf1(float x) { return (bf16_t)(pk_bf16(x, 0.f) & 0xffffu); }
struct CopIn { u32x2 ue, ukk, uka, uk, ur, uv; };
__device__ __forceinline__ void cop_in_load(CopIn& r, const CopArgs& a, int unit, int t, int cq) {
    const int c = unit & 255, bh = unit >> 8;
    const size_t gofs = ((size_t)(bh >> 3) * 4096 + c * 16 + t) * 512 + (bh & 7) * 64 + cq * 4;
    r.ue = *(const u32x2*)(a.se + gofs);
    r.ukk = *(const u32x2*)(a.skk + gofs); r.uka = *(const u32x2*)(a.skka + gofs); r.uk = *(const u32x2*)(a.sk + gofs); r.ur = *(const u32x2*)(a.sr + gofs); r.uv = *(const u32x2*)(a.sv + gofs);
}
__device__ void cop_phase(char* smem, const CopArgs& a) {
    const int tid = otid(), t = tid >> 4, cq = tid & 15, j = cq;
    float* F = (float*)smem;
    float* Wc = F; float* KAP = F + 1088; float* RT = F + 2176; float* KT = F + 3264; float* BT = F + 4352;
    float* SM = F + 5440;
    bf16_t* STG = (bf16_t*)(F + 5440 + 15 * 320);
#define SMAT(i) (SM + (i) * 320)
    int unit = blockIdx.x;
    if (unit >= 8192) return;
    CopIn cur, nxt;
    cop_in_load(cur, a, unit, t, cq);
    nxt = cur;
#pragma unroll 1
    for (; unit < 8192; unit += gridDim.x) {
        if (unit + (int)gridDim.x < 8192) cop_in_load(nxt, a, unit + gridDim.x, t, cq);
        __syncthreads();
        *(f32x4*)(Wc + t * 68 + cq * 4) = unpk4(cur.ue);
        __syncthreads();
        if (tid < 64) {
            float x[16];
#pragma unroll
            for (int i = 0; i < 16; ++i) x[i] = Wc[i * 68 + tid];
#pragma unroll
            for (int i = 1; i < 16; ++i) x[i] += x[i - 1];
#pragma unroll
            for (int i = 0; i < 16; ++i) Wc[i * 68 + tid] = x[i];
        }
        __syncthreads();
        const f32x4 ct = *(const f32x4*)(Wc + t * 68 + cq * 4), cC = *(const f32x4*)(Wc + 15 * 68 + cq * 4);
        f32x4 cp = (f32x4){0.f, 0.f, 0.f, 0.f}; if (t > 0) cp = *(const f32x4*)(Wc + (t - 1) * 68 + cq * 4);
        const f32x4 Wt = (f32x4){__expf(-ct.x), __expf(-ct.y), __expf(-ct.z), __expf(-ct.w)}, Wp = (f32x4){__expf(-cp.x), __expf(-cp.y), __expf(-cp.z), __expf(-cp.w)};
        const f32x4 WC = (f32x4){__expf(-cC.x), __expf(-cC.y), __expf(-cC.z), __expf(-cC.w)};
        {
            const f32x4 rW = (f32x4){__expf(ct.x), __expf(ct.y), __expf(ct.z), __expf(ct.w)};
            *(f32x4*)(KAP + t * 68 + cq * 4) = unpk4(cur.ukk) * Wp;
            *(f32x4*)(RT + t * 68 + cq * 4) = unpk4(cur.ur) * Wt;
            *(f32x4*)(KT + t * 68 + cq * 4) = unpk4(cur.uk) * rW;
            *(f32x4*)(BT + t * 68 + cq * 4) = unpk4(cur.uka) * rW;
        }
        __syncthreads();
        {
            float m1 = 0.f, m2 = 0.f, m3 = 0.f, m4 = 0.f;
#pragma unroll 4
            for (int i = 0; i < 16; ++i) {
                const f32x4 ka = *(const f32x4*)(KAP + t * 68 + i * 4), rt = *(const f32x4*)(RT + t * 68 + i * 4), kt = *(const f32x4*)(KT + j * 68 + i * 4), bt = *(const f32x4*)(BT + j * 68 + i * 4);
                m1 += ka.x * kt.x + ka.y * kt.y + ka.z * kt.z + ka.w * kt.w; m2 += ka.x * bt.x + ka.y * bt.y + ka.z * bt.z + ka.w * bt.w;
                m3 += rt.x * kt.x + rt.y * kt.y + rt.z * kt.z + rt.w * kt.w; m4 += rt.x * bt.x + rt.y * bt.y + rt.z * bt.z + rt.w * bt.w;
            }
            const float idv = t == j ? 1.f : 0.f;
            SMAT(0)[t * 20 + j] = j < t ? m1 : 0.f; SMAT(1)[t * 20 + j] = j < t ? m2 : 0.f; SMAT(2)[t * 20 + j] = j <= t ? m3 : 0.f; SMAT(3)[t * 20 + j] = j <= t ? m4 : 0.f;
            SMAT(12)[t * 20 + j] = idv - (j < t ? m2 : 0.f);
        }
        __syncthreads();
        const float idv = t == j ? 1.f : 0.f;
        { const float v = mm16p(SMAT(1), SMAT(1), t, j); SMAT(4)[t * 20 + j] = v; SMAT(13)[t * 20 + j] = v + idv; } __syncthreads();
        { const float v = mm16p(SMAT(4), SMAT(4), t, j); SMAT(5)[t * 20 + j] = v; SMAT(14)[t * 20 + j] = v + idv;
          SMAT(7)[t * 20 + j] = mm16p(SMAT(12), SMAT(13), t, j); } __syncthreads();
        SMAT(6)[t * 20 + j] = mm16p(SMAT(5), SMAT(5), t, j) + idv;
        SMAT(8)[t * 20 + j] = mm16p(SMAT(7), SMAT(14), t, j); __syncthreads();
        SMAT(9)[t * 20 + j] = mm16p(SMAT(8), SMAT(6), t, j); __syncthreads();
        SMAT(10)[t * 20 + j] = mm16p(SMAT(9), SMAT(0), t, j);
        SMAT(11)[t * 20 + j] = mm16p(SMAT(3), SMAT(9), t, j); __syncthreads();
        char* U = a.cops + (size_t)unit * COP_STRIDE;
        ((bf16_t*)(U + 4096))[t * 16 + j] = bf1(SMAT(2)[t * 20 + j] - mm16p(SMAT(11), SMAT(0), t, j));
        f32x4 q3 = (f32x4){0.f, 0.f, 0.f, 0.f}, q1 = *(const f32x4*)(RT + t * 68 + cq * 4), kh = *(const f32x4*)(KT + t * 68 + cq * 4);
#pragma unroll 4
        for (int i = 0; i < 16; ++i) {
            const f32x4 kap = *(const f32x4*)(KAP + i * 68 + cq * 4), bt = *(const f32x4*)(BT + i * 68 + cq * 4);
            q3 += kap * SMAT(9)[t * 20 + i]; q1 -= kap * SMAT(11)[t * 20 + i]; kh -= bt * SMAT(10)[i * 20 + t];
        }
        kh = kh * WC;
        const f32x4 bhv = *(const f32x4*)(BT + t * 68 + cq * 4) * WC;
        const int p0 = 32 * (cq >> 3) + 8 * (cq & 3) + 4 * ((cq >> 2) & 1);
        store4((bf16_t*)U + t * 64 + p0, q3);
        store4((bf16_t*)U + (16 + t) * 64 + p0, q1);
        const int so = (t >> 2) * 8 + (t & 3);
#pragma unroll
        for (int jj = 0; jj < 4; ++jj) { STG[(cq * 4 + jj) * 32 + so] = bf1(bhv[jj]); STG[(cq * 4 + jj) * 32 + so + 4] = bf1(kh[jj]); }
        STG[2048 + (cq * 4 + 0) * 16 + t] = (bf16_t)(cur.uv.x & 0xffffu); STG[2048 + (cq * 4 + 1) * 16 + t] = (bf16_t)(cur.uv.x >> 16);
        STG[2048 + (cq * 4 + 2) * 16 + t] = (bf16_t)(cur.uv.y & 0xffffu); STG[2048 + (cq * 4 + 3) * 16 + t] = (bf16_t)(cur.uv.y >> 16);
        if (tid < 64) ((float*)(U + 10752))[tid] = __expf(-Wc[15 * 68 + tid]);
        __syncthreads();
        *(u32x4*)(U + 4608 + tid * 16) = *(const u32x4*)((const char*)STG + tid * 16);
        if (tid < 128) *(u32x4*)(U + 8704 + tid * 16) = *(const u32x4*)((const char*)STG + 4096 + tid * 16);
        cur = nxt;
    }
#undef SMAT
}

__device__ __forceinline__ int cop_lds_of(int q) {
    if (q < 256) { const int row = q >> 3, pos = q & 7; return row * 128 + ((pos ^ ((row >> 1) & 7)) << 4); }
    if (q < 288) return q * 16;
    if (q < 544) { const int q2 = q - 288; return 4608 + (q2 & 3) * 1024 + (q2 >> 2) * 16; }
    return q * 16;
}
struct CopOps { u32x4 qc[2][2]; u32x2 q2; u32x4 bk[4]; u32x2 vt; f32x4 wc[4]; };
__device__ void chunk_scan(char* smem, const char* cops, float* yraw, int bl, int hh) {
    const int tid = otid(), lane = tid & 63, w = tid >> 6, fr = lane & 15, fq = lane >> 4;
    f32x4 st[4];
#pragma unroll
    for (int kt = 0; kt < 4; ++kt) st[kt] = (f32x4){0.f, 0.f, 0.f, 0.f};
    const char* U = cops + (size_t)((bl * 8 + hh) * 256) * COP_STRIDE + tid * 16;
    float* yp = yraw + ((size_t)bl * 4096 + fq * 4) * 512 + hh * 64 + w * 16 + fr;
    const int l0 = cop_lds_of(tid), l1 = cop_lds_of(tid + 256), l2 = cop_lds_of(tid < 176 ? tid + 512 : 0);
    const bool has2 = tid < 176;
    const int qo0 = fr * 128 + (((0 * 4 + fq) ^ ((fr >> 1) & 7)) << 4), qo1 = fr * 128 + (((1 * 4 + fq) ^ ((fr >> 1) & 7)) << 4);
    const int q2o = 4096 + fr * 32 + fq * 8, bko = 4608 + fq * 1024 + fr * 16, vto = 8704 + (w * 16 + fr) * 32 + fq * 8, wco = 10752 + fq * 16;
    u32x4 sA[3], sB[3], sC[3], sD[3];
    __builtin_amdgcn_s_setprio(3);
#define CS_LOAD(S, C) do { const char* g_ = U + (size_t)(C) * COP_STRIDE; S[0] = *(const u32x4*)g_; S[1] = *(const u32x4*)(g_ + 4096); if (has2) S[2] = *(const u32x4*)(g_ + 8192); } while (0)
#define CS_WRITE(S, SLOT) do { char* d_ = smem + (SLOT) * 11008; *(u32x4*)(d_ + l0) = S[0]; *(u32x4*)(d_ + l1) = S[1]; if (has2) *(u32x4*)(d_ + l2) = S[2]; } while (0)
    sA[2] = (u32x4){0u, 0u, 0u, 0u}; sB[2] = sA[2]; sC[2] = sA[2]; sD[2] = sA[2];
    CS_LOAD(sA, 0); CS_LOAD(sB, 1); CS_LOAD(sC, 2); CS_LOAD(sD, 3);
    CopOps R0, R1;
    auto ldsload = [&](CopOps& r, const char* L) {
        r.qc[0][0] = *(const u32x4*)(L + qo0); r.qc[0][1] = *(const u32x4*)(L + qo1); r.qc[1][0] = *(const u32x4*)(L + 2048 + qo0); r.qc[1][1] = *(const u32x4*)(L + 2048 + qo1);
        r.q2 = *(const u32x2*)(L + q2o); r.vt = *(const u32x2*)(L + vto);
#pragma unroll
        for (int kt = 0; kt < 4; ++kt) { r.bk[kt] = *(const u32x4*)(L + bko + kt * 256); r.wc[kt] = *(const f32x4*)(L + wco + kt * 64); }
    };
    auto compute = [&](const int c, const CopOps& r) {
        const u32x4 (&qc)[2][2] = r.qc; const u32x4 (&bk)[4] = r.bk; const f32x4 (&wc)[4] = r.wc; const u32x2 q2 = r.q2, vt = r.vt;
        u32x4 hi[2], lo[2];
#pragma unroll
        for (int s = 0; s < 2; ++s) {
            const f32x4 a0 = st[2 * s], a1 = st[2 * s + 1];
            hi[s].x = pk_bf16(a0.x, a0.y); hi[s].y = pk_bf16(a0.z, a0.w); hi[s].z = pk_bf16(a1.x, a1.y); hi[s].w = pk_bf16(a1.z, a1.w);
            lo[s].x = pk_bf16(a0.x - bf_lo(hi[s].x), a0.y - bf_hi(hi[s].x)); lo[s].y = pk_bf16(a0.z - bf_lo(hi[s].y), a0.w - bf_hi(hi[s].y));
            lo[s].z = pk_bf16(a1.x - bf_lo(hi[s].z), a1.y - bf_hi(hi[s].z)); lo[s].w = pk_bf16(a1.z - bf_lo(hi[s].w), a1.w - bf_hi(hi[s].w));
        }
        f32x4 p1 = (f32x4){0.f, 0.f, 0.f, 0.f}, p2 = p1;
#pragma unroll
        for (int s = 0; s < 2; ++s) {
            p1 = __builtin_amdgcn_mfma_f32_16x16x32_bf16(__builtin_bit_cast(bf16x8, qc[0][s]), __builtin_bit_cast(bf16x8, hi[s]), p1, 0, 0, 0);
            p2 = __builtin_amdgcn_mfma_f32_16x16x32_bf16(__builtin_bit_cast(bf16x8, qc[1][s]), __builtin_bit_cast(bf16x8, hi[s]), p2, 0, 0, 0);
            p1 = __builtin_amdgcn_mfma_f32_16x16x32_bf16(__builtin_bit_cast(bf16x8, qc[0][s]), __builtin_bit_cast(bf16x8, lo[s]), p1, 0, 0, 0);
            p2 = __builtin_amdgcn_mfma_f32_16x16x32_bf16(__builtin_bit_cast(bf16x8, qc[1][s]), __builtin_bit_cast(bf16x8, lo[s]), p2, 0, 0, 0);
        }
        p2 = __builtin_amdgcn_mfma_f32_16x16x32_bf16(__builtin_bit_cast(bf16x8, ((u32x4){q2.x, q2.y, 0u, 0u})), __builtin_bit_cast(bf16x8, ((u32x4){vt.x, vt.y, 0u, 0u})), p2, 0, 0, 0);
#pragma unroll
        for (int j = 0; j < 4; ++j) yp[(size_t)(c * 16 + j) * 512] = p2[j];
        u32x4 xh, xl;
        xh.x = pk_bf16(-p1.x, -p1.y); xh.y = pk_bf16(-p1.z, -p1.w); xh.z = vt.x; xh.w = vt.y;
        xl.x = pk_bf16(-p1.x - bf_lo(xh.x), -p1.y - bf_hi(xh.x)); xl.y = pk_bf16(-p1.z - bf_lo(xh.y), -p1.w - bf_hi(xh.y)); xl.z = 0u; xl.w = 0u;
#pragma unroll
        for (int kt = 0; kt < 4; ++kt) {
            f32x4 acc = st[kt] * wc[kt];
            acc = __builtin_amdgcn_mfma_f32_16x16x32_bf16(__builtin_bit_cast(bf16x8, bk[kt]), __builtin_bit_cast(bf16x8, xh), acc, 0, 0, 0);
            acc = __builtin_amdgcn_mfma_f32_16x16x32_bf16(__builtin_bit_cast(bf16x8, bk[kt]), __builtin_bit_cast(bf16x8, xl), acc, 0, 0, 0);
            st[kt] = acc;
        }
    };
    CS_WRITE(sA, 0); CS_LOAD(sA, 4);
    __syncthreads();
    ldsload(R0, smem);
#define CS_STEP(S, C, RC, RN) do { if ((C) + 1 < 256) CS_WRITE(S, ((C) + 1) & 1); if ((C) + 5 < 256) CS_LOAD(S, (C) + 5); __syncthreads(); \
        if ((C) + 1 < 256) ldsload(RN, smem + (((C) + 1) & 1) * 11008); compute((C), RC); } while (0)
#pragma unroll 1
    for (int c = 0; c < 256; c += 4) { CS_STEP(sB, c, R0, R1); CS_STEP(sC, c + 1, R1, R0); CS_STEP(sD, c + 2, R0, R1); CS_STEP(sA, c + 3, R1, R0); }
#undef CS_STEP
#undef CS_LOAD
#undef CS_WRITE
    __builtin_amdgcn_s_setprio(0);
    __syncthreads();
}

__global__ void __launch_bounds__(256, 2) fwd_megakernel(Params p) {
    __shared__ __attribute__((aligned(16))) char smem[65536 + 64];
    cg::grid_group grid = cg::this_grid();
    if (threadIdx.x == 0) { ((volatile LAS unsigned*)(smem + 65536))[0] = 0u; ((volatile LAS unsigned*)(smem + 65536))[1] = 0u; }
    __syncthreads();
    const XcdBarrier xb = xcd_barrier_post((unsigned*)(p.ws + OFF_BAR), (volatile LAS unsigned*)(smem + 65536));
    const unsigned cu_key = (xb.x & 7u) * 256u + ((unsigned)__builtin_amdgcn_s_getreg((7 << 11) | (8 << 6) | 4) & 0xffu);
    if (threadIdx.x == 0) (void)xb_add((unsigned*)(p.ws + OFF_CUCNT) + cu_key, 1u);
    char* ws = p.ws;
    float* mod = (float*)(ws + OFF_MOD);
    const float* cs = (const float*)(ws + OFF_COS); const float* sn = (const float*)(ws + OFF_SIN);
    bf16_t* hbuf = (bf16_t*)(ws + OFF_H);
    bf16_t* proj = (bf16_t*)(ws + OFF_PROJ);
    bf16_t *sr = (bf16_t*)(ws + OFF_SR), *sk = (bf16_t*)(ws + OFF_SK), *sv = (bf16_t*)(ws + OFF_SV), *skk = (bf16_t*)(ws + OFF_SKK), *skka = (bf16_t*)(ws + OFF_SKKA);
    bf16_t* se = (bf16_t*)(ws + OFF_SW);
    float *rsq = (float*)(ws + OFF_RSQ), *rskv = (float*)(ws + OFF_RSKV);
    bf16_t *Qh = (bf16_t*)(ws + OFF_Q), *Kh = (bf16_t*)(ws + OFF_K), *Vt = (bf16_t*)(ws + OFF_VT);
    float* yraw = (float*)(ws + OFF_YRAW);
    bf16_t* ycat = (bf16_t*)(ws + OFF_YCAT);
    bf16_t* vfirst = (bf16_t*)(ws + OFF_VFIRST);
    int* ctrl = (int*)(ws + OFF_CTRL);
    volatile int* s_item = (volatile int*)(smem + 65536 + 16);

    for (int rep = 0; rep < REP_P0; ++rep) prologue(smem, p);
    grid.sync();
    bool scan_role;
    {
        const unsigned k2 = (cu_key & ~255u) + threadIdx.x;
        const int lidx = __syncthreads_count(k2 < cu_key && xb_ld((unsigned*)(p.ws + OFF_CUCNT) + k2) > 0u);
        scan_role = lidx < 24;
    }

    norm_phase(p.x, p.norm_g, mod, hbuf, 0);
    GSYNC();
#pragma unroll 1
    for (int l = 0; l < NL; ++l) {
        const float* modl = mod + (size_t)l * 8 * 3072;
#pragma unroll 1
        for (int half = 0; half < 2; ++half) {
            const int tgbase = half * TH;
            {
                EpiProj e{proj, rsq, rskv, smem};
                const bf16_t* A = hbuf; const bf16_t* Bt = (const bf16_t*)(ws + OFF_WIN) + (size_t)l * NP * 1024;
                const int xcd = blockIdx.x & 7, loc = blockIdx.x >> 3, nloc = gridDim.x >> 3;
                for (int rep = 0; rep < REP_P2; ++rep) {
                if (rep) xcd_barrier(xb);
                for (int jn = loc; jn < 432; jn += nloc) {
                    const int mg = jn / 216, rem = jn - mg * 216, nt = rem >> 3, mi = rem & 7, mt = xcd * 16 + mg * 8 + mi;
                    gemm_tile(smem, A, 1024, Bt, 1024, 1024, mt * 128, nt * 128, e);
                }
                }
            }
            GSYNC();
            {
                PrepArgs pa;
                pa.proj = proj; pa.mu = p.mu_shift + l * 1664; pa.muv = p.mu_vmix + (l > 0 ? (l - 1) * 32 : 0);
                pa.wdec = (const bf16_t*)(ws + OFF_WDEC) + (size_t)l * 512 * 64; pa.wicl = (const bf16_t*)(ws + OFF_WICL) + (size_t)l * 512 * 64;
                pa.wvm = (const bf16_t*)(ws + OFF_WVM) + (size_t)l * 512 * 32;
                pa.w0 = p.w0 + l * 512; pa.a0 = p.a0 + l * 512; pa.v0 = p.v0 + (l > 0 ? (l - 1) * 512 : 0); pa.k_k = p.k_k + l * 512; pa.k_a = p.k_a + l * 512;
                pa.cs = cs; pa.sn = sn; pa.sr = sr; pa.sk = sk; pa.sv = sv; pa.skk = skk; pa.skka = skka; pa.se = se; pa.vfirst = vfirst; pa.Kh = Kh;
                pa.layer = l; pa.tgbase = tgbase;
                EpiKV ekv{Kh, Vt, rskv, smem};
                EpiQ eq{Qh, rsq, cs, sn, tgbase, smem};
                const bf16_t* Bkv = (const bf16_t*)(ws + OFF_WUKV) + (size_t)l * 1024 * 256; const bf16_t* Bq = (const bf16_t*)(ws + OFF_WUQ) + (size_t)l * 768 * 384;
                for (int rep = 0; rep < REP_P3; ++rep) {
                if (rep) xcd_barrier(xb);
                {
                    for (int it = blockIdx.x; it < 1024; it += gridDim.x) prep_tile(smem, pa, it >> 2, it & 3);
                    const int xcd = blockIdx.x & 7, loc = blockIdx.x >> 3, nloc = gridDim.x >> 3;
                    for (int j = loc; j < 128; j += nloc) gemm_tile(smem, proj + O_CKV, NP, Bkv, 256, 256, (xcd * 16 + (j >> 3)) * 128, (j & 7) * 128, ekv);
                    for (int j = loc; j < 96; j += nloc) { const int ml = j / 6, nt = j - ml * 6; gemm_tile(smem, proj + O_CQ, NP, Bq, 384, 384, (xcd * 16 + ml) * 128, nt * 128, eq); }
                }
                }
            }
            GSYNC();
            {
                CopArgs ca{sr, sk, sv, skk, skka, se, ws + OFF_COPS};
                cop_phase(smem, ca);
            }
            GSYNC();
            {
                int* ctr = ctrl + (l * 2 + half);
                for (;;) {
                    __syncthreads();
                    if (threadIdx.x == 0) *s_item = atomicAdd(ctr, 1);
                    __syncthreads();
                    const int item = *s_item;
                    const int nconv = (half == 0 && l + 1 < NL) ? 512 : 0;
                    if (item >= 32 + 1024 + nconv) break;
                    if (item < 32) chunk_scan(smem, ws + OFF_COPS, yraw, item >> 3, item & 7);
                    else if (item < 32 + 1024) { const int t = item - 32, qt = 31 - (t >> 5), bh = t & 31; attn_tile(smem, Qh, Kh, Vt, proj, ycat, bh >> 3, bh & 7, qt); }
                    else convert_layer(smem, p, l + 1, item - (32 + 1024), 512);
                }
            }
            GSYNC();
            {
                FinArgs fa{yraw, sr, sk, sv, proj, p.lnx_w + l * 512, p.lnx_b + l * 512, p.r_k + l * 512, ycat, nullptr, nullptr};
                for (int rep = 0; rep < REP_P5; ++rep) { if (rep) xcd_barrier(xb); rwkv_finalize(fa); }
                const int ln = half == 0 ? l : l + 1, hn = half ^ 1;
                if (ln < NL) norm_phase(ln == 0 ? p.x : p.out, p.norm_g + ln * 1024, mod + (size_t)ln * 8 * 3072, hbuf, hn * TH);
            }
            GSYNC();
            {
                for (int rep = 0; rep < REP_P6; ++rep) {
                if (rep) xcd_barrier(xb);
                EpiOut eo{l == 0 ? p.x : p.out, p.out, modl, tgbase, rep == REP_P6 - 1 ? 1.0f : 0.0f};
                const bf16_t* Bo = (const bf16_t*)(ws + OFF_WOUT) + (size_t)l * 1024 * 1024;
                {
                    const int xcd = blockIdx.x & 7, loc = blockIdx.x >> 3, nloc = gridDim.x >> 3;
                    for (int j = loc; j < 128; j += nloc) gemm_tile(smem, ycat, 1024, Bo, 1024, 1024, (xcd * 16 + (j >> 3)) * 128, (j & 7) * 128, eo);
                }
                }
            }
        }
    }
    GSYNC();
    final_norm(p.out, p.final_g);
}

extern "C" void kernel_launch(void* const* d_in, const int* in_sizes, int n_in, void* d_out, int out_size, void* d_ws, size_t ws_size, hipStream_t stream) {
    static int grid_blocks = 0;
    if (!grid_blocks) {
        int dev = 0, cus = 0, per_cu = 0;
        (void)hipGetDevice(&dev);
        (void)hipDeviceGetAttribute(&cus, hipDeviceAttributeMultiprocessorCount, dev);
        (void)hipOccupancyMaxActiveBlocksPerMultiprocessor(&per_cu, fwd_megakernel, 256, 0);
        if (per_cu > 2) per_cu = 2;
        if (per_cu < 1) per_cu = 1;
        grid_blocks = cus * per_cu;
        if (grid_blocks % 8) grid_blocks -= grid_blocks % 8;
    }
    Params p{};
    p.x = (const float*)d_in[0]; p.c = (const float*)d_in[1]; p.pos = (const int*)d_in[2];
    p.norm_g = (const float*)d_in[3]; p.w_ada = (const float*)d_in[4]; p.b_ada = (const float*)d_in[5]; p.w_in = (const float*)d_in[6];
    p.w_vmd = (const float*)d_in[7]; p.mu_shift = (const float*)d_in[8]; p.mu_vmix = (const float*)d_in[9]; p.w0 = (const float*)d_in[10];
    p.w_dec = (const float*)d_in[11]; p.a0 = (const float*)d_in[12]; p.w_icl = (const float*)d_in[13]; p.v0 = (const float*)d_in[14];
    p.w_vmu = (const float*)d_in[15]; p.k_k = (const float*)d_in[16]; p.k_a = (const float*)d_in[17]; p.r_k = (const float*)d_in[18];
    p.lnx_w = (const float*)d_in[19]; p.lnx_b = (const float*)d_in[20]; p.qng = (const float*)d_in[21]; p.kvng = (const float*)d_in[22];
    p.w_uq = (const float*)d_in[23]; p.w_ukv = (const float*)d_in[24]; p.w_out = (const float*)d_in[25]; p.final_g = (const float*)d_in[26];
    p.out = (float*)d_out; p.ws = (char*)d_ws;
    (void)hipMemsetAsync((char*)d_ws + OFF_BAR, 0, 16384 + 4096 + 8192, stream);
    void* args[] = {&p};
    hipError_t e = hipLaunchCooperativeKernel((void*)fwd_megakernel, dim3(grid_blocks), dim3(256), args, 0, stream);
    if (e != hipSuccess) fprintf(stderr, "cooperative launch failed: %s (grid %d)\n", hipGetErrorString(e), grid_blocks);
}
```

```cpp
#include <hip/hip_runtime.h>
#include <hip/hip_cooperative_groups.h>
#include <cstdio>
#include <cstdint>
namespace cg = cooperative_groups;
constexpr int REP_P1 = 1, REP_P2 = 1, REP_P3 = 1, REP_P4 = 1, REP_P5 = 1, REP_P6 = 1, REP_SYNC = 1, REP_P0 = 1;
#define GSYNC() do { for (int r_ = 0; r_ < REP_SYNC; ++r_) xcd_barrier(xb); } while (0)


typedef unsigned short bf16_t;
typedef short bf16x8 __attribute__((ext_vector_type(8)));
typedef float f32x4 __attribute__((ext_vector_type(4)));
typedef float f32x2 __attribute__((ext_vector_type(2)));
typedef unsigned u32x4 __attribute__((ext_vector_type(4)));
typedef unsigned u32x2 __attribute__((ext_vector_type(2)));
#define LAS __attribute__((address_space(3)))

constexpr int DM = 1024, NB = 8, SEQ = 4096, NT = NB * SEQ, TH = NT / 2, NL = 4;
constexpr int NP = 3456;
constexpr int O_GR = 1664, O_CQ = 2176, O_CKV = 2560, O_KR = 2816, O_GM = 2848, INW = 3360;
constexpr float QSCALE = 0.10206207261596577f * 1.4426950408889634f;

constexpr size_t al256(size_t x) { return (x + 255) & ~(size_t)255; }
constexpr size_t OFF_BAR = 0;
constexpr size_t OFF_CTRL = 16384;
constexpr size_t OFF_CUCNT = 16384 + 4096;
constexpr size_t OFF_MOD = 16384 + 4096 + 8192;
constexpr size_t OFF_COS = OFF_MOD + al256((size_t)NL * NB * 3072 * 4);
constexpr size_t OFF_SIN = OFF_COS + (size_t)NT * 16 * 4;
constexpr size_t OFF_WIN = OFF_SIN + (size_t)NT * 16 * 4;
constexpr size_t OFF_WOUT = OFF_WIN + (size_t)NL * NP * 1024 * 2;
constexpr size_t OFF_WUQ = OFF_WOUT + (size_t)NL * 1024 * 1024 * 2;
constexpr size_t OFF_WUKV = OFF_WUQ + (size_t)NL * 768 * 384 * 2;
constexpr size_t OFF_WDEC = OFF_WUKV + (size_t)NL * 1024 * 256 * 2;
constexpr size_t OFF_WICL = OFF_WDEC + (size_t)NL * 512 * 64 * 2;
constexpr size_t OFF_WVM = OFF_WICL + (size_t)NL * 512 * 64 * 2;
constexpr size_t OFF_VFIRST = OFF_WVM + (size_t)NL * 512 * 32 * 2;
constexpr size_t OFF_H = OFF_VFIRST + (size_t)NT * 512 * 2;
constexpr int COP_STRIDE = 11008;
constexpr size_t OFF_COPS = OFF_H;
constexpr size_t OFF_PROJ = OFF_H + (size_t)8192 * COP_STRIDE;
constexpr size_t OFF_SR = OFF_PROJ + (size_t)TH * NP * 2;
constexpr size_t OFF_SK = OFF_SR + (size_t)TH * 512 * 2;
constexpr size_t OFF_SV = OFF_SK + (size_t)TH * 512 * 2;
constexpr size_t OFF_SKK = OFF_SV + (size_t)TH * 512 * 2;
constexpr size_t OFF_SKKA = OFF_SKK + (size_t)TH * 512 * 2;
constexpr size_t OFF_SW = OFF_SKKA + (size_t)TH * 512 * 2;
constexpr size_t OFF_RSQ = OFF_SW + (size_t)TH * 512 * 4;
constexpr size_t OFF_RSKV = OFF_RSQ + (size_t)TH * 8 * 4;
constexpr size_t OFF_Q = OFF_RSKV + (size_t)TH * 4 * 4;
constexpr size_t OFF_K = OFF_Q + (size_t)TH * 768 * 2;
constexpr size_t OFF_VT = OFF_K + (size_t)TH * 768 * 2;
constexpr size_t OFF_YRAW = OFF_VT + (size_t)TH * 512 * 2;
constexpr size_t OFF_YCAT = OFF_YRAW + (size_t)TH * 512 * 4;
constexpr size_t WS_TOTAL = OFF_YCAT + (size_t)TH * 1024 * 2;
static_assert(WS_TOTAL <= (size_t)536870912, "workspace exceeds 512 MiB");

struct Params {
    const float *x, *c; const int* pos;
    const float *norm_g, *w_ada, *b_ada, *w_in, *w_vmd, *mu_shift, *mu_vmix, *w0, *w_dec, *a0, *w_icl, *v0, *w_vmu;
    const float *k_k, *k_a, *r_k, *lnx_w, *lnx_b, *qng, *kvng, *w_uq, *w_ukv, *w_out, *final_g;
    float* out; char* ws;
};

__device__ __forceinline__ int otid() { int t = threadIdx.x; asm volatile("" : "+v"(t)); return t; }
__device__ __forceinline__ unsigned pk_bf16(float lo, float hi) { unsigned r; asm("v_cvt_pk_bf16_f32 %0, %1, %2" : "=v"(r) : "v"(lo), "v"(hi)); return r; }
__device__ __forceinline__ float bf_lo(unsigned u) { return __uint_as_float(u << 16); }
__device__ __forceinline__ float bf_hi(unsigned u) { return __uint_as_float(u & 0xffff0000u); }
__device__ __forceinline__ float sigmoidf_(float x) { return 1.0f / (1.0f + __expf(-x)); }
__device__ __forceinline__ float siluf_(float x) { return x / (1.0f + __expf(-x)); }
__device__ __forceinline__ float tanhf_(float x) { const float t = __expf(2.0f * x); return 1.0f - 2.0f / (t + 1.0f); }
template <int CTRL> __device__ __forceinline__ float dpp_add(float x) {
    return x + __int_as_float(__builtin_amdgcn_update_dpp(0, __float_as_int(x), CTRL, 0xf, 0xf, true));
}
__device__ __forceinline__ float dpp_sum16(float x) {
    x = dpp_add<0xB1>(x);
    x = dpp_add<0x4E>(x);
    x = dpp_add<0x141>(x);
    x = dpp_add<0x140>(x);
    return x;
}
__device__ __forceinline__ void dpp_sum16x2(float& a, float& b) {
    a = dpp_add<0xB1>(a); b = dpp_add<0xB1>(b);
    a = dpp_add<0x4E>(a); b = dpp_add<0x4E>(b);
    a = dpp_add<0x141>(a); b = dpp_add<0x141>(b);
    a = dpp_add<0x140>(a); b = dpp_add<0x140>(b);
}
__device__ __forceinline__ float wave_sum64(float x) {
    x += __shfl_xor(x, 1); x += __shfl_xor(x, 2); x += __shfl_xor(x, 4); x += __shfl_xor(x, 8); x += __shfl_xor(x, 16); x += __shfl_xor(x, 32);
    return x;
}


#define XB_TMO      128
#define XB_XCNT(j)  (256  + 64 * (j))
#define XB_XSUB(j)  (1280 + 64 * (j))
#define XB_XGEN(j)  (2304 + 64 * (j))
#define XB_TOP      3328
#define XB_TOPGEN   3392
#define XCD_BAR_WORDS 3456
#define XB_SPIN_CAP (1u << 18)
__device__ __forceinline__ unsigned xb_ld(unsigned* p)              { return __hip_atomic_load(p, __ATOMIC_RELAXED, __HIP_MEMORY_SCOPE_AGENT); }
__device__ __forceinline__ unsigned xb_add(unsigned* p, unsigned v) { return __hip_atomic_fetch_add(p, v, __ATOMIC_RELAXED, __HIP_MEMORY_SCOPE_AGENT); }
__device__ __forceinline__ unsigned xb_xcc_id() { return (unsigned)__builtin_amdgcn_s_getreg((3 << 11) | 20) & 0xFu; }
#define XB_SPIN(cond, bar) do { unsigned _sp = 0; while (cond) { __builtin_amdgcn_s_sleep(1); \
    if ((++_sp & 255u) == 0u) { if (xb_ld(&(bar)[XB_TMO])) break; if (_sp > XB_SPIN_CAP) { atomicAdd(&(bar)[XB_TMO], 1u); break; } } } } while (0)
struct XcdBarrier { unsigned* bar; unsigned x; volatile LAS unsigned* st; };
__device__ __forceinline__ XcdBarrier xcd_barrier_post(unsigned* bar, volatile LAS unsigned* st) {
    XcdBarrier b; b.bar = bar; b.x = xb_xcc_id(); b.st = st;
    if (threadIdx.x == 0) (void)xb_add(&bar[XB_XCNT(b.x)], 1u);
    return b;
}
__device__ __forceinline__ void xcd_barrier_complete(unsigned* bar, unsigned x, unsigned& nloc, unsigned& nx) {
    const unsigned G = gridDim.x * gridDim.y * gridDim.z;
    unsigned sum, cnt, mine, sp = 0u;
    for (;;) {
        sum = 0u; cnt = 0u; mine = 0u;
#pragma unroll
        for (unsigned j = 0; j < 16; ++j) { const unsigned c = xb_ld(&bar[XB_XCNT(j)]); sum += c; cnt += (c > 0u) ? 1u : 0u; mine = (j == x) ? c : mine; }
        if (sum == G) break;
        __builtin_amdgcn_s_sleep(1);
        if ((++sp & 255u) == 0u) { if (xb_ld(&bar[XB_TMO])) break; if (sp > XB_SPIN_CAP) { atomicAdd(&bar[XB_TMO], 1u); break; } }
    }
    nloc = mine > 0u ? mine : 1u; nx = cnt > 0u ? cnt : 1u;
}
__device__ __forceinline__ void xcd_barrier(const XcdBarrier& b) {
    asm volatile("s_waitcnt vmcnt(0)" ::: "memory");
    __syncthreads();
    if (threadIdx.x == 0) {
        unsigned* bar = b.bar;
        __builtin_amdgcn_s_waitcnt(0);
        unsigned nloc = b.st[0], nx = b.st[1];
        if (nloc == 0u) { xcd_barrier_complete(bar, b.x, nloc, nx); b.st[0] = nloc; b.st[1] = nx; }
        const unsigned old = xb_add(&bar[XB_XSUB(b.x)], 1u);
        const unsigned gen = old / nloc;
        if (old + 1u == (gen + 1u) * nloc) {
            __builtin_amdgcn_fence(__ATOMIC_RELEASE, "agent");
            asm volatile("s_waitcnt vmcnt(0)" ::: "memory");
            const unsigned og = xb_add(&bar[XB_TOP], 1u);
            const unsigned tg = og / nx;
            if (og + 1u == (tg + 1u) * nx) xb_add(&bar[XB_TOPGEN], 1u);
            else XB_SPIN(xb_ld(&bar[XB_TOPGEN]) == tg, bar);
            __builtin_amdgcn_fence(__ATOMIC_ACQUIRE, "agent");
            xb_add(&bar[XB_XGEN(b.x)], 1u);
            asm volatile("s_waitcnt vmcnt(0)" ::: "memory");
        } else {
            XB_SPIN(xb_ld(&bar[XB_XGEN(b.x)]) == gen, bar);
            __builtin_amdgcn_fence(__ATOMIC_ACQUIRE, "agent");
            asm volatile("s_waitcnt vmcnt(0)" ::: "memory");
        }
    }
    __syncthreads();
}

__device__ void transpose_job(float* tile, const float* __restrict__ src, int ld, int K, int N, bf16_t* __restrict__ dst, int dst_rows,
                              const float* __restrict__ kscale, const float* __restrict__ src2, int ld2, int n2lo, int n2hi, int& rot, int idx, int nidx) {
    const int nkt = (K + 63) >> 6, nnt = (dst_rows + 63) >> 6, ntiles = nkt * nnt;
    const int tid_ = otid(); const int tx = tid_ & 63, ty = tid_ >> 6;
    const int first = (idx + nidx - rot % nidx) % nidx;
    rot += ntiles;
    for (int t = first; t < ntiles; t += nidx) {
        const int kt = t % nkt, nt = t / nkt, k0 = kt * 64, n0 = nt * 64;
#pragma unroll 4
        for (int i = 0; i < 16; ++i) {
            const int k = k0 + ty + 4 * i, n = n0 + tx; float v = 0.f;
            if (k < K) {
                if (n < N) { v = src[(size_t)k * ld + n]; if (kscale) v *= kscale[k]; }
                else if (src2 && n >= n2lo && n < n2hi) v = src2[(size_t)k * ld2 + (n - n2lo)];
            }
            tile[(ty + 4 * i) * 65 + tx] = v;
        }
        __syncthreads();
#pragma unroll 4
        for (int i = 0; i < 16; ++i) {
            const int n = n0 + ty + 4 * i, k = k0 + tx;
            if (n < dst_rows && k < K) dst[(size_t)n * K + k] = (bf16_t)(pk_bf16(tile[tx * 65 + ty + 4 * i], 0.f) & 0xffffu);
        }
        __syncthreads();
    }
}

__device__ void mod_job(float* lds, const Params& p, float* __restrict__ mod) {
    float* cact = lds;
    float* red = lds + 8192;
    const int tid = otid();
    bool have = false;
    for (int it = (int)gridDim.x - 1 - (int)blockIdx.x; it < 192; it += gridDim.x) {
        if (!have) {
            for (int i = tid; i < 8192; i += 256) cact[i] = siluf_(p.c[i]);
            have = true;
            __syncthreads();
        }
        const int l = it / 48, n0 = (it % 48) * 64, kg = tid >> 6, n = n0 + (tid & 63);
        float a0 = 0.f, a1 = 0.f, a2 = 0.f, a3 = 0.f, a4 = 0.f, a5 = 0.f, a6 = 0.f, a7 = 0.f;
        const float* wp = p.w_ada + ((size_t)l * 1024 + kg * 256) * 3072 + n;
#pragma unroll 8
        for (int k = 0; k < 256; ++k) {
            const float w = wp[(size_t)k * 3072]; const int kk = kg * 256 + k;
            a0 += cact[kk] * w; a1 += cact[1024 + kk] * w; a2 += cact[2048 + kk] * w; a3 += cact[3072 + kk] * w;
            a4 += cact[4096 + kk] * w; a5 += cact[5120 + kk] * w; a6 += cact[6144 + kk] * w; a7 += cact[7168 + kk] * w;
        }
        float* rp = red + (kg * 64 + (tid & 63)) * 8;
        rp[0] = a0; rp[1] = a1; rp[2] = a2; rp[3] = a3; rp[4] = a4; rp[5] = a5; rp[6] = a6; rp[7] = a7;
        __syncthreads();
        {
#pragma unroll
            for (int q = 0; q < 2; ++q) {
                const int o = tid + 256 * q, nn = o >> 3, b = o & 7;
                const float s = red[(0 * 64 + nn) * 8 + b] + red[(1 * 64 + nn) * 8 + b] + red[(2 * 64 + nn) * 8 + b] + red[(3 * 64 + nn) * 8 + b];
                mod[((size_t)l * 8 + b) * 3072 + n0 + nn] = s + p.b_ada[l * 3072 + n0 + nn];
            }
        }
        __syncthreads();
    }
}

__device__ void convert_layer(char* smem, const Params& p, int l, int idx, int nidx) {
    char* ws = p.ws; float* tile = (float*)smem; int rot = 0;
    transpose_job(tile, p.w_in + (size_t)l * 1024 * INW, INW, 1024, INW, (bf16_t*)(ws + OFF_WIN) + (size_t)l * NP * 1024, NP, nullptr,
                  l > 0 ? p.w_vmd + (size_t)(l - 1) * 1024 * 32 : nullptr, 32, INW, INW + 32, rot, idx, nidx);
    transpose_job(tile, p.w_out + (size_t)l * 1024 * 1024, 1024, 1024, 1024, (bf16_t*)(ws + OFF_WOUT) + (size_t)l * 1024 * 1024, 1024, nullptr, nullptr, 0, 0, 0, rot, idx, nidx);
    transpose_job(tile, p.w_uq + (size_t)l * 384 * 768, 768, 384, 768, (bf16_t*)(ws + OFF_WUQ) + (size_t)l * 768 * 384, 768, p.qng + l * 384, nullptr, 0, 0, 0, rot, idx, nidx);
    transpose_job(tile, p.w_ukv + (size_t)l * 256 * 1024, 1024, 256, 1024, (bf16_t*)(ws + OFF_WUKV) + (size_t)l * 1024 * 256, 1024, p.kvng + l * 256, nullptr, 0, 0, 0, rot, idx, nidx);
    transpose_job(tile, p.w_dec + (size_t)l * 64 * 512, 512, 64, 512, (bf16_t*)(ws + OFF_WDEC) + (size_t)l * 512 * 64, 512, nullptr, nullptr, 0, 0, 0, rot, idx, nidx);
    transpose_job(tile, p.w_icl + (size_t)l * 64 * 512, 512, 64, 512, (bf16_t*)(ws + OFF_WICL) + (size_t)l * 512 * 64, 512, nullptr, nullptr, 0, 0, 0, rot, idx, nidx);
    if (l > 0)
        transpose_job(tile, p.w_vmu + (size_t)(l - 1) * 32 * 512, 512, 32, 512, (bf16_t*)(ws + OFF_WVM) + (size_t)l * 512 * 32, 512, nullptr, nullptr, 0, 0, 0, rot, idx, nidx);
}

__device__ void prologue(char* smem, const Params& p) {
    char* ws = p.ws;
    float* tile = (float*)smem;
    { const int t0_ = otid(); if (blockIdx.x == 0 && t0_ < 64) ((int*)(ws + OFF_CTRL))[t0_] = 0; }
    {
        float* cs = (float*)(ws + OFF_COS); float* sn = (float*)(ws + OFF_SIN);
        const int gt = blockIdx.x * 256 + otid(), ng = gridDim.x * 256;
        for (int e = gt; e < NT * 16; e += ng) {
            const int t = e >> 4, i = e & 15;
            const float inv = exp2f(-(float)i * (13.287712379549449f / 16.0f));
            const float ang = (float)p.pos[t] * inv;
            cs[e] = cosf(ang); sn[e] = sinf(ang);
        }
    }
    mod_job(tile, p, (float*)(ws + OFF_MOD));
    __syncthreads();
    convert_layer(smem, p, 0, blockIdx.x, gridDim.x);
}

__device__ void norm_phase(const float* __restrict__ xin, const float* __restrict__ g, const float* __restrict__ modl, bf16_t* __restrict__ h, int tbase) {
    const int tid_ = otid(); const int lane = tid_ & 63, gw = blockIdx.x * 4 + (tid_ >> 6), nw = gridDim.x * 4;
    for (int t = tbase + gw; t < tbase + TH; t += nw) {
        const float* xr = xin + (size_t)t * 1024;
        f32x4 v[4]; float ss = 0.f;
#pragma unroll
        for (int i = 0; i < 4; ++i) { v[i] = *(const f32x4*)(xr + i * 256 + lane * 4); ss += v[i].x * v[i].x + v[i].y * v[i].y + v[i].z * v[i].z + v[i].w * v[i].w; }
        ss = wave_sum64(ss);
        const float rstd = rsqrtf(ss * (1.0f / 1024.0f) + 1e-6f);
        const float* mb = modl + (size_t)(t >> 12) * 3072;
#pragma unroll
        for (int i = 0; i < 4; ++i) {
            const int col = i * 256 + lane * 4;
            const f32x4 gg = *(const f32x4*)(g + col), sh = *(const f32x4*)(mb + col), sc = *(const f32x4*)(mb + 1024 + col);
            const f32x4 o = v[i] * rstd * gg * (sc + 1.0f) + sh;
            u32x2 w; w.x = pk_bf16(o.x, o.y); w.y = pk_bf16(o.z, o.w);
            *(u32x2*)(h + (size_t)(t - tbase) * 1024 + col) = w;
        }
    }
}

__device__ void final_norm(float* __restrict__ xio, const float* __restrict__ g) {
    const int tid_ = otid(); const int lane = tid_ & 63, gw = blockIdx.x * 4 + (tid_ >> 6), nw = gridDim.x * 4;
    for (int t = gw; t < NT; t += nw) {
        float* xr = xio + (size_t)t * 1024;
        f32x4 v[4]; float ss = 0.f;
#pragma unroll
        for (int i = 0; i < 4; ++i) { v[i] = *(const f32x4*)(xr + i * 256 + lane * 4); ss += v[i].x * v[i].x + v[i].y * v[i].y + v[i].z * v[i].z + v[i].w * v[i].w; }
        ss = wave_sum64(ss);
        const float rstd = rsqrtf(ss * (1.0f / 1024.0f) + 1e-6f);
#pragma unroll
        for (int i = 0; i < 4; ++i) {
            const int col = i * 256 + lane * 4;
            const f32x4 gg = *(const f32x4*)(g + col);
            *(f32x4*)(xr + col) = v[i] * rstd * gg;
        }
    }
}

template <class Epi>
__device__ __forceinline__ void gemm_tile(char* smem, const bf16_t* __restrict__ A, int lda, const bf16_t* __restrict__ Bt, int ldb, int K, int row0, int col0, const Epi& epi) {
    const int tid = otid(), lane = tid & 63, wid = tid >> 6, wr = wid >> 1, wc = wid & 1, fr = lane & 15, fq = lane >> 4;
    f32x4 acc[4][4];
#pragma unroll
    for (int i = 0; i < 4; ++i)
#pragma unroll
        for (int j = 0; j < 4; ++j) acc[i][j] = (f32x4){0.f, 0.f, 0.f, 0.f};
    const int lrow = lane >> 3, lp = lane & 7;
    const int srow0 = wid * 32 + lrow;
    const bf16_t* gA = A + (size_t)(row0 + srow0) * lda;
    const bf16_t* gB = Bt + (size_t)(col0 + srow0) * ldb;
    int gc[4];
#pragma unroll
    for (int i = 0; i < 4; ++i) gc[i] = (lp ^ (((srow0 + 8 * i) >> 1) & 7)) * 8;
    LAS char* lbase = (LAS char*)smem + wid * 4096;
#define GEMM_STAGE(buf, kofs) do { _Pragma("unroll") for (int i = 0; i < 4; ++i) { \
        __builtin_amdgcn_global_load_lds((const unsigned*)(gA + (size_t)(8 * i) * lda + (kofs) + gc[i]), (LAS unsigned*)(lbase + (buf) * 32768 + i * 1024), 16, 0, 0); \
        __builtin_amdgcn_global_load_lds((const unsigned*)(gB + (size_t)(8 * i) * ldb + (kofs) + gc[i]), (LAS unsigned*)(lbase + (buf) * 32768 + 16384 + i * 1024), 16, 0, 0); } } while (0)
    GEMM_STAGE(0, 0);
    __syncthreads();
    const int nk = K >> 6;
    const int fsw = (fr >> 1) & 7;
    const int aoff = (wr * 64 + fr) * 128, boff = 16384 + (wc * 64 + fr) * 128;
#define GEMM_STEP(CB, NB_) do { \
        const char* cur = smem + (CB) * 32768; \
        bf16x8 af[2][4], bfr[2][4]; \
        _Pragma("unroll") for (int kk = 0; kk < 2; ++kk) { \
            const int csw = (((kk * 4 + fq) ^ fsw) << 4); \
            _Pragma("unroll") for (int i = 0; i < 4; ++i) { af[kk][i] = *(const bf16x8*)(cur + aoff + i * 2048 + csw); bfr[kk][i] = *(const bf16x8*)(cur + boff + i * 2048 + csw); } \
        } \
        __builtin_amdgcn_sched_barrier(0); \
        if (ks + 1 < nk) GEMM_STAGE(NB_, (ks + 1) * 64); \
        __builtin_amdgcn_sched_barrier(0); \
        _Pragma("unroll") for (int kk = 0; kk < 2; ++kk) \
            _Pragma("unroll") for (int mi = 0; mi < 4; ++mi) \
                _Pragma("unroll") for (int ni = 0; ni < 4; ++ni) acc[mi][ni] = __builtin_amdgcn_mfma_f32_16x16x32_bf16(bfr[kk][ni], af[kk][mi], acc[mi][ni], 0, 0, 0); \
        __builtin_amdgcn_sched_barrier(0); \
        __syncthreads(); \
        ++ks; } while (0)
#pragma unroll 1
    for (int ks = 0; ks < nk;) {
        GEMM_STEP(0, 1);
        GEMM_STEP(1, 0);
    }
#undef GEMM_STEP
#undef GEMM_STAGE
    epi(acc, row0 + wr * 64, col0 + wc * 64, fr, fq);
}

struct EpiProj {
    bf16_t* proj; float* rsq; float* rskv; char* smem;
    __device__ __forceinline__ void operator()(const f32x4 (&acc)[4][4], int rbase, int cbase, int fr, int fq) const {
        const bool isq = cbase >= O_CQ && cbase < O_CKV, iskv = cbase >= O_CKV && cbase < O_KR;
        const int row0 = rbase & ~127, col0 = cbase & ~127, wr = (rbase >> 6) & 1, wc = (cbase >> 6) & 1;
        const int tid = (wr * 2 + wc) * 64 + fq * 16 + fr;
#pragma unroll
        for (int mi = 0; mi < 4; ++mi) {
            const int tl = rbase + mi * 16 + fr; float ss = 0.f;
#pragma unroll
            for (int ni = 0; ni < 4; ++ni) {
                u32x2 w; w.x = pk_bf16(acc[mi][ni][0], acc[mi][ni][1]); w.y = pk_bf16(acc[mi][ni][2], acc[mi][ni][3]);
                *(u32x2*)(smem + (wr * 64 + mi * 16 + fr) * 272 + (wc * 64 + ni * 16 + fq * 4) * 2) = w;
                const float a = bf_lo(w.x), b = bf_hi(w.x), c = bf_lo(w.y), d = bf_hi(w.y);
                ss += a * a + b * b + c * c + d * d;
            }
            if (isq || iskv) {
                ss += __shfl_xor(ss, 16); ss += __shfl_xor(ss, 32);
                if (fq == 0) { if (isq) rsq[(size_t)tl * 8 + ((cbase - O_CQ) >> 6)] = ss; else rskv[(size_t)tl * 4 + ((cbase - O_CKV) >> 6)] = ss; }
            }
        }
        __syncthreads();
#pragma unroll
        for (int i = 0; i < 8; ++i) {
            const int q = tid + 256 * i, r = q >> 4, c = q & 15;
            *(u32x4*)(proj + (size_t)(row0 + r) * NP + col0 + c * 8) = *(const u32x4*)(smem + r * 272 + c * 16);
        }
        __syncthreads();
    }
};
struct EpiQ {
    bf16_t* Q; const float* rsq; const float* cs; const float* sn; int tgbase; char* smem;
    __device__ __forceinline__ void operator()(const f32x4 (&acc)[4][4], int rbase, int cbase, int fr, int fq) const {
        const int g0 = cbase >> 4;
        char* stg = smem + ((((rbase >> 6) & 1) * 2 + ((cbase >> 6) & 1)) * 9216);
#pragma unroll
        for (int mi = 0; mi < 4; ++mi) {
            const int tl = rbase + mi * 16 + fr;
            const f32x4 s0 = *(const f32x4*)(rsq + (size_t)tl * 8); const f32x2 s1 = *(const f32x2*)(rsq + (size_t)tl * 8 + 4);
            const float rs = rsqrtf((s0.x + s0.y + s0.z + s0.w + s1.x + s1.y) * (1.0f / 384.0f) + 1e-6f) * QSCALE;
            const f32x4 cc = *(const f32x4*)(cs + (size_t)(tgbase + tl) * 16 + fq * 4), sv = *(const f32x4*)(sn + (size_t)(tgbase + tl) * 16 + fq * 4);
            f32x4 v[4];
#pragma unroll
            for (int ni = 0; ni < 4; ++ni) v[ni] = acc[mi][ni] * rs;
#pragma unroll
            for (int ni = 0; ni < 4; ni += 2)
                if ((g0 + ni) % 6 == 4) { const f32x4 x1 = v[ni], x2 = v[ni + 1]; v[ni] = x1 * cc - x2 * sv; v[ni + 1] = x2 * cc + x1 * sv; }
#pragma unroll
            for (int ni = 0; ni < 4; ++ni) {
                u32x2 w; w.x = pk_bf16(v[ni][0], v[ni][1]); w.y = pk_bf16(v[ni][2], v[ni][3]);
                *(u32x2*)(stg + (mi * 16 + fr) * 144 + (ni * 16 + fq * 4) * 2) = w;
            }
        }
        {
            const int lane = fq * 16 + fr;
#pragma unroll
            for (int i = 0; i < 8; ++i) {
                const int q = lane + 64 * i, tk = q >> 3, c = q & 7;
                *(u32x4*)(Q + (size_t)(rbase + tk) * 768 + cbase + c * 8) = *(const u32x4*)(stg + tk * 144 + c * 16);
            }
        }
        __syncthreads();
    }
};
struct EpiKV {
    bf16_t* Kh; bf16_t* Vt; const float* rskv; char* smem;
    __device__ __forceinline__ void operator()(const f32x4 (&acc)[4][4], int rbase, int cbase, int fr, int fq) const {
        const int hh = cbase >> 7, part = (cbase >> 6) & 1, lane = fq * 16 + fr;
        char* stg = smem + ((((rbase >> 6) & 1) * 2 + part) * 9216);
#pragma unroll
        for (int mi = 0; mi < 4; ++mi) {
            const int tl = rbase + mi * 16 + fr;
            const f32x4 s0 = *(const f32x4*)(rskv + (size_t)tl * 4);
            const float rs = rsqrtf((s0.x + s0.y + s0.z + s0.w) * (1.0f / 256.0f) + 1e-6f);
#pragma unroll
            for (int ni = 0; ni < 4; ++ni) {
                const unsigned w0 = pk_bf16(acc[mi][ni][0] * rs, acc[mi][ni][1] * rs), w1 = pk_bf16(acc[mi][ni][2] * rs, acc[mi][ni][3] * rs);
                if (part == 0) { u32x2 w; w.x = w0; w.y = w1; *(u32x2*)(stg + (mi * 16 + fr) * 144 + (ni * 16 + fq * 4) * 2) = w; }
                else {
                    bf16_t* sp = (bf16_t*)(stg + (ni * 16 + fq * 4) * 144) + mi * 16 + fr;
                    sp[0] = (bf16_t)(w0 & 0xffffu); sp[72] = (bf16_t)(w0 >> 16); sp[144] = (bf16_t)(w1 & 0xffffu); sp[216] = (bf16_t)(w1 >> 16);
                }
            }
        }
        if (part == 0) {
#pragma unroll
            for (int i = 0; i < 8; ++i) {
                const int q = lane + 64 * i, tk = q >> 3, c = q & 7;
                *(u32x4*)(Kh + (size_t)(rbase + tk) * 768 + hh * 96 + c * 8) = *(const u32x4*)(stg + tk * 144 + c * 16);
            }
        } else {
            const int bl = rbase >> 12, s0 = rbase & 4095;
            bf16_t* vb = Vt + ((size_t)(bl * 8 + hh) * 64) * 4096 + s0;
#pragma unroll
            for (int i = 0; i < 8; ++i) {
                const int q = lane + 64 * i, dv = q >> 3, c = q & 7;
                *(u32x4*)(vb + (size_t)dv * 4096 + c * 8) = *(const u32x4*)(stg + dv * 144 + c * 16);
            }
        }
        __syncthreads();
    }
};
struct EpiOut {
    const float* xold; float* xnew; const float* modl; int tgbase; float fac;
    __device__ __forceinline__ void operator()(const f32x4 (&acc)[4][4], int rbase, int cbase, int fr, int fq) const {
#pragma unroll
        for (int mi = 0; mi < 4; ++mi) {
            const int tg = tgbase + rbase + mi * 16 + fr; const float* gp = modl + (size_t)(tg >> 12) * 3072 + 2048;
#pragma unroll
            for (int ni = 0; ni < 4; ++ni) {
                const int col = cbase + ni * 16 + fq * 4;
                const f32x4 xo = *(const f32x4*)(xold + (size_t)tg * 1024 + col), gt = *(const f32x4*)(gp + col);
                *(f32x4*)(xnew + (size_t)tg * 1024 + col) = xo + gt * acc[mi][ni] * fac;
            }
        }
    }
};

struct PrepArgs {
    const bf16_t* proj; const float* mu; const float* muv; const bf16_t* wdec; const bf16_t* wicl; const bf16_t* wvm;
    const float *w0, *a0, *v0, *k_k, *k_a; const float *cs, *sn;
    bf16_t *sr, *sk, *sv, *skk, *skka; bf16_t* se; bf16_t* vfirst; bf16_t* Kh; int layer; int tgbase;
};
__device__ __forceinline__ void lerp8(const bf16_t* cur, const bf16_t* prv, bool hp, const float* mu, float (&o)[8]) {
    const u32x4 c = *(const u32x4*)cur; u32x4 q = (u32x4){0u, 0u, 0u, 0u}; if (hp) q = *(const u32x4*)prv;
    const f32x4 m0 = *(const f32x4*)mu, m1 = *(const f32x4*)(mu + 4);
    const float cv[8] = {bf_lo(c.x), bf_hi(c.x), bf_lo(c.y), bf_hi(c.y), bf_lo(c.z), bf_hi(c.z), bf_lo(c.w), bf_hi(c.w)};
    const float pv[8] = {bf_lo(q.x), bf_hi(q.x), bf_lo(q.y), bf_hi(q.y), bf_lo(q.z), bf_hi(q.z), bf_lo(q.w), bf_hi(q.w)};
    const float mv[8] = {m0.x, m0.y, m0.z, m0.w, m1.x, m1.y, m1.z, m1.w};
#pragma unroll
    for (int j = 0; j < 8; ++j) o[j] = cv[j] + (pv[j] - cv[j]) * mv[j];
}
__device__ __forceinline__ f32x4 lerp4(const bf16_t* cur, const bf16_t* prv, bool hp, const float* mu) {
    const u32x2 c = *(const u32x2*)cur; u32x2 q = (u32x2){0u, 0u}; if (hp) q = *(const u32x2*)prv;
    const f32x4 m = *(const f32x4*)mu;
    const f32x4 cv = (f32x4){bf_lo(c.x), bf_hi(c.x), bf_lo(c.y), bf_hi(c.y)}, pv = (f32x4){bf_lo(q.x), bf_hi(q.x), bf_lo(q.y), bf_hi(q.y)};
    return cv + (pv - cv) * m;
}
__device__ __forceinline__ bf16x8 pack8(const float (&v)[8]) {
    u32x4 w; w.x = pk_bf16(v[0], v[1]); w.y = pk_bf16(v[2], v[3]); w.z = pk_bf16(v[4], v[5]); w.w = pk_bf16(v[6], v[7]);
    return __builtin_bit_cast(bf16x8, w);
}
__device__ __forceinline__ void store4(bf16_t* dst, const f32x4 v) { u32x2 w; w.x = pk_bf16(v.x, v.y); w.y = pk_bf16(v.z, v.w); *(u32x2*)dst = w; }

__device__ __forceinline__ void prep_tile(char* smem, const PrepArgs& a, int tile, int hg) {
    const int tid = otid(), lane = tid & 63, wid = tid >> 6, fr = lane & 15, fq = lane >> 4;
    const int tl = tile * 64 + wid * 16 + fr, tg = a.tgbase + tl;
    char* stg = smem + wid * 15872;
    const int tlw = tile * 64 + wid * 16;
    const bool hp = (tg & 4095) != 0;
    const bf16_t* pr = a.proj + (size_t)tl * NP; const bf16_t* pp = pr - NP;
    if (hg == 0) {
        const u32x2 u1 = *(const u32x2*)(pr + O_KR + fq * 4), u2 = *(const u32x2*)(pr + O_KR + 16 + fq * 4);
        const f32x4 x1 = (f32x4){bf_lo(u1.x), bf_hi(u1.x), bf_lo(u1.y), bf_hi(u1.y)}, x2 = (f32x4){bf_lo(u2.x), bf_hi(u2.x), bf_lo(u2.y), bf_hi(u2.y)};
        const f32x4 cc = *(const f32x4*)(a.cs + (size_t)tg * 16 + fq * 4), sv = *(const f32x4*)(a.sn + (size_t)tg * 16 + fq * 4);
        const f32x4 o1 = x1 * cc - x2 * sv, o2 = x2 * cc + x1 * sv;
        u32x2 w1, w2; w1.x = pk_bf16(o1.x, o1.y); w1.y = pk_bf16(o1.z, o1.w); w2.x = pk_bf16(o2.x, o2.y); w2.y = pk_bf16(o2.z, o2.w);
#pragma unroll
        for (int hh = 0; hh < 8; ++hh) { *(u32x2*)(a.Kh + (size_t)tl * 768 + hh * 96 + 64 + fq * 4) = w1; *(u32x2*)(a.Kh + (size_t)tl * 768 + hh * 96 + 80 + fq * 4) = w2; }
    }
    bf16x8 bw[2], ba[2], bv;
#pragma unroll
    for (int ks = 0; ks < 2; ++ks) {
        float t[8];
        lerp8(pr + 1536 + ks * 32 + fq * 8, pp + 1536 + ks * 32 + fq * 8, hp, a.mu + 1536 + ks * 32 + fq * 8, t);
#pragma unroll
        for (int j = 0; j < 8; ++j) t[j] = tanhf_(t[j]);
        bw[ks] = pack8(t);
        lerp8(pr + 1600 + ks * 32 + fq * 8, pp + 1600 + ks * 32 + fq * 8, hp, a.mu + 1600 + ks * 32 + fq * 8, t);
        ba[ks] = pack8(t);
    }
    const bool hasv = a.layer > 0;
    if (hasv) { float t[8]; lerp8(pr + INW + fq * 8, pp + INW + fq * 8, hp, a.muv + fq * 8, t); bv = pack8(t); }
    else bv = (bf16x8){0, 0, 0, 0, 0, 0, 0, 0};
#pragma unroll 1
    for (int hh = hg * 2; hh < hg * 2 + 2; ++hh) {
        float ss = 0.f;
#pragma unroll
        for (int nt = 0; nt < 4; ++nt) {
            const int ch = hh * 64 + nt * 16 + fq * 4;
            const f32x4 k4 = lerp4(pr + 512 + ch, pp + 512 + ch, hp, a.mu + 512 + ch);
            const f32x4 kr = k4 * *(const f32x4*)(a.k_k + ch);
            ss += kr.x * kr.x + kr.y * kr.y + kr.z * kr.z + kr.w * kr.w;
        }
        ss += __shfl_xor(ss, 16); ss += __shfl_xor(ss, 32);
        const float inv = 1.0f / fmaxf(sqrtf(ss), 1e-12f);
#pragma unroll
        for (int nt = 0; nt < 4; ++nt) {
            const int cb = hh * 64 + nt * 16, ch = cb + fq * 4;
            f32x4 accw = (f32x4){0.f, 0.f, 0.f, 0.f}, acca = accw, accv = accw;
#pragma unroll
            for (int ks = 0; ks < 2; ++ks) {
                const bf16x8 aw = *(const bf16x8*)(a.wdec + (size_t)(cb + fr) * 64 + ks * 32 + fq * 8);
                const bf16x8 ai = *(const bf16x8*)(a.wicl + (size_t)(cb + fr) * 64 + ks * 32 + fq * 8);
                accw = __builtin_amdgcn_mfma_f32_16x16x32_bf16(aw, bw[ks], accw, 0, 0, 0);
                acca = __builtin_amdgcn_mfma_f32_16x16x32_bf16(ai, ba[ks], acca, 0, 0, 0);
            }
            if (hasv) {
                const bf16x8 avm = *(const bf16x8*)(a.wvm + (size_t)(cb + fr) * 32 + fq * 8);
                accv = __builtin_amdgcn_mfma_f32_16x16x32_bf16(avm, bv, accv, 0, 0, 0);
            }
            const f32x4 r4 = lerp4(pr + ch, pp + ch, hp, a.mu + ch);
            const f32x4 k4 = lerp4(pr + 512 + ch, pp + 512 + ch, hp, a.mu + 512 + ch);
            f32x4 v4 = lerp4(pr + 1024 + ch, pp + 1024 + ch, hp, a.mu + 1024 + ch);
            const f32x4 w0v = *(const f32x4*)(a.w0 + ch), a0v = *(const f32x4*)(a.a0 + ch), kkv = *(const f32x4*)(a.k_k + ch), kav = *(const f32x4*)(a.k_a + ch);
            f32x4 dec, aa;
#pragma unroll
            for (int j = 0; j < 4; ++j) {
                dec[j] = 0.6065306597126334f * sigmoidf_(w0v[j] + accw[j]);
                aa[j] = sigmoidf_(a0v[j] + acca[j]);
            }
            if (hasv) {
                const f32x4 v0v = *(const f32x4*)(a.v0 + ch);
                const u32x2 uf = *(const u32x2*)(a.vfirst + (size_t)tg * 512 + ch);
                const f32x4 vf = (f32x4){bf_lo(uf.x), bf_hi(uf.x), bf_lo(uf.y), bf_hi(uf.y)};
#pragma unroll
                for (int j = 0; j < 4; ++j) v4[j] = v4[j] + (vf[j] - v4[j]) * sigmoidf_(v0v[j] + accv[j]);
            } else {
                store4(a.vfirst + (size_t)tg * 512 + ch, v4);
            }
            const f32x4 kk = k4 * kkv * inv;
            const f32x4 kp = k4 * ((aa - 1.0f) * kav + 1.0f);
            {
                const int so = fr * 144 + nt * 32 + fq * 8;
                store4((bf16_t*)(stg + so), r4); store4((bf16_t*)(stg + 2304 + so), kp); store4((bf16_t*)(stg + 4608 + so), v4);
                store4((bf16_t*)(stg + 6912 + so), kk); store4((bf16_t*)(stg + 9216 + so), kk * aa);
                store4((bf16_t*)(stg + 11520 + so), dec);
            }
        }
        {
#pragma unroll
            for (int i = 0; i < 2; ++i) {
                const int q = lane + 64 * i, tk = q >> 3, c = q & 7;
                const size_t go = (size_t)(tlw + tk) * 512 + hh * 64 + c * 8; const int lo = tk * 144 + c * 16;
                *(u32x4*)(a.sr + go) = *(const u32x4*)(stg + lo); *(u32x4*)(a.sk + go) = *(const u32x4*)(stg + 2304 + lo); *(u32x4*)(a.sv + go) = *(const u32x4*)(stg + 4608 + lo);
                *(u32x4*)(a.skk + go) = *(const u32x4*)(stg + 6912 + lo); *(u32x4*)(a.skka + go) = *(const u32x4*)(stg + 9216 + lo);
                *(u32x4*)(a.se + go) = *(const u32x4*)(stg + 11520 + lo);
            }
        }
    }
    __syncthreads();
}

struct ScanArgs { const bf16_t *sr, *sk, *sv, *skk, *skka; const float* sw; float* yraw; float* zbuf; float* sfin; };
__device__ __forceinline__ void cvt_store8(float* dst, const u32x4 u) {
    *(f32x4*)dst = (f32x4){bf_lo(u.x), bf_hi(u.x), bf_lo(u.y), bf_hi(u.y)};
    *(f32x4*)(dst + 4) = (f32x4){bf_lo(u.z), bf_hi(u.z), bf_lo(u.w), bf_hi(u.w)};
}
__device__ __forceinline__ void scan_tile(char* smem, const ScanArgs& a, int mode, int bl, int hh, int g) {
    const int tid = otid(), lane = tid & 63, wid = tid >> 6, rl = lane >> 4, c = lane & 15;
    float* L = (float*)smem;
    float* ybuf = L + 2 * 5376;
    const size_t tokbase = (size_t)bl * 4096 + (mode ? 2048 : 0);
    const int colh = hh * 64, i0 = g * 16;
    const bf16_t* src0 = (tid < 128) ? a.skk : a.skka;
    const bf16_t* src1 = (tid < 128) ? a.sk : a.sr;
    const int rem = tid & 127, tokA = rem >> 3, chA = rem & 7;
    const size_t gofsA = (size_t)tokA * 512 + colh + chA * 8;
    const int ldsA0 = (1 + (tid >> 7)) * 1024 + tokA * 64 + chA * 8, ldsA1 = (3 + (tid >> 7)) * 1024 + tokA * 64 + chA * 8;
    const size_t gofsW = (size_t)(tid >> 4) * 512 + colh + (tid & 15) * 4;
    const int ldsW = (tid >> 4) * 64 + (tid & 15) * 4;
    const size_t gofsV = (size_t)((tid & 31) >> 1) * 512 + colh + i0 + (tid & 1) * 8;
    const int ldsV = 5120 + ((tid & 31) >> 1) * 16 + (tid & 1) * 8;
    const bool ldv = tid < 32 && mode != 2;
    f32x2 S01 = (f32x2){0.f, 0.f}, S23 = (f32x2){0.f, 0.f};
    if (mode == 2) { const int d = (i0 + wid * 4 + rl) - c * 4; S01.x = d == 0 ? 1.f : 0.f; S01.y = d == 1 ? 1.f : 0.f; S23.x = d == 2 ? 1.f : 0.f; S23.y = d == 3 ? 1.f : 0.f; }
    u32x4 qa, qb, qv = (u32x4){0u, 0u, 0u, 0u}; f32x4 qw;
    {
        const size_t tb = tokbase * 512;
        qa = *(const u32x4*)(src0 + tb + gofsA); qb = *(const u32x4*)(src1 + tb + gofsA); qw = *(const f32x4*)(a.sw + tb + gofsW);
        if (ldv) qv = *(const u32x4*)(a.sv + tb + gofsV);
        cvt_store8(L + ldsA0, qa); cvt_store8(L + ldsA1, qb); *(f32x4*)(L + ldsW) = qw; if (tid < 32) { cvt_store8(L + ldsV, qv); if (mode == 2) cvt_store8(L + 5376 + ldsV, qv); }
    }
    __syncthreads();
    const int vofs = 5120 + wid * 4 + rl;
#pragma unroll 1
    for (int ch = 0; ch < 128; ++ch) {
        const float* cur = L + (ch & 1) * 5376;
        if (ch + 1 < 128) {
            const size_t tb = (tokbase + (size_t)(ch + 1) * 16) * 512;
            qa = *(const u32x4*)(src0 + tb + gofsA); qb = *(const u32x4*)(src1 + tb + gofsA); qw = *(const f32x4*)(a.sw + tb + gofsW);
            if (ldv) qv = *(const u32x4*)(a.sv + tb + gofsV);
        }
        float* yb = ybuf + (ch & 1) * 256;
        float ykeep = 0.f;
        f32x4 w4 = *(const f32x4*)(cur + c * 4), kk4 = *(const f32x4*)(cur + 1024 + c * 4), ka4 = *(const f32x4*)(cur + 2048 + c * 4);
        f32x4 k4 = *(const f32x4*)(cur + 3072 + c * 4), r4 = *(const f32x4*)(cur + 4096 + c * 4);
        float v = cur[vofs];
        float prevq = 0.f;
#pragma unroll
        for (int s = 0; s < 16; ++s) {
            f32x4 nw4 = w4, nkk4 = kk4, nka4 = ka4, nk4 = k4, nr4 = r4; float nv = v;
            if (s + 1 < 16) {
                nw4 = *(const f32x4*)(cur + (s + 1) * 64 + c * 4); nkk4 = *(const f32x4*)(cur + 1024 + (s + 1) * 64 + c * 4); nka4 = *(const f32x4*)(cur + 2048 + (s + 1) * 64 + c * 4);
                nk4 = *(const f32x4*)(cur + 3072 + (s + 1) * 64 + c * 4); nr4 = *(const f32x4*)(cur + 4096 + (s + 1) * 64 + c * 4);
                nv = cur[vofs + (s + 1) * 16];
            }
            const f32x2 pp = S01 * kk4.xy + S23 * kk4.zw;
            float sa = pp.x + pp.y;
            if (s > 0) { float yq = prevq; dpp_sum16x2(sa, yq); ykeep = (c == s - 1) ? yq : ykeep; }
            else sa = dpp_sum16(sa);
            const f32x2 sa2 = (f32x2){sa, sa}, v2 = (f32x2){v, v};
            S01 = S01 * w4.xy + (v2 * k4.xy - sa2 * ka4.xy);
            S23 = S23 * w4.zw + (v2 * k4.zw - sa2 * ka4.zw);
            const f32x2 qq = S01 * r4.xy + S23 * r4.zw;
            prevq = qq.x + qq.y;
            __builtin_amdgcn_sched_barrier(0);
            w4 = nw4; kk4 = nkk4; ka4 = nka4; k4 = nk4; r4 = nr4; v = nv;
        }
        { const float yq = dpp_sum16(prevq); ykeep = (c == 15) ? yq : ykeep; }
        yb[c * 16 + wid * 4 + rl] = ykeep;
        if (ch + 1 < 128) {
            float* nx = L + ((ch + 1) & 1) * 5376;
            cvt_store8(nx + ldsA0, qa); cvt_store8(nx + ldsA1, qb); *(f32x4*)(nx + ldsW) = qw; if (ldv) cvt_store8(nx + ldsV, qv);
        }
        __syncthreads();
        if (mode != 2) a.yraw[(tokbase + (size_t)ch * 16 + (tid >> 4)) * 512 + colh + i0 + (tid & 15)] = yb[tid];
        else a.zbuf[((size_t)bl * 2048 + (size_t)ch * 16 + (tid >> 4)) * 512 + colh + i0 + (tid & 15)] = yb[tid];
    }
    if (mode == 0) *(f32x4*)(a.sfin + ((size_t)((bl * 8 + hh) * 64 + i0 + wid * 4 + rl)) * 64 + c * 4) = (f32x4){S01.x, S01.y, S23.x, S23.y};
}

__device__ __forceinline__ void attn_tile(char* smem, const bf16_t* __restrict__ Qh, const bf16_t* __restrict__ Kh, const bf16_t* __restrict__ Vt,
                                          const bf16_t* __restrict__ proj, bf16_t* __restrict__ ycat, int bl, int hh, int qt) {
    const int tid = otid(), lane = tid & 63, wid = tid >> 6, fr = lane & 15, fq = lane >> 4;
    const int q0 = qt * 128, tok0 = bl * 4096, qw0 = q0 + wid * 32;
    bf16x8 qf[2][3];
#pragma unroll
    for (int qi = 0; qi < 2; ++qi)
#pragma unroll
        for (int ks = 0; ks < 3; ++ks) qf[qi][ks] = *(const bf16x8*)(Qh + (size_t)(tok0 + qw0 + qi * 16 + fr) * 768 + hh * 96 + ks * 32 + fq * 8);
    f32x4 o[4][2];
#pragma unroll
    for (int i = 0; i < 4; ++i) { o[i][0] = (f32x4){0.f, 0.f, 0.f, 0.f}; o[i][1] = o[i][0]; }
    float m[2] = {-1e30f, -1e30f}, lsum[2] = {0.f, 0.f};
    const int nkv = 2 * (qt + 1);
    const bf16_t* Kb = Kh + (size_t)tok0 * 768 + hh * 96;
    const bf16_t* Vb = Vt + ((size_t)((bl * 8 + hh) * 64)) * 4096;
    int gK[3], lK[3];
#pragma unroll
    for (int i = 0; i < 3; ++i) { const int cid = tid + 256 * i, key = cid / 12, cc = cid - key * 12; gK[i] = key * 768 + cc * 8; lK[i] = key * 224 + cc * 16; }
    int gV[2], lV[2];
#pragma unroll
    for (int i = 0; i < 2; ++i) { const int cid = tid + 256 * i, dv = cid >> 3, cc = cid & 7; gV[i] = dv * 4096 + cc * 8; lV[i] = 14336 + dv * 144 + cc * 16; }
    u32x4 rkA[3], rvA[2], rkB[3], rvB[2];
#define ATT_LOAD(RK, RV, T) do { _Pragma("unroll") for (int i = 0; i < 3; ++i) RK[i] = *(const u32x4*)(Kb + (size_t)((T) * 64) * 768 + gK[i]); \
                                 _Pragma("unroll") for (int i = 0; i < 2; ++i) RV[i] = *(const u32x4*)(Vb + (T) * 64 + gV[i]); } while (0)
#define ATT_WRITE(RK, RV, BUF) do { _Pragma("unroll") for (int i = 0; i < 3; ++i) *(u32x4*)(smem + (BUF) * 23552 + lK[i]) = RK[i]; \
                                    _Pragma("unroll") for (int i = 0; i < 2; ++i) *(u32x4*)(smem + (BUF) * 23552 + lV[i]) = RV[i]; } while (0)
    ATT_LOAD(rkA, rvA, 0);
    ATT_WRITE(rkA, rvA, 0);
    ATT_LOAD(rkA, rvA, 1);
    __syncthreads();
    auto compute = [&](const int j, const char* cur) {
        const int kv0 = j * 64;
        if (kv0 <= qw0 + 31) {
            f32x4 s[4][2];
            {
                bf16x8 kf[4][3];
#pragma unroll
                for (int kt = 0; kt < 4; ++kt)
#pragma unroll
                    for (int ks = 0; ks < 3; ++ks) kf[kt][ks] = *(const bf16x8*)(cur + (kt * 16 + fr) * 224 + (ks * 4 + fq) * 16);
                __builtin_amdgcn_sched_barrier(0);
#pragma unroll
                for (int kt = 0; kt < 4; ++kt)
#pragma unroll
                    for (int qi = 0; qi < 2; ++qi) {
                        f32x4 acc = (f32x4){0.f, 0.f, 0.f, 0.f};
#pragma unroll
                        for (int ks = 0; ks < 3; ++ks) acc = __builtin_amdgcn_mfma_f32_16x16x32_bf16(kf[kt][ks], qf[qi][ks], acc, 0, 0, 0);
                        s[kt][qi] = acc;
                    }
                __builtin_amdgcn_sched_barrier(0);
            }
            bf16x8 vfr[4][2];
#pragma unroll
            for (int dvt = 0; dvt < 4; ++dvt)
#pragma unroll
                for (int kb = 0; kb < 2; ++kb) {
                    const char* vp = cur + 14336 + (dvt * 16 + fr) * 144 + kb * 64 + fq * 8;
                    const u32x2 lo = *(const u32x2*)vp, hi = *(const u32x2*)(vp + 32);
                    vfr[dvt][kb] = __builtin_bit_cast(bf16x8, ((u32x4){lo.x, lo.y, hi.x, hi.y}));
                }
            __builtin_amdgcn_sched_barrier(0);
            if (kv0 + 63 > qw0) {
#pragma unroll
                for (int kt = 0; kt < 4; ++kt)
#pragma unroll
                    for (int qi = 0; qi < 2; ++qi)
#pragma unroll
                        for (int jj = 0; jj < 4; ++jj) { const int kpos = kv0 + kt * 16 + fq * 4 + jj, qpos = qw0 + qi * 16 + fr; if (kpos > qpos) s[kt][qi][jj] = -1e30f; }
            }
#pragma unroll
            for (int qi = 0; qi < 2; ++qi) {
                float mx = -1e30f;
#pragma unroll
                for (int kt = 0; kt < 4; ++kt) mx = fmaxf(mx, fmaxf(fmaxf(s[kt][qi][0], s[kt][qi][1]), fmaxf(s[kt][qi][2], s[kt][qi][3])));
                mx = fmaxf(mx, __shfl_xor(mx, 16)); mx = fmaxf(mx, __shfl_xor(mx, 32));
                const float mnew = fmaxf(m[qi], mx), alpha = __builtin_amdgcn_exp2f(m[qi] - mnew);
                m[qi] = mnew;
                float rs = 0.f;
#pragma unroll
                for (int kt = 0; kt < 4; ++kt)
#pragma unroll
                    for (int jj = 0; jj < 4; ++jj) { const float pexp = __builtin_amdgcn_exp2f(s[kt][qi][jj] - mnew); s[kt][qi][jj] = pexp; rs += pexp; }
                lsum[qi] = lsum[qi] * alpha + rs;
#pragma unroll
                for (int dvt = 0; dvt < 4; ++dvt) o[dvt][qi] = o[dvt][qi] * alpha;
            }
            bf16x8 pf[2][2];
#pragma unroll
            for (int kb = 0; kb < 2; ++kb)
#pragma unroll
                for (int qi = 0; qi < 2; ++qi) {
                    u32x4 t;
                    t.x = pk_bf16(s[2 * kb][qi][0], s[2 * kb][qi][1]); t.y = pk_bf16(s[2 * kb][qi][2], s[2 * kb][qi][3]);
                    t.z = pk_bf16(s[2 * kb + 1][qi][0], s[2 * kb + 1][qi][1]); t.w = pk_bf16(s[2 * kb + 1][qi][2], s[2 * kb + 1][qi][3]);
                    pf[kb][qi] = __builtin_bit_cast(bf16x8, t);
                }
            __builtin_amdgcn_sched_barrier(0);
#pragma unroll
            for (int dvt = 0; dvt < 4; ++dvt)
#pragma unroll
                for (int kb = 0; kb < 2; ++kb)
#pragma unroll
                    for (int qi = 0; qi < 2; ++qi) o[dvt][qi] = __builtin_amdgcn_mfma_f32_16x16x32_bf16(vfr[dvt][kb], pf[kb][qi], o[dvt][qi], 0, 0, 0);
        }
    };
#pragma unroll 1
    for (int j = 0; j < nkv; j += 2) {
        if (j + 2 < nkv) ATT_LOAD(rkB, rvB, j + 2);
        compute(j, smem);
        ATT_WRITE(rkA, rvA, 1);
        __syncthreads();
        if (j + 3 < nkv) ATT_LOAD(rkA, rvA, j + 3);
        compute(j + 1, smem + 23552);
        if (j + 2 < nkv) ATT_WRITE(rkB, rvB, 0);
        __syncthreads();
    }
#undef ATT_LOAD
#undef ATT_WRITE
#pragma unroll
    for (int qi = 0; qi < 2; ++qi) {
        float lt = lsum[qi]; lt += __shfl_xor(lt, 16); lt += __shfl_xor(lt, 32);
        const float inv = 1.0f / lt;
        const int tl = tok0 + qw0 + qi * 16 + fr;
#pragma unroll
        for (int dvt = 0; dvt < 4; ++dvt) {
            const int dv = dvt * 16 + fq * 4;
            const u32x2 gu = *(const u32x2*)(proj + (size_t)tl * NP + O_GM + hh * 64 + dv);
            const f32x4 gg = (f32x4){bf_lo(gu.x), bf_hi(gu.x), bf_lo(gu.y), bf_hi(gu.y)};
            f32x4 r;
#pragma unroll
            for (int jj = 0; jj < 4; ++jj) r[jj] = o[dvt][qi][jj] * inv * siluf_(gg[jj]);
            store4(ycat + (size_t)tl * 1024 + 512 + hh * 64 + dv, r);
        }
    }
}

struct FinArgs { const float* yraw; const bf16_t *sr, *sk, *sv; const bf16_t* proj; const float *lnw, *lnb, *rk; bf16_t* ycat; const float* zbuf; const float* sfin; };
__device__ void rwkv_finalize(const FinArgs& a) {
    const int tid_ = otid(); const int lane = tid_ & 63, gw = blockIdx.x * 4 + (tid_ >> 6), nw = gridDim.x * 4;
    for (int u = gw; u < TH * 2; u += nw) {
        const int tl = u >> 1, ch = ((u & 1) * 4 + (lane >> 4)) * 64 + (lane & 15) * 4;
        f32x4 y = *(const f32x4*)(a.yraw + (size_t)tl * 512 + ch);
        const float mean = dpp_sum16(y.x + y.y + y.z + y.w) * (1.0f / 64.0f);
        const f32x4 d = y - mean;
        const float var = dpp_sum16(d.x * d.x + d.y * d.y + d.z * d.z + d.w * d.w) * (1.0f / 64.0f);
        const float rstd = rsqrtf(var + 64e-5f);
        const u32x2 ur = *(const u32x2*)(a.sr + (size_t)tl * 512 + ch), uk = *(const u32x2*)(a.sk + (size_t)tl * 512 + ch), uv = *(const u32x2*)(a.sv + (size_t)tl * 512 + ch);
        const f32x4 r4 = (f32x4){bf_lo(ur.x), bf_hi(ur.x), bf_lo(ur.y), bf_hi(ur.y)}, k4 = (f32x4){bf_lo(uk.x), bf_hi(uk.x), bf_lo(uk.y), bf_hi(uk.y)};
        const f32x4 v4 = (f32x4){bf_lo(uv.x), bf_hi(uv.x), bf_lo(uv.y), bf_hi(uv.y)};
        const f32x4 rkv = *(const f32x4*)(a.rk + ch), lw = *(const f32x4*)(a.lnw + ch), lb = *(const f32x4*)(a.lnb + ch);
        const f32x4 t = r4 * k4 * rkv;
        const float bon = dpp_sum16(t.x + t.y + t.z + t.w);
        const u32x2 gu = *(const u32x2*)(a.proj + (size_t)tl * NP + O_GR + ch);
        const f32x4 gg = (f32x4){bf_lo(gu.x), bf_hi(gu.x), bf_lo(gu.y), bf_hi(gu.y)};
        f32x4 o = d * rstd * lw + lb + v4 * bon;
#pragma unroll
        for (int j = 0; j < 4; ++j) o[j] *= siluf_(gg[j]);
        store4(a.ycat + (size_t)tl * 1024 + ch, o);
    }
}


struct CopArgs { const bf16_t *sr, *sk, *sv, *skk, *skka; const bf16_t* se; char* cops; };
__device__ __forceinline__ float mm16(const float* A, float sa, float ia, const float* B, float sb, float ib, int t, int j) {
    float acc = 0.f;
#pragma unroll
    for (int i = 0; i < 16; ++i) { const float av = sa * A[t * 17 + i] + (i == t ? ia : 0.f); const float bv = sb * B[i * 17 + j] + (i == j ? ib : 0.f); acc += av * bv; }
    return acc;
}
__device__ __forceinline__ float mm16p(const float* A, const float* B, int t, int j) {
    float acc = 0.f;
#pragma unroll
    for (int q = 0; q < 4; ++q) {
        const f32x4 a4 = *(const f32x4*)(A + t * 20 + q * 4);
        acc += a4.x * B[(q * 4 + 0) * 20 + j] + a4.y * B[(q * 4 + 1) * 20 + j] + a4.z * B[(q * 4 + 2) * 20 + j] + a4.w * B[(q * 4 + 3) * 20 + j];
    }
    return acc;
}
__device__ __forceinline__ f32x4 unpk4(const u32x2 u) { return (f32x4){bf_lo(u.x), bf_hi(u.x), bf_lo(u.y), bf_hi(u.y)}; }
__device__ __forceinline__ bf16_t bf1(float x) { return (bf16_t)(pk_bf16(x, 0.f) & 0xffffu); }
struct CopIn { u32x2 ue, ukk, uka, uk, ur, uv; };
__device__ __forceinline__ void cop_in_load(CopIn& r, const CopArgs& a, int unit, int t, int cq) {
    const int c = unit & 255, bh = unit >> 8;
    const size_t gofs = ((size_t)(bh >> 3) * 4096 + c * 16 + t) * 512 + (bh & 7) * 64 + cq * 4;
    r.ue = *(const u32x2*)(a.se + gofs);
    r.ukk = *(const u32x2*)(a.skk + gofs); r.uka = *(const u32x2*)(a.skka + gofs); r.uk = *(const u32x2*)(a.sk + gofs); r.ur = *(const u32x2*)(a.sr + gofs); r.uv = *(const u32x2*)(a.sv + gofs);
}
__device__ void cop_phase(char* smem, const CopArgs& a) {
    const int tid = otid(), t = tid >> 4, cq = tid & 15, j = cq;
    float* F = (float*)smem;
    float* Wc = F; float* KAP = F + 1088; float* RT = F + 2176; float* KT = F + 3264; float* BT = F + 4352;
    float* SM = F + 5440;
    bf16_t* STG = (bf16_t*)(F + 5440 + 15 * 320);
#define SMAT(i) (SM + (i) * 320)
    int unit = blockIdx.x;
    if (unit >= 8192) return;
    CopIn cur, nxt;
    cop_in_load(cur, a, unit, t, cq);
    nxt = cur;
#pragma unroll 1
    for (; unit < 8192; unit += gridDim.x) {
        if (unit + (int)gridDim.x < 8192) cop_in_load(nxt, a, unit + gridDim.x, t, cq);
        __syncthreads();
        *(f32x4*)(Wc + t * 68 + cq * 4) = unpk4(cur.ue);
        __syncthreads();
        if (tid < 64) {
            float x[16];
#pragma unroll
            for (int i = 0; i < 16; ++i) x[i] = Wc[i * 68 + tid];
#pragma unroll
            for (int i = 1; i < 16; ++i) x[i] += x[i - 1];
#pragma unroll
            for (int i = 0; i < 16; ++i) Wc[i * 68 + tid] = x[i];
        }
        __syncthreads();
        const f32x4 ct = *(const f32x4*)(Wc + t * 68 + cq * 4), cC = *(const f32x4*)(Wc + 15 * 68 + cq * 4);
        f32x4 cp = (f32x4){0.f, 0.f, 0.f, 0.f}; if (t > 0) cp = *(const f32x4*)(Wc + (t - 1) * 68 + cq * 4);
        const f32x4 Wt = (f32x4){__expf(-ct.x), __expf(-ct.y), __expf(-ct.z), __expf(-ct.w)}, Wp = (f32x4){__expf(-cp.x), __expf(-cp.y), __expf(-cp.z), __expf(-cp.w)};
        const f32x4 WC = (f32x4){__expf(-cC.x), __expf(-cC.y), __expf(-cC.z), __expf(-cC.w)};
        {
            const f32x4 rW = (f32x4){__expf(ct.x), __expf(ct.y), __expf(ct.z), __expf(ct.w)};
            *(f32x4*)(KAP + t * 68 + cq * 4) = unpk4(cur.ukk) * Wp;
            *(f32x4*)(RT + t * 68 + cq * 4) = unpk4(cur.ur) * Wt;
            *(f32x4*)(KT + t * 68 + cq * 4) = unpk4(cur.uk) * rW;
            *(f32x4*)(BT + t * 68 + cq * 4) = unpk4(cur.uka) * rW;
        }
        __syncthreads();
        {
            const int wv = tid >> 6, ln = tid & 63, gfr = ln & 15, gfq = ln >> 4;
            const float* X = (wv < 2 ? KAP : RT) + gfr * 68 + gfq * 16;
            const float* Y = ((wv & 1) ? BT : KT) + gfr * 68 + gfq * 16;
            f32x4 acc = (f32x4){0.f, 0.f, 0.f, 0.f};
#pragma unroll
            for (int q = 0; q < 4; ++q) {
                const f32x4 xa = *(const f32x4*)(X + q * 4), ya = *(const f32x4*)(Y + q * 4);
                acc = __builtin_amdgcn_mfma_f32_16x16x4f32(xa.x, ya.x, acc, 0, 0, 0);
                acc = __builtin_amdgcn_mfma_f32_16x16x4f32(xa.y, ya.y, acc, 0, 0, 0);
                acc = __builtin_amdgcn_mfma_f32_16x16x4f32(xa.z, ya.z, acc, 0, 0, 0);
                acc = __builtin_amdgcn_mfma_f32_16x16x4f32(xa.w, ya.w, acc, 0, 0, 0);
            }
#pragma unroll
            for (int jj = 0; jj < 4; ++jj) {
                const int tt = gfq * 4 + jj, jc = gfr;
                const float v = (wv < 2 ? jc < tt : jc <= tt) ? acc[jj] : 0.f;
                SMAT(wv)[tt * 20 + jc] = v;
                if (wv == 1) SMAT(12)[tt * 20 + jc] = (tt == jc ? 1.f : 0.f) - v;
            }
        }
        __syncthreads();
        const float idv = t == j ? 1.f : 0.f;
        { const float v = mm16p(SMAT(1), SMAT(1), t, j); SMAT(4)[t * 20 + j] = v; SMAT(13)[t * 20 + j] = v + idv; } __syncthreads();
        { const float v = mm16p(SMAT(4), SMAT(4), t, j); SMAT(5)[t * 20 + j] = v; SMAT(14)[t * 20 + j] = v + idv;
          SMAT(7)[t * 20 + j] = mm16p(SMAT(12), SMAT(13), t, j); } __syncthreads();
        SMAT(6)[t * 20 + j] = mm16p(SMAT(5), SMAT(5), t, j) + idv;
        SMAT(8)[t * 20 + j] = mm16p(SMAT(7), SMAT(14), t, j); __syncthreads();
        SMAT(9)[t * 20 + j] = mm16p(SMAT(8), SMAT(6), t, j); __syncthreads();
        SMAT(10)[t * 20 + j] = mm16p(SMAT(9), SMAT(0), t, j);
        SMAT(11)[t * 20 + j] = mm16p(SMAT(3), SMAT(9), t, j); __syncthreads();
        char* U = a.cops + (size_t)unit * COP_STRIDE;
        ((bf16_t*)(U + 4096))[t * 16 + j] = bf1(SMAT(2)[t * 20 + j] - mm16p(SMAT(11), SMAT(0), t, j));
        f32x4 q3 = (f32x4){0.f, 0.f, 0.f, 0.f}, q1 = *(const f32x4*)(RT + t * 68 + cq * 4), kh = *(const f32x4*)(KT + t * 68 + cq * 4);
#pragma unroll 4
        for (int i = 0; i < 16; ++i) {
            const f32x4 kap = *(const f32x4*)(KAP + i * 68 + cq * 4), bt = *(const f32x4*)(BT + i * 68 + cq * 4);
            q3 += kap * SMAT(9)[t * 20 + i]; q1 -= kap * SMAT(11)[t * 20 + i]; kh -= bt * SMAT(10)[i * 20 + t];
        }
        kh = kh * WC;
        const f32x4 bhv = *(const f32x4*)(BT + t * 68 + cq * 4) * WC;
        const int p0 = 32 * (cq >> 3) + 8 * (cq & 3) + 4 * ((cq >> 2) & 1);
        store4((bf16_t*)U + t * 64 + p0, q3);
        store4((bf16_t*)U + (16 + t) * 64 + p0, q1);
        const int so = (t >> 2) * 8 + (t & 3);
#pragma unroll
        for (int jj = 0; jj < 4; ++jj) { STG[(cq * 4 + jj) * 32 + so] = bf1(bhv[jj]); STG[(cq * 4 + jj) * 32 + so + 4] = bf1(kh[jj]); }
        STG[2048 + (cq * 4 + 0) * 16 + t] = (bf16_t)(cur.uv.x & 0xffffu); STG[2048 + (cq * 4 + 1) * 16 + t] = (bf16_t)(cur.uv.x >> 16);
        STG[2048 + (cq * 4 + 2) * 16 + t] = (bf16_t)(cur.uv.y & 0xffffu); STG[2048 + (cq * 4 + 3) * 16 + t] = (bf16_t)(cur.uv.y >> 16);
        if (tid < 64) ((float*)(U + 10752))[tid] = __expf(-Wc[15 * 68 + tid]);
        __syncthreads();
        *(u32x4*)(U + 4608 + tid * 16) = *(const u32x4*)((const char*)STG + tid * 16);
        if (tid < 128) *(u32x4*)(U + 8704 + tid * 16) = *(const u32x4*)((const char*)STG + 4096 + tid * 16);
        cur = nxt;
    }
#undef SMAT
}

__device__ __forceinline__ int cop_lds_of(int q) {
    if (q < 256) { const int row = q >> 3, pos = q & 7; return row * 128 + ((pos ^ ((row >> 1) & 7)) << 4); }
    if (q < 288) return q * 16;
    if (q < 544) { const int q2 = q - 288; return 4608 + (q2 & 3) * 1024 + (q2 >> 2) * 16; }
    return q * 16;
}
struct CopOps { u32x4 qc[2][2]; u32x2 q2; u32x4 bk[4]; u32x2 vt; f32x4 wc[4]; };
__device__ void chunk_scan(char* smem, const char* cops, float* yraw, int bl, int hh) {
    const int tid = otid(), lane = tid & 63, w = tid >> 6, fr = lane & 15, fq = lane >> 4;
    f32x4 st[4];
#pragma unroll
    for (int kt = 0; kt < 4; ++kt) st[kt] = (f32x4){0.f, 0.f, 0.f, 0.f};
    const char* U = cops + (size_t)((bl * 8 + hh) * 256) * COP_STRIDE + tid * 16;
    float* yp = yraw + ((size_t)bl * 4096 + fq * 4) * 512 + hh * 64 + w * 16 + fr;
    const int l0 = cop_lds_of(tid), l1 = cop_lds_of(tid + 256), l2 = cop_lds_of(tid < 176 ? tid + 512 : 0);
    const bool has2 = tid < 176;
    const int qo0 = fr * 128 + (((0 * 4 + fq) ^ ((fr >> 1) & 7)) << 4), qo1 = fr * 128 + (((1 * 4 + fq) ^ ((fr >> 1) & 7)) << 4);
    const int q2o = 4096 + fr * 32 + fq * 8, bko = 4608 + fq * 1024 + fr * 16, vto = 8704 + (w * 16 + fr) * 32 + fq * 8, wco = 10752 + fq * 16;
    u32x4 sA[3], sB[3], sC[3], sD[3];
    __builtin_amdgcn_s_setprio(3);
#define CS_LOAD(S, C) do { const char* g_ = U + (size_t)(C) * COP_STRIDE; S[0] = *(const u32x4*)g_; S[1] = *(const u32x4*)(g_ + 4096); if (has2) S[2] = *(const u32x4*)(g_ + 8192); } while (0)
#define CS_WRITE(S, SLOT) do { char* d_ = smem + (SLOT) * 11008; *(u32x4*)(d_ + l0) = S[0]; *(u32x4*)(d_ + l1) = S[1]; if (has2) *(u32x4*)(d_ + l2) = S[2]; } while (0)
    sA[2] = (u32x4){0u, 0u, 0u, 0u}; sB[2] = sA[2]; sC[2] = sA[2]; sD[2] = sA[2];
    CS_LOAD(sA, 0); CS_LOAD(sB, 1); CS_LOAD(sC, 2); CS_LOAD(sD, 3);
    CopOps R0, R1;
    auto ldsload = [&](CopOps& r, const char* L) {
        r.qc[0][0] = *(const u32x4*)(L + qo0); r.qc[0][1] = *(const u32x4*)(L + qo1); r.qc[1][0] = *(const u32x4*)(L + 2048 + qo0); r.qc[1][1] = *(const u32x4*)(L + 2048 + qo1);
        r.q2 = *(const u32x2*)(L + q2o); r.vt = *(const u32x2*)(L + vto);
#pragma unroll
        for (int kt = 0; kt < 4; ++kt) { r.bk[kt] = *(const u32x4*)(L + bko + kt * 256); r.wc[kt] = *(const f32x4*)(L + wco + kt * 64); }
    };
    auto compute = [&](const int c, const CopOps& r) {
        const u32x4 (&qc)[2][2] = r.qc; const u32x4 (&bk)[4] = r.bk; const f32x4 (&wc)[4] = r.wc; const u32x2 q2 = r.q2, vt = r.vt;
        u32x4 hi[2], lo[2];
#pragma unroll
        for (int s = 0; s < 2; ++s) {
            const f32x4 a0 = st[2 * s], a1 = st[2 * s + 1];
            hi[s].x = pk_bf16(a0.x, a0.y); hi[s].y = pk_bf16(a0.z, a0.w); hi[s].z = pk_bf16(a1.x, a1.y); hi[s].w = pk_bf16(a1.z, a1.w);
            lo[s].x = pk_bf16(a0.x - bf_lo(hi[s].x), a0.y - bf_hi(hi[s].x)); lo[s].y = pk_bf16(a0.z - bf_lo(hi[s].y), a0.w - bf_hi(hi[s].y));
            lo[s].z = pk_bf16(a1.x - bf_lo(hi[s].z), a1.y - bf_hi(hi[s].z)); lo[s].w = pk_bf16(a1.z - bf_lo(hi[s].w), a1.w - bf_hi(hi[s].w));
        }
        f32x4 p1 = (f32x4){0.f, 0.f, 0.f, 0.f}, p2 = p1;
#pragma unroll
        for (int s = 0; s < 2; ++s) {
            p1 = __builtin_amdgcn_mfma_f32_16x16x32_bf16(__builtin_bit_cast(bf16x8, qc[0][s]), __builtin_bit_cast(bf16x8, hi[s]), p1, 0, 0, 0);
            p2 = __builtin_amdgcn_mfma_f32_16x16x32_bf16(__builtin_bit_cast(bf16x8, qc[1][s]), __builtin_bit_cast(bf16x8, hi[s]), p2, 0, 0, 0);
            p1 = __builtin_amdgcn_mfma_f32_16x16x32_bf16(__builtin_bit_cast(bf16x8, qc[0][s]), __builtin_bit_cast(bf16x8, lo[s]), p1, 0, 0, 0);
            p2 = __builtin_amdgcn_mfma_f32_16x16x32_bf16(__builtin_bit_cast(bf16x8, qc[1][s]), __builtin_bit_cast(bf16x8, lo[s]), p2, 0, 0, 0);
        }
        p2 = __builtin_amdgcn_mfma_f32_16x16x32_bf16(__builtin_bit_cast(bf16x8, ((u32x4){q2.x, q2.y, 0u, 0u})), __builtin_bit_cast(bf16x8, ((u32x4){vt.x, vt.y, 0u, 0u})), p2, 0, 0, 0);
#pragma unroll
        for (int j = 0; j < 4; ++j) yp[(size_t)(c * 16 + j) * 512] = p2[j];
        u32x4 xh, xl;
        xh.x = pk_bf16(-p1.x, -p1.y); xh.y = pk_bf16(-p1.z, -p1.w); xh.z = vt.x; xh.w = vt.y;
        xl.x = pk_bf16(-p1.x - bf_lo(xh.x), -p1.y - bf_hi(xh.x)); xl.y = pk_bf16(-p1.z - bf_lo(xh.y), -p1.w - bf_hi(xh.y)); xl.z = 0u; xl.w = 0u;
#pragma unroll
        for (int kt = 0; kt < 4; ++kt) {
            f32x4 acc = st[kt] * wc[kt];
            acc = __builtin_amdgcn_mfma_f32_16x16x32_bf16(__builtin_bit_cast(bf16x8, bk[kt]), __builtin_bit_cast(bf16x8, xh), acc, 0, 0, 0);
            acc = __builtin_amdgcn_mfma_f32_16x16x32_bf16(__builtin_bit_cast(bf16x8, bk[kt]), __builtin_bit_cast(bf16x8, xl), acc, 0, 0, 0);
            st[kt] = acc;
        }
    };
    CS_WRITE(sA, 0); CS_LOAD(sA, 4);
    __syncthreads();
    ldsload(R0, smem);
#define CS_STEP(S, C, RC, RN) do { if ((C) + 1 < 256) CS_WRITE(S, ((C) + 1) & 1); if ((C) + 5 < 256) CS_LOAD(S, (C) + 5); __syncthreads(); \
        if ((C) + 1 < 256) ldsload(RN, smem + (((C) + 1) & 1) * 11008); compute((C), RC); } while (0)
#pragma unroll 1
    for (int c = 0; c < 256; c += 4) { CS_STEP(sB, c, R0, R1); CS_STEP(sC, c + 1, R1, R0); CS_STEP(sD, c + 2, R0, R1); CS_STEP(sA, c + 3, R1, R0); }
#undef CS_STEP
#undef CS_LOAD
#undef CS_WRITE
    __builtin_amdgcn_s_setprio(0);
    __syncthreads();
}

__global__ void __launch_bounds__(256, 2) fwd_megakernel(Params p) {
    __shared__ __attribute__((aligned(16))) char smem[65536 + 64];
    cg::grid_group grid = cg::this_grid();
    if (threadIdx.x == 0) { ((volatile LAS unsigned*)(smem + 65536))[0] = 0u; ((volatile LAS unsigned*)(smem + 65536))[1] = 0u; }
    __syncthreads();
    const XcdBarrier xb = xcd_barrier_post((unsigned*)(p.ws + OFF_BAR), (volatile LAS unsigned*)(smem + 65536));
    const unsigned cu_key = (xb.x & 7u) * 256u + ((unsigned)__builtin_amdgcn_s_getreg((7 << 11) | (8 << 6) | 4) & 0xffu);
    if (threadIdx.x == 0) (void)xb_add((unsigned*)(p.ws + OFF_CUCNT) + cu_key, 1u);
    char* ws = p.ws;
    float* mod = (float*)(ws + OFF_MOD);
    const float* cs = (const float*)(ws + OFF_COS); const float* sn = (const float*)(ws + OFF_SIN);
    bf16_t* hbuf = (bf16_t*)(ws + OFF_H);
    bf16_t* proj = (bf16_t*)(ws + OFF_PROJ);
    bf16_t *sr = (bf16_t*)(ws + OFF_SR), *sk = (bf16_t*)(ws + OFF_SK), *sv = (bf16_t*)(ws + OFF_SV), *skk = (bf16_t*)(ws + OFF_SKK), *skka = (bf16_t*)(ws + OFF_SKKA);
    bf16_t* se = (bf16_t*)(ws + OFF_SW);
    float *rsq = (float*)(ws + OFF_RSQ), *rskv = (float*)(ws + OFF_RSKV);
    bf16_t *Qh = (bf16_t*)(ws + OFF_Q), *Kh = (bf16_t*)(ws + OFF_K), *Vt = (bf16_t*)(ws + OFF_VT);
    float* yraw = (float*)(ws + OFF_YRAW);
    bf16_t* ycat = (bf16_t*)(ws + OFF_YCAT);
    bf16_t* vfirst = (bf16_t*)(ws + OFF_VFIRST);
    int* ctrl = (int*)(ws + OFF_CTRL);
    volatile int* s_item = (volatile int*)(smem + 65536 + 16);

    for (int rep = 0; rep < REP_P0; ++rep) prologue(smem, p);
    grid.sync();
    bool scan_role;
    {
        const unsigned k2 = (cu_key & ~255u) + threadIdx.x;
        const int lidx = __syncthreads_count(k2 < cu_key && xb_ld((unsigned*)(p.ws + OFF_CUCNT) + k2) > 0u);
        scan_role = lidx < 24;
    }

    norm_phase(p.x, p.norm_g, mod, hbuf, 0);
    GSYNC();
#pragma unroll 1
    for (int l = 0; l < NL; ++l) {
        const float* modl = mod + (size_t)l * 8 * 3072;
#pragma unroll 1
        for (int half = 0; half < 2; ++half) {
            const int tgbase = half * TH;
            {
                EpiProj e{proj, rsq, rskv, smem};
                const bf16_t* A = hbuf; const bf16_t* Bt = (const bf16_t*)(ws + OFF_WIN) + (size_t)l * NP * 1024;
                const int xcd = blockIdx.x & 7, loc = blockIdx.x >> 3, nloc = gridDim.x >> 3;
                for (int rep = 0; rep < REP_P2; ++rep) {
                if (rep) xcd_barrier(xb);
                for (int jn = loc; jn < 432; jn += nloc) {
                    const int mg = jn / 216, rem = jn - mg * 216, nt = rem >> 3, mi = rem & 7, mt = xcd * 16 + mg * 8 + mi;
                    gemm_tile(smem, A, 1024, Bt, 1024, 1024, mt * 128, nt * 128, e);
                }
                }
            }
            GSYNC();
            {
                PrepArgs pa;
                pa.proj = proj; pa.mu = p.mu_shift + l * 1664; pa.muv = p.mu_vmix + (l > 0 ? (l - 1) * 32 : 0);
                pa.wdec = (const bf16_t*)(ws + OFF_WDEC) + (size_t)l * 512 * 64; pa.wicl = (const bf16_t*)(ws + OFF_WICL) + (size_t)l * 512 * 64;
                pa.wvm = (const bf16_t*)(ws + OFF_WVM) + (size_t)l * 512 * 32;
                pa.w0 = p.w0 + l * 512; pa.a0 = p.a0 + l * 512; pa.v0 = p.v0 + (l > 0 ? (l - 1) * 512 : 0); pa.k_k = p.k_k + l * 512; pa.k_a = p.k_a + l * 512;
                pa.cs = cs; pa.sn = sn; pa.sr = sr; pa.sk = sk; pa.sv = sv; pa.skk = skk; pa.skka = skka; pa.se = se; pa.vfirst = vfirst; pa.Kh = Kh;
                pa.layer = l; pa.tgbase = tgbase;
                EpiKV ekv{Kh, Vt, rskv, smem};
                EpiQ eq{Qh, rsq, cs, sn, tgbase, smem};
                const bf16_t* Bkv = (const bf16_t*)(ws + OFF_WUKV) + (size_t)l * 1024 * 256; const bf16_t* Bq = (const bf16_t*)(ws + OFF_WUQ) + (size_t)l * 768 * 384;
                for (int rep = 0; rep < REP_P3; ++rep) {
                if (rep) xcd_barrier(xb);
                {
                    for (int it = blockIdx.x; it < 1024; it += gridDim.x) prep_tile(smem, pa, it >> 2, it & 3);
                    const int xcd = blockIdx.x & 7, loc = blockIdx.x >> 3, nloc = gridDim.x >> 3;
                    for (int j = loc; j < 128; j += nloc) gemm_tile(smem, proj + O_CKV, NP, Bkv, 256, 256, (xcd * 16 + (j >> 3)) * 128, (j & 7) * 128, ekv);
                    for (int j = loc; j < 96; j += nloc) { const int ml = j / 6, nt = j - ml * 6; gemm_tile(smem, proj + O_CQ, NP, Bq, 384, 384, (xcd * 16 + ml) * 128, nt * 128, eq); }
                }
                }
            }
            GSYNC();
            {
                CopArgs ca{sr, sk, sv, skk, skka, se, ws + OFF_COPS};
                cop_phase(smem, ca);
            }
            GSYNC();
            {
                int* ctr = ctrl + (l * 2 + half);
                for (;;) {
                    __syncthreads();
                    if (threadIdx.x == 0) *s_item = atomicAdd(ctr, 1);
                    __syncthreads();
                    const int item = *s_item;
                    const int nconv = (half == 0 && l + 1 < NL) ? 512 : 0;
                    if (item >= 32 + 1024 + nconv) break;
                    if (item < 32) chunk_scan(smem, ws + OFF_COPS, yraw, item >> 3, item & 7);
                    else if (item < 32 + 1024) { const int t = item - 32, qt = 31 - (t >> 5), bh = t & 31; attn_tile(smem, Qh, Kh, Vt, proj, ycat, bh >> 3, bh & 7, qt); }
                    else convert_layer(smem, p, l + 1, item - (32 + 1024), 512);
                }
            }
            GSYNC();
            {
                FinArgs fa{yraw, sr, sk, sv, proj, p.lnx_w + l * 512, p.lnx_b + l * 512, p.r_k + l * 512, ycat, nullptr, nullptr};
                for (int rep = 0; rep < REP_P5; ++rep) { if (rep) xcd_barrier(xb); rwkv_finalize(fa); }
                const int ln = half == 0 ? l : l + 1, hn = half ^ 1;
                if (ln < NL) norm_phase(ln == 0 ? p.x : p.out, p.norm_g + ln * 1024, mod + (size_t)ln * 8 * 3072, hbuf, hn * TH);
            }
            GSYNC();
            {
                for (int rep = 0; rep < REP_P6; ++rep) {
                if (rep) xcd_barrier(xb);
                EpiOut eo{l == 0 ? p.x : p.out, p.out, modl, tgbase, rep == REP_P6 - 1 ? 1.0f : 0.0f};
                const bf16_t* Bo = (const bf16_t*)(ws + OFF_WOUT) + (size_t)l * 1024 * 1024;
                {
                    const int xcd = blockIdx.x & 7, loc = blockIdx.x >> 3, nloc = gridDim.x >> 3;
                    for (int j = loc; j < 128; j += nloc) gemm_tile(smem, ycat, 1024, Bo, 1024, 1024, (xcd * 16 + (j >> 3)) * 128, (j & 7) * 128, eo);
                }
                }
            }
        }
    }
    GSYNC();
    final_norm(p.out, p.final_g);
}

extern "C" void kernel_launch(void* const* d_in, const int* in_sizes, int n_in, void* d_out, int out_size, void* d_ws, size_t ws_size, hipStream_t stream) {
    static int grid_blocks = 0;
    if (!grid_blocks) {
        int dev = 0, cus = 0, per_cu = 0;
        (void)hipGetDevice(&dev);
        (void)hipDeviceGetAttribute(&cus, hipDeviceAttributeMultiprocessorCount, dev);
        (void)hipOccupancyMaxActiveBlocksPerMultiprocessor(&per_cu, fwd_megakernel, 256, 0);
        if (per_cu > 2) per_cu = 2;
        if (per_cu < 1) per_cu = 1;
        grid_blocks = cus * per_cu;
        if (grid_blocks % 8) grid_blocks -= grid_blocks % 8;
    }
    Params p{};
    p.x = (const float*)d_in[0]; p.c = (const float*)d_in[1]; p.pos = (const int*)d_in[2];
    p.norm_g = (const float*)d_in[3]; p.w_ada = (const float*)d_in[4]; p.b_ada = (const float*)d_in[5]; p.w_in = (const float*)d_in[6];
    p.w_vmd = (const float*)d_in[7]; p.mu_shift = (const float*)d_in[8]; p.mu_vmix = (const float*)d_in[9]; p.w0 = (const float*)d_in[10];
    p.w_dec = (const float*)d_in[11]; p.a0 = (const float*)d_in[12]; p.w_icl = (const float*)d_in[13]; p.v0 = (const float*)d_in[14];
    p.w_vmu = (const float*)d_in[15]; p.k_k = (const float*)d_in[16]; p.k_a = (const float*)d_in[17]; p.r_k = (const float*)d_in[18];
    p.lnx_w = (const float*)d_in[19]; p.lnx_b = (const float*)d_in[20]; p.qng = (const float*)d_in[21]; p.kvng = (const float*)d_in[22];
    p.w_uq = (const float*)d_in[23]; p.w_ukv = (const float*)d_in[24]; p.w_out = (const float*)d_in[25]; p.final_g = (const float*)d_in[26];
    p.out = (float*)d_out; p.ws = (char*)d_ws;
    (void)hipMemsetAsync((char*)d_ws + OFF_BAR, 0, 16384 + 4096 + 8192, stream);
    void* args[] = {&p};
    hipError_t e = hipLaunchCooperativeKernel((void*)fwd_megakernel, dim3(grid_blocks), dim3(256), args, 0, stream);
    if (e != hipSuccess) fprintf(stderr, "cooperative launch failed: %s (grid %d)\n", hipGetErrorString(e), grid_blocks);
}
```

```cpp
#include <hip/hip_runtime.h>
#include <hip/hip_cooperative_groups.h>
#include <cstdio>
#include <cstdint>
namespace cg = cooperative_groups;
constexpr int REP_P1 = 1, REP_P2 = 1, REP_P3 = 1, REP_P4 = 1, REP_P5 = 1, REP_P6 = 1, REP_SYNC = 1, REP_P0 = 1;
#define GSYNC() do { for (int r_ = 0; r_ < REP_SYNC; ++r_) xcd_barrier(xb); } while (0)


typedef unsigned short bf16_t;
typedef short bf16x8 __attribute__((ext_vector_type(8)));
typedef float f32x4 __attribute__((ext_vector_type(4)));
typedef float f32x2 __attribute__((ext_vector_type(2)));
typedef unsigned u32x4 __attribute__((ext_vector_type(4)));
typedef unsigned u32x2 __attribute__((ext_vector_type(2)));
#define LAS __attribute__((address_space(3)))

constexpr int DM = 1024, NB = 8, SEQ = 4096, NT = NB * SEQ, TH = NT / 2, NL = 4;
constexpr int NP = 3456;
constexpr int O_GR = 1664, O_CQ = 2176, O_CKV = 2560, O_KR = 2816, O_GM = 2848, INW = 3360;
constexpr float QSCALE = 0.10206207261596577f * 1.4426950408889634f;

constexpr size_t al256(size_t x) { return (x + 255) & ~(size_t)255; }
constexpr size_t OFF_BAR = 0;
constexpr size_t OFF_CTRL = 16384;
constexpr size_t OFF_CUCNT = 16384 + 4096;
constexpr size_t OFF_MOD = 16384 + 4096 + 8192;
constexpr size_t OFF_COS = OFF_MOD + al256((size_t)NL * NB * 3072 * 4);
constexpr size_t OFF_SIN = OFF_COS + (size_t)NT * 16 * 4;
constexpr size_t OFF_WIN = OFF_SIN + (size_t)NT * 16 * 4;
constexpr size_t OFF_WOUT = OFF_WIN + (size_t)NL * NP * 1024 * 2;
constexpr size_t OFF_WUQ = OFF_WOUT + (size_t)NL * 1024 * 1024 * 2;
constexpr size_t OFF_WUKV = OFF_WUQ + (size_t)NL * 768 * 384 * 2;
constexpr size_t OFF_WDEC = OFF_WUKV + (size_t)NL * 1024 * 256 * 2;
constexpr size_t OFF_WICL = OFF_WDEC + (size_t)NL * 512 * 64 * 2;
constexpr size_t OFF_WVM = OFF_WICL + (size_t)NL * 512 * 64 * 2;
constexpr size_t OFF_VFIRST = OFF_WVM + (size_t)NL * 512 * 32 * 2;
constexpr size_t OFF_H = OFF_VFIRST + (size_t)NT * 512 * 2;
constexpr int COP_STRIDE = 11008;
constexpr size_t OFF_COPS = OFF_H;
constexpr size_t OFF_PROJ = OFF_H + (size_t)8192 * COP_STRIDE;
constexpr size_t OFF_SR = OFF_PROJ + (size_t)TH * NP * 2;
constexpr size_t OFF_SK = OFF_SR + (size_t)TH * 512 * 2;
constexpr size_t OFF_SV = OFF_SK + (size_t)TH * 512 * 2;
constexpr size_t OFF_SKK = OFF_SV + (size_t)TH * 512 * 2;
constexpr size_t OFF_SKKA = OFF_SKK + (size_t)TH * 512 * 2;
constexpr size_t OFF_SW = OFF_SKKA + (size_t)TH * 512 * 2;
constexpr size_t OFF_RSQ = OFF_SW + (size_t)TH * 512 * 4;
constexpr size_t OFF_RSKV = OFF_RSQ + (size_t)TH * 8 * 4;
constexpr size_t OFF_Q = OFF_RSKV + (size_t)TH * 4 * 4;
constexpr size_t OFF_K = OFF_Q + (size_t)TH * 768 * 2;
constexpr size_t OFF_VT = OFF_K + (size_t)TH * 768 * 2;
constexpr size_t OFF_YRAW = OFF_VT + (size_t)TH * 512 * 2;
constexpr size_t OFF_YCAT = OFF_YRAW + (size_t)TH * 512 * 4;
constexpr size_t WS_TOTAL = OFF_YCAT + (size_t)TH * 1024 * 2;
static_assert(WS_TOTAL <= (size_t)536870912, "workspace exceeds 512 MiB");

struct Params {
    const float *x, *c; const int* pos;
    const float *norm_g, *w_ada, *b_ada, *w_in, *w_vmd, *mu_shift, *mu_vmix, *w0, *w_dec, *a0, *w_icl, *v0, *w_vmu;
    const float *k_k, *k_a, *r_k, *lnx_w, *lnx_b, *qng, *kvng, *w_uq, *w_ukv, *w_out, *final_g;
    float* out; char* ws;
};

__device__ __forceinline__ int otid() { int t = threadIdx.x; asm volatile("" : "+v"(t)); return t; }
__device__ __forceinline__ unsigned pk_bf16(float lo, float hi) { unsigned r; asm("v_cvt_pk_bf16_f32 %0, %1, %2" : "=v"(r) : "v"(lo), "v"(hi)); return r; }
__device__ __forceinline__ float bf_lo(unsigned u) { return __uint_as_float(u << 16); }
__device__ __forceinline__ float bf_hi(unsigned u) { return __uint_as_float(u & 0xffff0000u); }
__device__ __forceinline__ float sigmoidf_(float x) { return 1.0f / (1.0f + __expf(-x)); }
__device__ __forceinline__ float siluf_(float x) { return x / (1.0f + __expf(-x)); }
__device__ __forceinline__ float tanhf_(float x) { const float t = __expf(2.0f * x); return 1.0f - 2.0f / (t + 1.0f); }
template <int CTRL> __device__ __forceinline__ float dpp_add(float x) {
    return x + __int_as_float(__builtin_amdgcn_update_dpp(0, __float_as_int(x), CTRL, 0xf, 0xf, true));
}
__device__ __forceinline__ float dpp_sum16(float x) {
    x = dpp_add<0xB1>(x);
    x = dpp_add<0x4E>(x);
    x = dpp_add<0x141>(x);
    x = dpp_add<0x140>(x);
    return x;
}
__device__ __forceinline__ void dpp_sum16x2(float& a, float& b) {
    a = dpp_add<0xB1>(a); b = dpp_add<0xB1>(b);
    a = dpp_add<0x4E>(a); b = dpp_add<0x4E>(b);
    a = dpp_add<0x141>(a); b = dpp_add<0x141>(b);
    a = dpp_add<0x140>(a); b = dpp_add<0x140>(b);
}
__device__ __forceinline__ float wave_sum64(float x) {
    x += __shfl_xor(x, 1); x += __shfl_xor(x, 2); x += __shfl_xor(x, 4); x += __shfl_xor(x, 8); x += __shfl_xor(x, 16); x += __shfl_xor(x, 32);
    return x;
}


#define XB_TMO      128
#define XB_XCNT(j)  (256  + 64 * (j))
#define XB_XSUB(j)  (1280 + 64 * (j))
#define XB_XGEN(j)  (2304 + 64 * (j))
#define XB_TOP      3328
#define XB_TOPGEN   3392
#define XCD_BAR_WORDS 3456
#define XB_SPIN_CAP (1u << 18)
__device__ __forceinline__ unsigned xb_ld(unsigned* p)              { return __hip_atomic_load(p, __ATOMIC_RELAXED, __HIP_MEMORY_SCOPE_AGENT); }
__device__ __forceinline__ unsigned xb_add(unsigned* p, unsigned v) { return __hip_atomic_fetch_add(p, v, __ATOMIC_RELAXED, __HIP_MEMORY_SCOPE_AGENT); }
__device__ __forceinline__ unsigned xb_xcc_id() { return (unsigned)__builtin_amdgcn_s_getreg((3 << 11) | 20) & 0xFu; }
#define XB_SPIN(cond, bar) do { unsigned _sp = 0; while (cond) { __builtin_amdgcn_s_sleep(1); \
    if ((++_sp & 255u) == 0u) { if (xb_ld(&(bar)[XB_TMO])) break; if (_sp > XB_SPIN_CAP) { atomicAdd(&(bar)[XB_TMO], 1u); break; } } } } while (0)
struct XcdBarrier { unsigned* bar; unsigned x; volatile LAS unsigned* st; };
__device__ __forceinline__ XcdBarrier xcd_barrier_post(unsigned* bar, volatile LAS unsigned* st) {
    XcdBarrier b; b.bar = bar; b.x = xb_xcc_id(); b.st = st;
    if (threadIdx.x == 0) (void)xb_add(&bar[XB_XCNT(b.x)], 1u);
    return b;
}
__device__ __forceinline__ void xcd_barrier_complete(unsigned* bar, unsigned x, unsigned& nloc, unsigned& nx) {
    const unsigned G = gridDim.x * gridDim.y * gridDim.z;
    unsigned sum, cnt, mine, sp = 0u;
    for (;;) {
        sum = 0u; cnt = 0u; mine = 0u;
#pragma unroll
        for (unsigned j = 0; j < 16; ++j) { const unsigned c = xb_ld(&bar[XB_XCNT(j)]); sum += c; cnt += (c > 0u) ? 1u : 0u; mine = (j == x) ? c : mine; }
        if (sum == G) break;
        __builtin_amdgcn_s_sleep(1);
        if ((++sp & 255u) == 0u) { if (xb_ld(&bar[XB_TMO])) break; if (sp > XB_SPIN_CAP) { atomicAdd(&bar[XB_TMO], 1u); break; } }
    }
    nloc = mine > 0u ? mine : 1u; nx = cnt > 0u ? cnt : 1u;
}
__device__ __forceinline__ void xcd_barrier(const XcdBarrier& b) {
    asm volatile("s_waitcnt vmcnt(0)" ::: "memory");
    __syncthreads();
    if (threadIdx.x == 0) {
        unsigned* bar = b.bar;
        __builtin_amdgcn_s_waitcnt(0);
        unsigned nloc = b.st[0], nx = b.st[1];
        if (nloc == 0u) { xcd_barrier_complete(bar, b.x, nloc, nx); b.st[0] = nloc; b.st[1] = nx; }
        const unsigned old = xb_add(&bar[XB_XSUB(b.x)], 1u);
        const unsigned gen = old / nloc;
        if (old + 1u == (gen + 1u) * nloc) {
            __builtin_amdgcn_fence(__ATOMIC_RELEASE, "agent");
            asm volatile("s_waitcnt vmcnt(0)" ::: "memory");
            const unsigned og = xb_add(&bar[XB_TOP], 1u);
            const unsigned tg = og / nx;
            if (og + 1u == (tg + 1u) * nx) xb_add(&bar[XB_TOPGEN], 1u);
            else XB_SPIN(xb_ld(&bar[XB_TOPGEN]) == tg, bar);
            __builtin_amdgcn_fence(__ATOMIC_ACQUIRE, "agent");
            xb_add(&bar[XB_XGEN(b.x)], 1u);
            asm volatile("s_waitcnt vmcnt(0)" ::: "memory");
        } else {
            XB_SPIN(xb_ld(&bar[XB_XGEN(b.x)]) == gen, bar);
            __builtin_amdgcn_fence(__ATOMIC_ACQUIRE, "agent");
            asm volatile("s_waitcnt vmcnt(0)" ::: "memory");
        }
    }
    __syncthreads();
}

__device__ void transpose_job(float* tile, const float* __restrict__ src, int ld, int K, int N, bf16_t* __restrict__ dst, int dst_rows,
                              const float* __restrict__ kscale, const float* __restrict__ src2, int ld2, int n2lo, int n2hi, int& rot, int idx, int nidx) {
    const int nkt = (K + 63) >> 6, nnt = (dst_rows + 63) >> 6, ntiles = nkt * nnt;
    const int tid_ = otid(); const int tx = tid_ & 63, ty = tid_ >> 6;
    const int first = (idx + nidx - rot % nidx) % nidx;
    rot += ntiles;
    for (int t = first; t < ntiles; t += nidx) {
        const int kt = t % nkt, nt = t / nkt, k0 = kt * 64, n0 = nt * 64;
#pragma unroll 4
        for (int i = 0; i < 16; ++i) {
            const int k = k0 + ty + 4 * i, n = n0 + tx; float v = 0.f;
            if (k < K) {
                if (n < N) { v = src[(size_t)k * ld + n]; if (kscale) v *= kscale[k]; }
                else if (src2 && n >= n2lo && n < n2hi) v = src2[(size_t)k * ld2 + (n - n2lo)];
            }
            tile[(ty + 4 * i) * 65 + tx] = v;
        }
        __syncthreads();
#pragma unroll 4
        for (int i = 0; i < 16; ++i) {
            const int n = n0 + ty + 4 * i, k = k0 + tx;
            if (n < dst_rows && k < K) dst[(size_t)n * K + k] = (bf16_t)(pk_bf16(tile[tx * 65 + ty + 4 * i], 0.f) & 0xffffu);
        }
        __syncthreads();
    }
}

__device__ void mod_job(float* lds, const Params& p, float* __restrict__ mod) {
    float* cact = lds;
    float* red = lds + 8192;
    const int tid = otid();
    bool have = false;
    for (int it = (int)gridDim.x - 1 - (int)blockIdx.x; it < 192; it += gridDim.x) {
        if (!have) {
            for (int i = tid; i < 8192; i += 256) cact[i] = siluf_(p.c[i]);
            have = true;
            __syncthreads();
        }
        const int l = it / 48, n0 = (it % 48) * 64, kg = tid >> 6, n = n0 + (tid & 63);
        float a0 = 0.f, a1 = 0.f, a2 = 0.f, a3 = 0.f, a4 = 0.f, a5 = 0.f, a6 = 0.f, a7 = 0.f;
        const float* wp = p.w_ada + ((size_t)l * 1024 + kg * 256) * 3072 + n;
#pragma unroll 8
        for (int k = 0; k < 256; ++k) {
            const float w = wp[(size_t)k * 3072]; const int kk = kg * 256 + k;
            a0 += cact[kk] * w; a1 += cact[1024 + kk] * w; a2 += cact[2048 + kk] * w; a3 += cact[3072 + kk] * w;
            a4 += cact[4096 + kk] * w; a5 += cact[5120 + kk] * w; a6 += cact[6144 + kk] * w; a7 += cact[7168 + kk] * w;
        }
        float* rp = red + (kg * 64 + (tid & 63)) * 8;
        rp[0] = a0; rp[1] = a1; rp[2] = a2; rp[3] = a3; rp[4] = a4; rp[5] = a5; rp[6] = a6; rp[7] = a7;
        __syncthreads();
        {
#pragma unroll
            for (int q = 0; q < 2; ++q) {
                const int o = tid + 256 * q, nn = o >> 3, b = o & 7;
                const float s = red[(0 * 64 + nn) * 8 + b] + red[(1 * 64 + nn) * 8 + b] + red[(2 * 64 + nn) * 8 + b] + red[(3 * 64 + nn) * 8 + b];
                mod[((size_t)l * 8 + b) * 3072 + n0 + nn] = s + p.b_ada[l * 3072 + n0 + nn];
            }
        }
        __syncthreads();
    }
}

__device__ void convert_layer(char* smem, const Params& p, int l, int idx, int nidx) {
    char* ws = p.ws; float* tile = (float*)smem; int rot = 0;
    transpose_job(tile, p.w_in + (size_t)l * 1024 * INW, INW, 1024, INW, (bf16_t*)(ws + OFF_WIN) + (size_t)l * NP * 1024, NP, nullptr,
                  l > 0 ? p.w_vmd + (size_t)(l - 1) * 1024 * 32 : nullptr, 32, INW, INW + 32, rot, idx, nidx);
    transpose_job(tile, p.w_out + (size_t)l * 1024 * 1024, 1024, 1024, 1024, (bf16_t*)(ws + OFF_WOUT) + (size_t)l * 1024 * 1024, 1024, nullptr, nullptr, 0, 0, 0, rot, idx, nidx);
    transpose_job(tile, p.w_uq + (size_t)l * 384 * 768, 768, 384, 768, (bf16_t*)(ws + OFF_WUQ) + (size_t)l * 768 * 384, 768, p.qng + l * 384, nullptr, 0, 0, 0, rot, idx, nidx);
    transpose_job(tile, p.w_ukv + (size_t)l * 256 * 1024, 1024, 256, 1024, (bf16_t*)(ws + OFF_WUKV) + (size_t)l * 1024 * 256, 1024, p.kvng + l * 256, nullptr, 0, 0, 0, rot, idx, nidx);
    transpose_job(tile, p.w_dec + (size_t)l * 64 * 512, 512, 64, 512, (bf16_t*)(ws + OFF_WDEC) + (size_t)l * 512 * 64, 512, nullptr, nullptr, 0, 0, 0, rot, idx, nidx);
    transpose_job(tile, p.w_icl + (size_t)l * 64 * 512, 512, 64, 512, (bf16_t*)(ws + OFF_WICL) + (size_t)l * 512 * 64, 512, nullptr, nullptr, 0, 0, 0, rot, idx, nidx);
    if (l > 0)
        transpose_job(tile, p.w_vmu + (size_t)(l - 1) * 32 * 512, 512, 32, 512, (bf16_t*)(ws + OFF_WVM) + (size_t)l * 512 * 32, 512, nullptr, nullptr, 0, 0, 0, rot, idx, nidx);
}

__device__ void prologue(char* smem, const Params& p) {
    char* ws = p.ws;
    float* tile = (float*)smem;
    { const int t0_ = otid(); if (blockIdx.x == 0 && t0_ < 64) ((int*)(ws + OFF_CTRL))[t0_] = 0; }
    {
        float* cs = (float*)(ws + OFF_COS); float* sn = (float*)(ws + OFF_SIN);
        const int gt = blockIdx.x * 256 + otid(), ng = gridDim.x * 256;
        for (int e = gt; e < NT * 16; e += ng) {
            const int t = e >> 4, i = e & 15;
            const float inv = exp2f(-(float)i * (13.287712379549449f / 16.0f));
            const float ang = (float)p.pos[t] * inv;
            cs[e] = cosf(ang); sn[e] = sinf(ang);
        }
    }
    mod_job(tile, p, (float*)(ws + OFF_MOD));
    __syncthreads();
    convert_layer(smem, p, 0, blockIdx.x, gridDim.x);
}

__device__ void norm_phase(const float* __restrict__ xin, const float* __restrict__ g, const float* __restrict__ modl, bf16_t* __restrict__ h, int tbase) {
    const int tid_ = otid(); const int lane = tid_ & 63, gw = blockIdx.x * 4 + (tid_ >> 6), nw = gridDim.x * 4;
    for (int t = tbase + gw; t < tbase + TH; t += nw) {
        const float* xr = xin + (size_t)t * 1024;
        f32x4 v[4]; float ss = 0.f;
#pragma unroll
        for (int i = 0; i < 4; ++i) { v[i] = *(const f32x4*)(xr + i * 256 + lane * 4); ss += v[i].x * v[i].x + v[i].y * v[i].y + v[i].z * v[i].z + v[i].w * v[i].w; }
        ss = wave_sum64(ss);
        const float rstd = rsqrtf(ss * (1.0f / 1024.0f) + 1e-6f);
        const float* mb = modl + (size_t)(t >> 12) * 3072;
#pragma unroll
        for (int i = 0; i < 4; ++i) {
            const int col = i * 256 + lane * 4;
            const f32x4 gg = *(const f32x4*)(g + col), sh = *(const f32x4*)(mb + col), sc = *(const f32x4*)(mb + 1024 + col);
            const f32x4 o = v[i] * rstd * gg * (sc + 1.0f) + sh;
            u32x2 w; w.x = pk_bf16(o.x, o.y); w.y = pk_bf16(o.z, o.w);
            *(u32x2*)(h + (size_t)(t - tbase) * 1024 + col) = w;
        }
    }
}

__device__ void final_norm(float* __restrict__ xio, const float* __restrict__ g) {
    const int tid_ = otid(); const int lane = tid_ & 63, gw = blockIdx.x * 4 + (tid_ >> 6), nw = gridDim.x * 4;
    for (int t = gw; t < NT; t += nw) {
        float* xr = xio + (size_t)t * 1024;
        f32x4 v[4]; float ss = 0.f;
#pragma unroll
        for (int i = 0; i < 4; ++i) { v[i] = *(const f32x4*)(xr + i * 256 + lane * 4); ss += v[i].x * v[i].x + v[i].y * v[i].y + v[i].z * v[i].z + v[i].w * v[i].w; }
        ss = wave_sum64(ss);
        const float rstd = rsqrtf(ss * (1.0f / 1024.0f) + 1e-6f);
#pragma unroll
        for (int i = 0; i < 4; ++i) {
            const int col = i * 256 + lane * 4;
            const f32x4 gg = *(const f32x4*)(g + col);
            *(f32x4*)(xr + col) = v[i] * rstd * gg;
        }
    }
}

template <class Epi>
__device__ __forceinline__ void gemm_tile(char* smem, const bf16_t* __restrict__ A, int lda, const bf16_t* __restrict__ Bt, int ldb, int K, int row0, int col0, const Epi& epi) {
    const int tid = otid(), lane = tid & 63, wid = tid >> 6, wr = wid >> 1, wc = wid & 1, fr = lane & 15, fq = lane >> 4;
    f32x4 acc[4][4];
#pragma unroll
    for (int i = 0; i < 4; ++i)
#pragma unroll
        for (int j = 0; j < 4; ++j) acc[i][j] = (f32x4){0.f, 0.f, 0.f, 0.f};
    const int lrow = lane >> 3, lp = lane & 7;
    const int srow0 = wid * 32 + lrow;
    const bf16_t* gA = A + (size_t)(row0 + srow0) * lda;
    const bf16_t* gB = Bt + (size_t)(col0 + srow0) * ldb;
    int gc[4];
#pragma unroll
    for (int i = 0; i < 4; ++i) gc[i] = (lp ^ (((srow0 + 8 * i) >> 1) & 7)) * 8;
    LAS char* lbase = (LAS char*)smem + wid * 4096;
#define GEMM_STAGE(buf, kofs) do { _Pragma("unroll") for (int i = 0; i < 4; ++i) { \
        __builtin_amdgcn_global_load_lds((const unsigned*)(gA + (size_t)(8 * i) * lda + (kofs) + gc[i]), (LAS unsigned*)(lbase + (buf) * 32768 + i * 1024), 16, 0, 0); \
        __builtin_amdgcn_global_load_lds((const unsigned*)(gB + (size_t)(8 * i) * ldb + (kofs) + gc[i]), (LAS unsigned*)(lbase + (buf) * 32768 + 16384 + i * 1024), 16, 0, 0); } } while (0)
    GEMM_STAGE(0, 0);
    __syncthreads();
    const int nk = K >> 6;
    const int fsw = (fr >> 1) & 7;
    const int aoff = (wr * 64 + fr) * 128, boff = 16384 + (wc * 64 + fr) * 128;
#define GEMM_STEP(CB, NB_) do { \
        const char* cur = smem + (CB) * 32768; \
        bf16x8 af[2][4], bfr[2][4]; \
        _Pragma("unroll") for (int kk = 0; kk < 2; ++kk) { \
            const int csw = (((kk * 4 + fq) ^ fsw) << 4); \
            _Pragma("unroll") for (int i = 0; i < 4; ++i) { af[kk][i] = *(const bf16x8*)(cur + aoff + i * 2048 + csw); bfr[kk][i] = *(const bf16x8*)(cur + boff + i * 2048 + csw); } \
        } \
        __builtin_amdgcn_sched_barrier(0); \
        if (ks + 1 < nk) GEMM_STAGE(NB_, (ks + 1) * 64); \
        __builtin_amdgcn_sched_barrier(0); \
        _Pragma("unroll") for (int kk = 0; kk < 2; ++kk) \
            _Pragma("unroll") for (int mi = 0; mi < 4; ++mi) \
                _Pragma("unroll") for (int ni = 0; ni < 4; ++ni) acc[mi][ni] = __builtin_amdgcn_mfma_f32_16x16x32_bf16(bfr[kk][ni], af[kk][mi], acc[mi][ni], 0, 0, 0); \
        __builtin_amdgcn_sched_barrier(0); \
        __syncthreads(); \
        ++ks; } while (0)
#pragma unroll 1
    for (int ks = 0; ks < nk;) {
        GEMM_STEP(0, 1);
        GEMM_STEP(1, 0);
    }
#undef GEMM_STEP
#undef GEMM_STAGE
    epi(acc, row0 + wr * 64, col0 + wc * 64, fr, fq);
}

struct EpiProj {
    bf16_t* proj; float* rsq; float* rskv; char* smem;
    __device__ __forceinline__ void operator()(const f32x4 (&acc)[4][4], int rbase, int cbase, int fr, int fq) const {
        const bool isq = cbase >= O_CQ && cbase < O_CKV, iskv = cbase >= O_CKV && cbase < O_KR;
        const int row0 = rbase & ~127, col0 = cbase & ~127, wr = (rbase >> 6) & 1, wc = (cbase >> 6) & 1;
        const int tid = (wr * 2 + wc) * 64 + fq * 16 + fr;
#pragma unroll
        for (int mi = 0; mi < 4; ++mi) {
            const int tl = rbase + mi * 16 + fr; float ss = 0.f;
#pragma unroll
            for (int ni = 0; ni < 4; ++ni) {
                u32x2 w; w.x = pk_bf16(acc[mi][ni][0], acc[mi][ni][1]); w.y = pk_bf16(acc[mi][ni][2], acc[mi][ni][3]);
                *(u32x2*)(smem + (wr * 64 + mi * 16 + fr) * 272 + (wc * 64 + ni * 16 + fq * 4) * 2) = w;
                const float a = bf_lo(w.x), b = bf_hi(w.x), c = bf_lo(w.y), d = bf_hi(w.y);
                ss += a * a + b * b + c * c + d * d;
            }
            if (isq || iskv) {
                ss += __shfl_xor(ss, 16); ss += __shfl_xor(ss, 32);
                if (fq == 0) { if (isq) rsq[(size_t)tl * 8 + ((cbase - O_CQ) >> 6)] = ss; else rskv[(size_t)tl * 4 + ((cbase - O_CKV) >> 6)] = ss; }
            }
        }
        __syncthreads();
#pragma unroll
        for (int i = 0; i < 8; ++i) {
            const int q = tid + 256 * i, r = q >> 4, c = q & 15;
            *(u32x4*)(proj + (size_t)(row0 + r) * NP + col0 + c * 8) = *(const u32x4*)(smem + r * 272 + c * 16);
        }
        __syncthreads();
    }
};
struct EpiQ {
    bf16_t* Q; const float* rsq; const float* cs; const float* sn; int tgbase; char* smem;
    __device__ __forceinline__ void operator()(const f32x4 (&acc)[4][4], int rbase, int cbase, int fr, int fq) const {
        const int g0 = cbase >> 4;
        char* stg = smem + ((((rbase >> 6) & 1) * 2 + ((cbase >> 6) & 1)) * 9216);
#pragma unroll
        for (int mi = 0; mi < 4; ++mi) {
            const int tl = rbase + mi * 16 + fr;
            const f32x4 s0 = *(const f32x4*)(rsq + (size_t)tl * 8); const f32x2 s1 = *(const f32x2*)(rsq + (size_t)tl * 8 + 4);
            const float rs = rsqrtf((s0.x + s0.y + s0.z + s0.w + s1.x + s1.y) * (1.0f / 384.0f) + 1e-6f) * QSCALE;
            const f32x4 cc = *(const f32x4*)(cs + (size_t)(tgbase + tl) * 16 + fq * 4), sv = *(const f32x4*)(sn + (size_t)(tgbase + tl) * 16 + fq * 4);
            f32x4 v[4];
#pragma unroll
            for (int ni = 0; ni < 4; ++ni) v[ni] = acc[mi][ni] * rs;
#pragma unroll
            for (int ni = 0; ni < 4; ni += 2)
                if ((g0 + ni) % 6 == 4) { const f32x4 x1 = v[ni], x2 = v[ni + 1]; v[ni] = x1 * cc - x2 * sv; v[ni + 1] = x2 * cc + x1 * sv; }
#pragma unroll
            for (int ni = 0; ni < 4; ++ni) {
                u32x2 w; w.x = pk_bf16(v[ni][0], v[ni][1]); w.y = pk_bf16(v[ni][2], v[ni][3]);
                *(u32x2*)(stg + (mi * 16 + fr) * 144 + (ni * 16 + fq * 4) * 2) = w;
            }
        }
        {
            const int lane = fq * 16 + fr;
#pragma unroll
            for (int i = 0; i < 8; ++i) {
                const int q = lane + 64 * i, tk = q >> 3, c = q & 7;
                *(u32x4*)(Q + (size_t)(rbase + tk) * 768 + cbase + c * 8) = *(const u32x4*)(stg + tk * 144 + c * 16);
            }
        }
        __syncthreads();
    }
};
struct EpiKV {
    bf16_t* Kh; bf16_t* Vt; const float* rskv; char* smem;
    __device__ __forceinline__ void operator()(const f32x4 (&acc)[4][4], int rbase, int cbase, int fr, int fq) const {
        const int hh = cbase >> 7, part = (cbase >> 6) & 1, lane = fq * 16 + fr;
        char* stg = smem + ((((rbase >> 6) & 1) * 2 + part) * 9216);
#pragma unroll
        for (int mi = 0; mi < 4; ++mi) {
            const int tl = rbase + mi * 16 + fr;
            const f32x4 s0 = *(const f32x4*)(rskv + (size_t)tl * 4);
            const float rs = rsqrtf((s0.x + s0.y + s0.z + s0.w) * (1.0f / 256.0f) + 1e-6f);
#pragma unroll
            for (int ni = 0; ni < 4; ++ni) {
                const unsigned w0 = pk_bf16(acc[mi][ni][0] * rs, acc[mi][ni][1] * rs), w1 = pk_bf16(acc[mi][ni][2] * rs, acc[mi][ni][3] * rs);
                if (part == 0) { u32x2 w; w.x = w0; w.y = w1; *(u32x2*)(stg + (mi * 16 + fr) * 144 + (ni * 16 + fq * 4) * 2) = w; }
                else {
                    bf16_t* sp = (bf16_t*)(stg + (ni * 16 + fq * 4) * 144) + mi * 16 + fr;
                    sp[0] = (bf16_t)(w0 & 0xffffu); sp[72] = (bf16_t)(w0 >> 16); sp[144] = (bf16_t)(w1 & 0xffffu); sp[216] = (bf16_t)(w1 >> 16);
                }
            }
        }
        if (part == 0) {
#pragma unroll
            for (int i = 0; i < 8; ++i) {
                const int q = lane + 64 * i, tk = q >> 3, c = q & 7;
                *(u32x4*)(Kh + (size_t)(rbase + tk) * 768 + hh * 96 + c * 8) = *(const u32x4*)(stg + tk * 144 + c * 16);
            }
        } else {
            const int bl = rbase >> 12, s0 = rbase & 4095;
            bf16_t* vb = Vt + ((size_t)(bl * 8 + hh) * 64) * 4096 + s0;
#pragma unroll
            for (int i = 0; i < 8; ++i) {
                const int q = lane + 64 * i, dv = q >> 3, c = q & 7;
                *(u32x4*)(vb + (size_t)dv * 4096 + c * 8) = *(const u32x4*)(stg + dv * 144 + c * 16);
            }
        }
        __syncthreads();
    }
};
struct EpiOut {
    const float* xold; float* xnew; const float* modl; int tgbase; float fac;
    __device__ __forceinline__ void operator()(const f32x4 (&acc)[4][4], int rbase, int cbase, int fr, int fq) const {
#pragma unroll
        for (int mi = 0; mi < 4; ++mi) {
            const int tg = tgbase + rbase + mi * 16 + fr; const float* gp = modl + (size_t)(tg >> 12) * 3072 + 2048;
#pragma unroll
            for (int ni = 0; ni < 4; ++ni) {
                const int col = cbase + ni * 16 + fq * 4;
                const f32x4 xo = *(const f32x4*)(xold + (size_t)tg * 1024 + col), gt = *(const f32x4*)(gp + col);
                *(f32x4*)(xnew + (size_t)tg * 1024 + col) = xo + gt * acc[mi][ni] * fac;
            }
        }
    }
};

struct PrepArgs {
    const bf16_t* proj; const float* mu; const float* muv; const bf16_t* wdec; const bf16_t* wicl; const bf16_t* wvm;
    const float *w0, *a0, *v0, *k_k, *k_a; const float *cs, *sn;
    bf16_t *sr, *sk, *sv, *skk, *skka; bf16_t* se; bf16_t* vfirst; bf16_t* Kh; int layer; int tgbase;
};
__device__ __forceinline__ void lerp8(const bf16_t* cur, const bf16_t* prv, bool hp, const float* mu, float (&o)[8]) {
    const u32x4 c = *(const u32x4*)cur; u32x4 q = (u32x4){0u, 0u, 0u, 0u}; if (hp) q = *(const u32x4*)prv;
    const f32x4 m0 = *(const f32x4*)mu, m1 = *(const f32x4*)(mu + 4);
    const float cv[8] = {bf_lo(c.x), bf_hi(c.x), bf_lo(c.y), bf_hi(c.y), bf_lo(c.z), bf_hi(c.z), bf_lo(c.w), bf_hi(c.w)};
    const float pv[8] = {bf_lo(q.x), bf_hi(q.x), bf_lo(q.y), bf_hi(q.y), bf_lo(q.z), bf_hi(q.z), bf_lo(q.w), bf_hi(q.w)};
    const float mv[8] = {m0.x, m0.y, m0.z, m0.w, m1.x, m1.y, m1.z, m1.w};
#pragma unroll
    for (int j = 0; j < 8; ++j) o[j] = cv[j] + (pv[j] - cv[j]) * mv[j];
}
__device__ __forceinline__ f32x4 lerp4(const bf16_t* cur, const bf16_t* prv, bool hp, const float* mu) {
    const u32x2 c = *(const u32x2*)cur; u32x2 q = (u32x2){0u, 0u}; if (hp) q = *(const u32x2*)prv;
    const f32x4 m = *(const f32x4*)mu;
    const f32x4 cv = (f32x4){bf_lo(c.x), bf_hi(c.x), bf_lo(c.y), bf_hi(c.y)}, pv = (f32x4){bf_lo(q.x), bf_hi(q.x), bf_lo(q.y), bf_hi(q.y)};
    return cv + (pv - cv) * m;
}
__device__ __forceinline__ bf16x8 pack8(const float (&v)[8]) {
    u32x4 w; w.x = pk_bf16(v[0], v[1]); w.y = pk_bf16(v[2], v[3]); w.z = pk_bf16(v[4], v[5]); w.w = pk_bf16(v[6], v[7]);
    return __builtin_bit_cast(bf16x8, w);
}
__device__ __forceinline__ void store4(bf16_t* dst, const f32x4 v) { u32x2 w; w.x = pk_bf16(v.x, v.y); w.y = pk_bf16(v.z, v.w); *(u32x2*)dst = w; }

__device__ __forceinline__ void prep_tile(char* smem, const PrepArgs& a, int tile, int hg) {
    const int tid = otid(), lane = tid & 63, wid = tid >> 6, fr = lane & 15, fq = lane >> 4;
    const int tl = tile * 64 + wid * 16 + fr, tg = a.tgbase + tl;
    char* stg = smem + wid * 15872;
    const int tlw = tile * 64 + wid * 16;
    const bool hp = (tg & 4095) != 0;
    const bf16_t* pr = a.proj + (size_t)tl * NP; const bf16_t* pp = pr - NP;
    if (hg == 0) {
        const u32x2 u1 = *(const u32x2*)(pr + O_KR + fq * 4), u2 = *(const u32x2*)(pr + O_KR + 16 + fq * 4);
        const f32x4 x1 = (f32x4){bf_lo(u1.x), bf_hi(u1.x), bf_lo(u1.y), bf_hi(u1.y)}, x2 = (f32x4){bf_lo(u2.x), bf_hi(u2.x), bf_lo(u2.y), bf_hi(u2.y)};
        const f32x4 cc = *(const f32x4*)(a.cs + (size_t)tg * 16 + fq * 4), sv = *(const f32x4*)(a.sn + (size_t)tg * 16 + fq * 4);
        const f32x4 o1 = x1 * cc - x2 * sv, o2 = x2 * cc + x1 * sv;
        u32x2 w1, w2; w1.x = pk_bf16(o1.x, o1.y); w1.y = pk_bf16(o1.z, o1.w); w2.x = pk_bf16(o2.x, o2.y); w2.y = pk_bf16(o2.z, o2.w);
#pragma unroll
        for (int hh = 0; hh < 8; ++hh) { *(u32x2*)(a.Kh + (size_t)tl * 768 + hh * 96 + 64 + fq * 4) = w1; *(u32x2*)(a.Kh + (size_t)tl * 768 + hh * 96 + 80 + fq * 4) = w2; }
    }
    bf16x8 bw[2], ba[2], bv;
#pragma unroll
    for (int ks = 0; ks < 2; ++ks) {
        float t[8];
        lerp8(pr + 1536 + ks * 32 + fq * 8, pp + 1536 + ks * 32 + fq * 8, hp, a.mu + 1536 + ks * 32 + fq * 8, t);
#pragma unroll
        for (int j = 0; j < 8; ++j) t[j] = tanhf_(t[j]);
        bw[ks] = pack8(t);
        lerp8(pr + 1600 + ks * 32 + fq * 8, pp + 1600 + ks * 32 + fq * 8, hp, a.mu + 1600 + ks * 32 + fq * 8, t);
        ba[ks] = pack8(t);
    }
    const bool hasv = a.layer > 0;
    if (hasv) { float t[8]; lerp8(pr + INW + fq * 8, pp + INW + fq * 8, hp, a.muv + fq * 8, t); bv = pack8(t); }
    else bv = (bf16x8){0, 0, 0, 0, 0, 0, 0, 0};
#pragma unroll 1
    for (int hh = hg * 2; hh < hg * 2 + 2; ++hh) {
        float ss = 0.f;
#pragma unroll
        for (int nt = 0; nt < 4; ++nt) {
            const int ch = hh * 64 + nt * 16 + fq * 4;
            const f32x4 k4 = lerp4(pr + 512 + ch, pp + 512 + ch, hp, a.mu + 512 + ch);
            const f32x4 kr = k4 * *(const f32x4*)(a.k_k + ch);
            ss += kr.x * kr.x + kr.y * kr.y + kr.z * kr.z + kr.w * kr.w;
        }
        ss += __shfl_xor(ss, 16); ss += __shfl_xor(ss, 32);
        const float inv = 1.0f / fmaxf(sqrtf(ss), 1e-12f);
#pragma unroll
        for (int nt = 0; nt < 4; ++nt) {
            const int cb = hh * 64 + nt * 16, ch = cb + fq * 4;
            f32x4 accw = (f32x4){0.f, 0.f, 0.f, 0.f}, acca = accw, accv = accw;
#pragma unroll
            for (int ks = 0; ks < 2; ++ks) {
                const bf16x8 aw = *(const bf16x8*)(a.wdec + (size_t)(cb + fr) * 64 + ks * 32 + fq * 8);
                const bf16x8 ai = *(const bf16x8*)(a.wicl + (size_t)(cb + fr) * 64 + ks * 32 + fq * 8);
                accw = __builtin_amdgcn_mfma_f32_16x16x32_bf16(aw, bw[ks], accw, 0, 0, 0);
                acca = __builtin_amdgcn_mfma_f32_16x16x32_bf16(ai, ba[ks], acca, 0, 0, 0);
            }
            if (hasv) {
                const bf16x8 avm = *(const bf16x8*)(a.wvm + (size_t)(cb + fr) * 32 + fq * 8);
                accv = __builtin_amdgcn_mfma_f32_16x16x32_bf16(avm, bv, accv, 0, 0, 0);
            }
            const f32x4 r4 = lerp4(pr + ch, pp + ch, hp, a.mu + ch);
            const f32x4 k4 = lerp4(pr + 512 + ch, pp + 512 + ch, hp, a.mu + 512 + ch);
            f32x4 v4 = lerp4(pr + 1024 + ch, pp + 1024 + ch, hp, a.mu + 1024 + ch);
            const f32x4 w0v = *(const f32x4*)(a.w0 + ch), a0v = *(const f32x4*)(a.a0 + ch), kkv = *(const f32x4*)(a.k_k + ch), kav = *(const f32x4*)(a.k_a + ch);
            f32x4 dec, aa;
#pragma unroll
            for (int j = 0; j < 4; ++j) {
                dec[j] = 0.6065306597126334f * sigmoidf_(w0v[j] + accw[j]);
                aa[j] = sigmoidf_(a0v[j] + acca[j]);
            }
            if (hasv) {
                const f32x4 v0v = *(const f32x4*)(a.v0 + ch);
                const u32x2 uf = *(const u32x2*)(a.vfirst + (size_t)tg * 512 + ch);
                const f32x4 vf = (f32x4){bf_lo(uf.x), bf_hi(uf.x), bf_lo(uf.y), bf_hi(uf.y)};
#pragma unroll
                for (int j = 0; j < 4; ++j) v4[j] = v4[j] + (vf[j] - v4[j]) * sigmoidf_(v0v[j] + accv[j]);
            } else {
                store4(a.vfirst + (size_t)tg * 512 + ch, v4);
            }
            const f32x4 kk = k4 * kkv * inv;
            const f32x4 kp = k4 * ((aa - 1.0f) * kav + 1.0f);
            {
                const int so = fr * 144 + nt * 32 + fq * 8;
                store4((bf16_t*)(stg + so), r4); store4((bf16_t*)(stg + 2304 + so), kp); store4((bf16_t*)(stg + 4608 + so), v4);
                store4((bf16_t*)(stg + 6912 + so), kk); store4((bf16_t*)(stg + 9216 + so), kk * aa);
                store4((bf16_t*)(stg + 11520 + so), dec);
            }
        }
        {
#pragma unroll
            for (int i = 0; i < 2; ++i) {
                const int q = lane + 64 * i, tk = q >> 3, c = q & 7;
                const size_t go = (size_t)(tlw + tk) * 512 + hh * 64 + c * 8; const int lo = tk * 144 + c * 16;
                *(u32x4*)(a.sr + go) = *(const u32x4*)(stg + lo); *(u32x4*)(a.sk + go) = *(const u32x4*)(stg + 2304 + lo); *(u32x4*)(a.sv + go) = *(const u32x4*)(stg + 4608 + lo);
                *(u32x4*)(a.skk + go) = *(const u32x4*)(stg + 6912 + lo); *(u32x4*)(a.skka + go) = *(const u32x4*)(stg + 9216 + lo);
                *(u32x4*)(a.se + go) = *(const u32x4*)(stg + 11520 + lo);
            }
        }
    }
    __syncthreads();
}

struct ScanArgs { const bf16_t *sr, *sk, *sv, *skk, *skka; const float* sw; float* yraw; float* zbuf; float* sfin; };
__device__ __forceinline__ void cvt_store8(float* dst, const u32x4 u) {
    *(f32x4*)dst = (f32x4){bf_lo(u.x), bf_hi(u.x), bf_lo(u.y), bf_hi(u.y)};
    *(f32x4*)(dst + 4) = (f32x4){bf_lo(u.z), bf_hi(u.z), bf_lo(u.w), bf_hi(u.w)};
}
__device__ __forceinline__ void scan_tile(char* smem, const ScanArgs& a, int mode, int bl, int hh, int g) {
    const int tid = otid(), lane = tid & 63, wid = tid >> 6, rl = lane >> 4, c = lane & 15;
    float* L = (float*)smem;
    float* ybuf = L + 2 * 5376;
    const size_t tokbase = (size_t)bl * 4096 + (mode ? 2048 : 0);
    const int colh = hh * 64, i0 = g * 16;
    const bf16_t* src0 = (tid < 128) ? a.skk : a.skka;
    const bf16_t* src1 = (tid < 128) ? a.sk : a.sr;
    const int rem = tid & 127, tokA = rem >> 3, chA = rem & 7;
    const size_t gofsA = (size_t)tokA * 512 + colh + chA * 8;
    const int ldsA0 = (1 + (tid >> 7)) * 1024 + tokA * 64 + chA * 8, ldsA1 = (3 + (tid >> 7)) * 1024 + tokA * 64 + chA * 8;
    const size_t gofsW = (size_t)(tid >> 4) * 512 + colh + (tid & 15) * 4;
    const int ldsW = (tid >> 4) * 64 + (tid & 15) * 4;
    const size_t gofsV = (size_t)((tid & 31) >> 1) * 512 + colh + i0 + (tid & 1) * 8;
    const int ldsV = 5120 + ((tid & 31) >> 1) * 16 + (tid & 1) * 8;
    const bool ldv = tid < 32 && mode != 2;
    f32x2 S01 = (f32x2){0.f, 0.f}, S23 = (f32x2){0.f, 0.f};
    if (mode == 2) { const int d = (i0 + wid * 4 + rl) - c * 4; S01.x = d == 0 ? 1.f : 0.f; S01.y = d == 1 ? 1.f : 0.f; S23.x = d == 2 ? 1.f : 0.f; S23.y = d == 3 ? 1.f : 0.f; }
    u32x4 qa, qb, qv = (u32x4){0u, 0u, 0u, 0u}; f32x4 qw;
    {
        const size_t tb = tokbase * 512;
        qa = *(const u32x4*)(src0 + tb + gofsA); qb = *(const u32x4*)(src1 + tb + gofsA); qw = *(const f32x4*)(a.sw + tb + gofsW);
        if (ldv) qv = *(const u32x4*)(a.sv + tb + gofsV);
        cvt_store8(L + ldsA0, qa); cvt_store8(L + ldsA1, qb); *(f32x4*)(L + ldsW) = qw; if (tid < 32) { cvt_store8(L + ldsV, qv); if (mode == 2) cvt_store8(L + 5376 + ldsV, qv); }
    }
    __syncthreads();
    const int vofs = 5120 + wid * 4 + rl;
#pragma unroll 1
    for (int ch = 0; ch < 128; ++ch) {
        const float* cur = L + (ch & 1) * 5376;
        if (ch + 1 < 128) {
            const size_t tb = (tokbase + (size_t)(ch + 1) * 16) * 512;
            qa = *(const u32x4*)(src0 + tb + gofsA); qb = *(const u32x4*)(src1 + tb + gofsA); qw = *(const f32x4*)(a.sw + tb + gofsW);
            if (ldv) qv = *(const u32x4*)(a.sv + tb + gofsV);
        }
        float* yb = ybuf + (ch & 1) * 256;
        float ykeep = 0.f;
        f32x4 w4 = *(const f32x4*)(cur + c * 4), kk4 = *(const f32x4*)(cur + 1024 + c * 4), ka4 = *(const f32x4*)(cur + 2048 + c * 4);
        f32x4 k4 = *(const f32x4*)(cur + 3072 + c * 4), r4 = *(const f32x4*)(cur + 4096 + c * 4);
        float v = cur[vofs];
        float prevq = 0.f;
#pragma unroll
        for (int s = 0; s < 16; ++s) {
            f32x4 nw4 = w4, nkk4 = kk4, nka4 = ka4, nk4 = k4, nr4 = r4; float nv = v;
            if (s + 1 < 16) {
                nw4 = *(const f32x4*)(cur + (s + 1) * 64 + c * 4); nkk4 = *(const f32x4*)(cur + 1024 + (s + 1) * 64 + c * 4); nka4 = *(const f32x4*)(cur + 2048 + (s + 1) * 64 + c * 4);
                nk4 = *(const f32x4*)(cur + 3072 + (s + 1) * 64 + c * 4); nr4 = *(const f32x4*)(cur + 4096 + (s + 1) * 64 + c * 4);
                nv = cur[vofs + (s + 1) * 16];
            }
            const f32x2 pp = S01 * kk4.xy + S23 * kk4.zw;
            float sa = pp.x + pp.y;
            if (s > 0) { float yq = prevq; dpp_sum16x2(sa, yq); ykeep = (c == s - 1) ? yq : ykeep; }
            else sa = dpp_sum16(sa);
            const f32x2 sa2 = (f32x2){sa, sa}, v2 = (f32x2){v, v};
            S01 = S01 * w4.xy + (v2 * k4.xy - sa2 * ka4.xy);
            S23 = S23 * w4.zw + (v2 * k4.zw - sa2 * ka4.zw);
            const f32x2 qq = S01 * r4.xy + S23 * r4.zw;
            prevq = qq.x + qq.y;
            __builtin_amdgcn_sched_barrier(0);
            w4 = nw4; kk4 = nkk4; ka4 = nka4; k4 = nk4; r4 = nr4; v = nv;
        }
        { const float yq = dpp_sum16(prevq); ykeep = (c == 15) ? yq : ykeep; }
        yb[c * 16 + wid * 4 + rl] = ykeep;
        if (ch + 1 < 128) {
            float* nx = L + ((ch + 1) & 1) * 5376;
            cvt_store8(nx + ldsA0, qa); cvt_store8(nx + ldsA1, qb); *(f32x4*)(nx + ldsW) = qw; if (ldv) cvt_store8(nx + ldsV, qv);
        }
        __syncthreads();
        if (mode != 2) a.yraw[(tokbase + (size_t)ch * 16 + (tid >> 4)) * 512 + colh + i0 + (tid & 15)] = yb[tid];
        else a.zbuf[((size_t)bl * 2048 + (size_t)ch * 16 + (tid >> 4)) * 512 + colh + i0 + (tid & 15)] = yb[tid];
    }
    if (mode == 0) *(f32x4*)(a.sfin + ((size_t)((bl * 8 + hh) * 64 + i0 + wid * 4 + rl)) * 64 + c * 4) = (f32x4){S01.x, S01.y, S23.x, S23.y};
}

__device__ __forceinline__ void attn_tile(char* smem, const bf16_t* __restrict__ Qh, const bf16_t* __restrict__ Kh, const bf16_t* __restrict__ Vt,
                                          const bf16_t* __restrict__ proj, bf16_t* __restrict__ ycat, int bl, int hh, int qt) {
    const int tid = otid(), lane = tid & 63, wid = tid >> 6, fr = lane & 15, fq = lane >> 4;
    const int q0 = qt * 128, tok0 = bl * 4096, qw0 = q0 + wid * 32;
    bf16x8 qf[2][3];
#pragma unroll
    for (int qi = 0; qi < 2; ++qi)
#pragma unroll
        for (int ks = 0; ks < 3; ++ks) qf[qi][ks] = *(const bf16x8*)(Qh + (size_t)(tok0 + qw0 + qi * 16 + fr) * 768 + hh * 96 + ks * 32 + fq * 8);
    f32x4 o[4][2];
#pragma unroll
    for (int i = 0; i < 4; ++i) { o[i][0] = (f32x4){0.f, 0.f, 0.f, 0.f}; o[i][1] = o[i][0]; }
    float m[2] = {-1e30f, -1e30f}, lsum[2] = {0.f, 0.f};
    const int nkv = 2 * (qt + 1);
    const bf16_t* Kb = Kh + (size_t)tok0 * 768 + hh * 96;
    const bf16_t* Vb = Vt + ((size_t)((bl * 8 + hh) * 64)) * 4096;
    int gK[3], lK[3];
#pragma unroll
    for (int i = 0; i < 3; ++i) { const int cid = tid + 256 * i, key = cid / 12, cc = cid - key * 12; gK[i] = key * 768 + cc * 8; lK[i] = key * 224 + cc * 16; }
    int gV[2], lV[2];
#pragma unroll
    for (int i = 0; i < 2; ++i) { const int cid = tid + 256 * i, dv = cid >> 3, cc = cid & 7; gV[i] = dv * 4096 + cc * 8; lV[i] = 14336 + dv * 144 + cc * 16; }
    u32x4 rkA[3], rvA[2], rkB[3], rvB[2];
#define ATT_LOAD(RK, RV, T) do { _Pragma("unroll") for (int i = 0; i < 3; ++i) RK[i] = *(const u32x4*)(Kb + (size_t)((T) * 64) * 768 + gK[i]); \
                                 _Pragma("unroll") for (int i = 0; i < 2; ++i) RV[i] = *(const u32x4*)(Vb + (T) * 64 + gV[i]); } while (0)
#define ATT_WRITE(RK, RV, BUF) do { _Pragma("unroll") for (int i = 0; i < 3; ++i) *(u32x4*)(smem + (BUF) * 23552 + lK[i]) = RK[i]; \
                                    _Pragma("unroll") for (int i = 0; i < 2; ++i) *(u32x4*)(smem + (BUF) * 23552 + lV[i]) = RV[i]; } while (0)
    ATT_LOAD(rkA, rvA, 0);
    ATT_WRITE(rkA, rvA, 0);
    ATT_LOAD(rkA, rvA, 1);
    __syncthreads();
    auto compute = [&](const int j, const char* cur) {
        const int kv0 = j * 64;
        if (kv0 <= qw0 + 31) {
            f32x4 s[4][2];
            {
                bf16x8 kf[4][3];
#pragma unroll
                for (int kt = 0; kt < 4; ++kt)
#pragma unroll
                    for (int ks = 0; ks < 3; ++ks) kf[kt][ks] = *(const bf16x8*)(cur + (kt * 16 + fr) * 224 + (ks * 4 + fq) * 16);
                __builtin_amdgcn_sched_barrier(0);
#pragma unroll
                for (int kt = 0; kt < 4; ++kt)
#pragma unroll
                    for (int qi = 0; qi < 2; ++qi) {
                        f32x4 acc = (f32x4){0.f, 0.f, 0.f, 0.f};
#pragma unroll
                        for (int ks = 0; ks < 3; ++ks) acc = __builtin_amdgcn_mfma_f32_16x16x32_bf16(kf[kt][ks], qf[qi][ks], acc, 0, 0, 0);
                        s[kt][qi] = acc;
                    }
                __builtin_amdgcn_sched_barrier(0);
            }
            bf16x8 vfr[4][2];
#pragma unroll
            for (int dvt = 0; dvt < 4; ++dvt)
#pragma unroll
                for (int kb = 0; kb < 2; ++kb) {
                    const char* vp = cur + 14336 + (dvt * 16 + fr) * 144 + kb * 64 + fq * 8;
                    const u32x2 lo = *(const u32x2*)vp, hi = *(const u32x2*)(vp + 32);
                    vfr[dvt][kb] = __builtin_bit_cast(bf16x8, ((u32x4){lo.x, lo.y, hi.x, hi.y}));
                }
            __builtin_amdgcn_sched_barrier(0);
            if (kv0 + 63 > qw0) {
#pragma unroll
                for (int kt = 0; kt < 4; ++kt)
#pragma unroll
                    for (int qi = 0; qi < 2; ++qi)
#pragma unroll
                        for (int jj = 0; jj < 4; ++jj) { const int kpos = kv0 + kt * 16 + fq * 4 + jj, qpos = qw0 + qi * 16 + fr; if (kpos > qpos) s[kt][qi][jj] = -1e30f; }
            }
#pragma unroll
            for (int qi = 0; qi < 2; ++qi) {
                float mx = -1e30f;
#pragma unroll
                for (int kt = 0; kt < 4; ++kt) mx = fmaxf(mx, fmaxf(fmaxf(s[kt][qi][0], s[kt][qi][1]), fmaxf(s[kt][qi][2], s[kt][qi][3])));
                mx = fmaxf(mx, __shfl_xor(mx, 16)); mx = fmaxf(mx, __shfl_xor(mx, 32));
                const float mnew = fmaxf(m[qi], mx), alpha = __builtin_amdgcn_exp2f(m[qi] - mnew);
                m[qi] = mnew;
                float rs = 0.f;
#pragma unroll
                for (int kt = 0; kt < 4; ++kt)
#pragma unroll
                    for (int jj = 0; jj < 4; ++jj) { const float pexp = __builtin_amdgcn_exp2f(s[kt][qi][jj] - mnew); s[kt][qi][jj] = pexp; rs += pexp; }
                lsum[qi] = lsum[qi] * alpha + rs;
#pragma unroll
                for (int dvt = 0; dvt < 4; ++dvt) o[dvt][qi] = o[dvt][qi] * alpha;
            }
            bf16x8 pf[2][2];
#pragma unroll
            for (int kb = 0; kb < 2; ++kb)
#pragma unroll
                for (int qi = 0; qi < 2; ++qi) {
                    u32x4 t;
                    t.x = pk_bf16(s[2 * kb][qi][0], s[2 * kb][qi][1]); t.y = pk_bf16(s[2 * kb][qi][2], s[2 * kb][qi][3]);
                    t.z = pk_bf16(s[2 * kb + 1][qi][0], s[2 * kb + 1][qi][1]); t.w = pk_bf16(s[2 * kb + 1][qi][2], s[2 * kb + 1][qi][3]);
                    pf[kb][qi] = __builtin_bit_cast(bf16x8, t);
                }
            __builtin_amdgcn_sched_barrier(0);
#pragma unroll
            for (int dvt = 0; dvt < 4; ++dvt)
#pragma unroll
                for (int kb = 0; kb < 2; ++kb)
#pragma unroll
                    for (int qi = 0; qi < 2; ++qi) o[dvt][qi] = __builtin_amdgcn_mfma_f32_16x16x32_bf16(vfr[dvt][kb], pf[kb][qi], o[dvt][qi], 0, 0, 0);
        }
    };
#pragma unroll 1
    for (int j = 0; j < nkv; j += 2) {
        if (j + 2 < nkv) ATT_LOAD(rkB, rvB, j + 2);
        compute(j, smem);
        ATT_WRITE(rkA, rvA, 1);
        __syncthreads();
        if (j + 3 < nkv) ATT_LOAD(rkA, rvA, j + 3);
        compute(j + 1, smem + 23552);
        if (j + 2 < nkv) ATT_WRITE(rkB, rvB, 0);
        __syncthreads();
    }
#undef ATT_LOAD
#undef ATT_WRITE
#pragma unroll
    for (int qi = 0; qi < 2; ++qi) {
        float lt = lsum[qi]; lt += __shfl_xor(lt, 16); lt += __shfl_xor(lt, 32);
        const float inv = 1.0f / lt;
        const int tl = tok0 + qw0 + qi * 16 + fr;
#pragma unroll
        for (int dvt = 0; dvt < 4; ++dvt) {
            const int dv = dvt * 16 + fq * 4;
            const u32x2 gu = *(const u32x2*)(proj + (size_t)tl * NP + O_GM + hh * 64 + dv);
            const f32x4 gg = (f32x4){bf_lo(gu.x), bf_hi(gu.x), bf_lo(gu.y), bf_hi(gu.y)};
            f32x4 r;
#pragma unroll
            for (int jj = 0; jj < 4; ++jj) r[jj] = o[dvt][qi][jj] * inv * siluf_(gg[jj]);
            store4(ycat + (size_t)tl * 1024 + 512 + hh * 64 + dv, r);
        }
    }
}

struct FinArgs { const float* yraw; const bf16_t *sr, *sk, *sv; const bf16_t* proj; const float *lnw, *lnb, *rk; bf16_t* ycat; const float* zbuf; const float* sfin; };
__device__ void rwkv_finalize(const FinArgs& a) {
    const int tid_ = otid(); const int lane = tid_ & 63, gw = blockIdx.x * 4 + (tid_ >> 6), nw = gridDim.x * 4;
    for (int u = gw; u < TH * 2; u += nw) {
        const int tl = u >> 1, ch = ((u & 1) * 4 + (lane >> 4)) * 64 + (lane & 15) * 4;
        f32x4 y = *(const f32x4*)(a.yraw + (size_t)tl * 512 + ch);
        const float mean = dpp_sum16(y.x + y.y + y.z + y.w) * (1.0f / 64.0f);
        const f32x4 d = y - mean;
        const float var = dpp_sum16(d.x * d.x + d.y * d.y + d.z * d.z + d.w * d.w) * (1.0f / 64.0f);
        const float rstd = rsqrtf(var + 64e-5f);
        const u32x2 ur = *(const u32x2*)(a.sr + (size_t)tl * 512 + ch), uk = *(const u32x2*)(a.sk + (size_t)tl * 512 + ch), uv = *(const u32x2*)(a.sv + (size_t)tl * 512 + ch);
        const f32x4 r4 = (f32x4){bf_lo(ur.x), bf_hi(ur.x), bf_lo(ur.y), bf_hi(ur.y)}, k4 = (f32x4){bf_lo(uk.x), bf_hi(uk.x), bf_lo(uk.y), bf_hi(uk.y)};
        const f32x4 v4 = (f32x4){bf_lo(uv.x), bf_hi(uv.x), bf_lo(uv.y), bf_hi(uv.y)};
        const f32x4 rkv = *(const f32x4*)(a.rk + ch), lw = *(const f32x4*)(a.lnw + ch), lb = *(const f32x4*)(a.lnb + ch);
        const f32x4 t = r4 * k4 * rkv;
        const float bon = dpp_sum16(t.x + t.y + t.z + t.w);
        const u32x2 gu = *(const u32x2*)(a.proj + (size_t)tl * NP + O_GR + ch);
        const f32x4 gg = (f32x4){bf_lo(gu.x), bf_hi(gu.x), bf_lo(gu.y), bf_hi(gu.y)};
        f32x4 o = d * rstd * lw + lb + v4 * bon;
#pragma unroll
        for (int j = 0; j < 4; ++j) o[j] *= siluf_(gg[j]);
        store4(a.ycat + (size_t)tl * 1024 + ch, o);
    }
}


struct CopArgs { const bf16_t *sr, *sk, *sv, *skk, *skka; const bf16_t* se; char* cops; };
__device__ __forceinline__ float mm16(const float* A, float sa, float ia, const float* B, float sb, float ib, int t, int j) {
    float acc = 0.f;
#pragma unroll
    for (int i = 0; i < 16; ++i) { const float av = sa * A[t * 17 + i] + (i == t ? ia : 0.f); const float bv = sb * B[i * 17 + j] + (i == j ? ib : 0.f); acc += av * bv; }
    return acc;
}
__device__ __forceinline__ float mm16p(const float* A, const float* B, int t, int j) {
    float acc = 0.f;
#pragma unroll
    for (int q = 0; q < 4; ++q) {
        const f32x4 a4 = *(const f32x4*)(A + t * 20 + q * 4);
        acc += a4.x * B[(q * 4 + 0) * 20 + j] + a4.y * B[(q * 4 + 1) * 20 + j] + a4.z * B[(q * 4 + 2) * 20 + j] + a4.w * B[(q * 4 + 3) * 20 + j];
    }
    return acc;
}
__device__ __forceinline__ f32x4 mm16m(const float* A, const float* B, int fr, int fq) {
    f32x4 acc = (f32x4){0.f, 0.f, 0.f, 0.f};
#pragma unroll
    for (int m = 0; m < 4; ++m) acc = __builtin_amdgcn_mfma_f32_16x16x4f32(A[fr * 20 + 4 * m + fq], B[(4 * m + fq) * 20 + fr], acc, 0, 0, 0);
    return acc;
}
__device__ __forceinline__ void mm16st(float* D, const f32x4 acc, int fr, int fq, float diag) {
#pragma unroll
    for (int jj = 0; jj < 4; ++jj) D[(4 * fq + jj) * 20 + fr] = acc[jj] + ((4 * fq + jj) == fr ? diag : 0.f);
}
__device__ __forceinline__ f32x4 unpk4(const u32x2 u) { return (f32x4){bf_lo(u.x), bf_hi(u.x), bf_lo(u.y), bf_hi(u.y)}; }
__device__ __forceinline__ bf16_t bf1(float x) { return (bf16_t)(pk_bf16(x, 0.f) & 0xffffu); }
struct CopIn { u32x2 ue, ukk, uka, uk, ur, uv; };
__device__ __forceinline__ void cop_in_load(CopIn& r, const CopArgs& a, int unit, int t, int cq) {
    const int c = unit & 255, bh = unit >> 8;
    const size_t gofs = ((size_t)(bh >> 3) * 4096 + c * 16 + t) * 512 + (bh & 7) * 64 + cq * 4;
    r.ue = *(const u32x2*)(a.se + gofs);
    r.ukk = *(const u32x2*)(a.skk + gofs); r.uka = *(const u32x2*)(a.skka + gofs); r.uk = *(const u32x2*)(a.sk + gofs); r.ur = *(const u32x2*)(a.sr + gofs); r.uv = *(const u32x2*)(a.sv + gofs);
}
__device__ void cop_phase(char* smem, const CopArgs& a) {
    const int tid = otid(), t = tid >> 4, cq = tid & 15, j = cq;
    float* F = (float*)smem;
    float* Wc = F; float* KAP = F + 1088; float* RT = F + 2176; float* KT = F + 3264; float* BT = F + 4352;
    float* SM = F + 5440;
    bf16_t* STG = (bf16_t*)(F + 5440 + 15 * 320);
#define SMAT(i) (SM + (i) * 320)
    int unit = blockIdx.x;
    if (unit >= 8192) return;
    CopIn cur, nxt;
    cop_in_load(cur, a, unit, t, cq);
    nxt = cur;
#pragma unroll 1
    for (; unit < 8192; unit += gridDim.x) {
        if (unit + (int)gridDim.x < 8192) cop_in_load(nxt, a, unit + gridDim.x, t, cq);
        __syncthreads();
        *(f32x4*)(Wc + t * 68 + cq * 4) = unpk4(cur.ue);
        __syncthreads();
        if (tid < 64) {
            float x[16];
#pragma unroll
            for (int i = 0; i < 16; ++i) x[i] = Wc[i * 68 + tid];
#pragma unroll
            for (int i = 1; i < 16; ++i) x[i] += x[i - 1];
#pragma unroll
            for (int i = 0; i < 16; ++i) Wc[i * 68 + tid] = x[i];
        }
        __syncthreads();
        const f32x4 ct = *(const f32x4*)(Wc + t * 68 + cq * 4), cC = *(const f32x4*)(Wc + 15 * 68 + cq * 4);
        f32x4 cp = (f32x4){0.f, 0.f, 0.f, 0.f}; if (t > 0) cp = *(const f32x4*)(Wc + (t - 1) * 68 + cq * 4);
        const f32x4 Wt = (f32x4){__expf(-ct.x), __expf(-ct.y), __expf(-ct.z), __expf(-ct.w)}, Wp = (f32x4){__expf(-cp.x), __expf(-cp.y), __expf(-cp.z), __expf(-cp.w)};
        const f32x4 WC = (f32x4){__expf(-cC.x), __expf(-cC.y), __expf(-cC.z), __expf(-cC.w)};
        {
            const f32x4 rW = (f32x4){__expf(ct.x), __expf(ct.y), __expf(ct.z), __expf(ct.w)};
            *(f32x4*)(KAP + t * 68 + cq * 4) = unpk4(cur.ukk) * Wp;
            *(f32x4*)(RT + t * 68 + cq * 4) = unpk4(cur.ur) * Wt;
            *(f32x4*)(KT + t * 68 + cq * 4) = unpk4(cur.uk) * rW;
            *(f32x4*)(BT + t * 68 + cq * 4) = unpk4(cur.uka) * rW;
        }
        __syncthreads();
        {
            const int wv = tid >> 6, ln = tid & 63, gfr = ln & 15, gfq = ln >> 4;
            const float* X = (wv < 2 ? KAP : RT) + gfr * 68 + gfq * 16;
            const float* Y = ((wv & 1) ? BT : KT) + gfr * 68 + gfq * 16;
            f32x4 acc = (f32x4){0.f, 0.f, 0.f, 0.f};
#pragma unroll
            for (int q = 0; q < 4; ++q) {
                const f32x4 xa = *(const f32x4*)(X + q * 4), ya = *(const f32x4*)(Y + q * 4);
                acc = __builtin_amdgcn_mfma_f32_16x16x4f32(xa.x, ya.x, acc, 0, 0, 0);
                acc = __builtin_amdgcn_mfma_f32_16x16x4f32(xa.y, ya.y, acc, 0, 0, 0);
                acc = __builtin_amdgcn_mfma_f32_16x16x4f32(xa.z, ya.z, acc, 0, 0, 0);
                acc = __builtin_amdgcn_mfma_f32_16x16x4f32(xa.w, ya.w, acc, 0, 0, 0);
            }
#pragma unroll
            for (int jj = 0; jj < 4; ++jj) {
                const int tt = gfq * 4 + jj, jc = gfr;
                const float v = (wv < 2 ? jc < tt : jc <= tt) ? acc[jj] : 0.f;
                SMAT(wv)[tt * 20 + jc] = v;
                if (wv == 1) SMAT(12)[tt * 20 + jc] = (tt == jc ? 1.f : 0.f) - v;
            }
        }
        __syncthreads();
        {
            const int wv = tid >> 6, ln = tid & 63, mfr = ln & 15, mfq = ln >> 4;
            if (wv == 0) { const f32x4 v = mm16m(SMAT(1), SMAT(1), mfr, mfq); mm16st(SMAT(4), v, mfr, mfq, 0.f); mm16st(SMAT(13), v, mfr, mfq, 1.f); }
            __syncthreads();
            if (wv == 0) { const f32x4 v = mm16m(SMAT(4), SMAT(4), mfr, mfq); mm16st(SMAT(5), v, mfr, mfq, 0.f); mm16st(SMAT(14), v, mfr, mfq, 1.f); }
            else if (wv == 1) mm16st(SMAT(7), mm16m(SMAT(12), SMAT(13), mfr, mfq), mfr, mfq, 0.f);
            __syncthreads();
            if (wv == 0) mm16st(SMAT(6), mm16m(SMAT(5), SMAT(5), mfr, mfq), mfr, mfq, 1.f);
            else if (wv == 1) mm16st(SMAT(8), mm16m(SMAT(7), SMAT(14), mfr, mfq), mfr, mfq, 0.f);
            __syncthreads();
            if (wv == 0) mm16st(SMAT(9), mm16m(SMAT(8), SMAT(6), mfr, mfq), mfr, mfq, 0.f);
            __syncthreads();
            if (wv == 0) mm16st(SMAT(10), mm16m(SMAT(9), SMAT(0), mfr, mfq), mfr, mfq, 0.f);
            else if (wv == 1) mm16st(SMAT(11), mm16m(SMAT(3), SMAT(9), mfr, mfq), mfr, mfq, 0.f);
            __syncthreads();
        }
        char* U = a.cops + (size_t)unit * COP_STRIDE;
        if (tid < 64) {
            const int mfr = tid & 15, mfq = tid >> 4; const f32x4 v = mm16m(SMAT(11), SMAT(0), mfr, mfq);
#pragma unroll
            for (int jj = 0; jj < 4; ++jj) ((bf16_t*)(U + 4096))[(4 * mfq + jj) * 16 + mfr] = bf1(SMAT(2)[(4 * mfq + jj) * 20 + mfr] - v[jj]);
        }
        f32x4 q3 = (f32x4){0.f, 0.f, 0.f, 0.f}, q1 = *(const f32x4*)(RT + t * 68 + cq * 4), kh = *(const f32x4*)(KT + t * 68 + cq * 4);
#pragma unroll 4
        for (int i = 0; i < 16; ++i) {
            const f32x4 kap = *(const f32x4*)(KAP + i * 68 + cq * 4), bt = *(const f32x4*)(BT + i * 68 + cq * 4);
            q3 += kap * SMAT(9)[t * 20 + i]; q1 -= kap * SMAT(11)[t * 20 + i]; kh -= bt * SMAT(10)[i * 20 + t];
        }
        kh = kh * WC;
        const f32x4 bhv = *(const f32x4*)(BT + t * 68 + cq * 4) * WC;
        const int p0 = 32 * (cq >> 3) + 8 * (cq & 3) + 4 * ((cq >> 2) & 1);
        store4((bf16_t*)U + t * 64 + p0, q3);
        store4((bf16_t*)U + (16 + t) * 64 + p0, q1);
        const int so = (t >> 2) * 8 + (t & 3);
#pragma unroll
        for (int jj = 0; jj < 4; ++jj) { STG[(cq * 4 + jj) * 32 + so] = bf1(bhv[jj]); STG[(cq * 4 + jj) * 32 + so + 4] = bf1(kh[jj]); }
        STG[2048 + (cq * 4 + 0) * 16 + t] = (bf16_t)(cur.uv.x & 0xffffu); STG[2048 + (cq * 4 + 1) * 16 + t] = (bf16_t)(cur.uv.x >> 16);
        STG[2048 + (cq * 4 + 2) * 16 + t] = (bf16_t)(cur.uv.y & 0xffffu); STG[2048 + (cq * 4 + 3) * 16 + t] = (bf16_t)(cur.uv.y >> 16);
        if (tid < 64) ((float*)(U + 10752))[tid] = __expf(-Wc[15 * 68 + tid]);
        __syncthreads();
        *(u32x4*)(U + 4608 + tid * 16) = *(const u32x4*)((const char*)STG + tid * 16);
        if (tid < 128) *(u32x4*)(U + 8704 + tid * 16) = *(const u32x4*)((const char*)STG + 4096 + tid * 16);
        cur = nxt;
    }
#undef SMAT
}

__device__ __forceinline__ int cop_lds_of(int q) {
    if (q < 256) { const int row = q >> 3, pos = q & 7; return row * 128 + ((pos ^ ((row >> 1) & 7)) << 4); }
    if (q < 288) return q * 16;
    if (q < 544) { const int q2 = q - 288; return 4608 + (q2 & 3) * 1024 + (q2 >> 2) * 16; }
    return q * 16;
}
struct CopOps { u32x4 qc[2][2]; u32x2 q2; u32x4 bk[4]; u32x2 vt; f32x4 wc[4]; };
__device__ void chunk_scan(char* smem, const char* cops, float* yraw, int bl, int hh) {
    const int tid = otid(), lane = tid & 63, w = tid >> 6, fr = lane & 15, fq = lane >> 4;
    f32x4 st[4];
#pragma unroll
    for (int kt = 0; kt < 4; ++kt) st[kt] = (f32x4){0.f, 0.f, 0.f, 0.f};
    const char* U = cops + (size_t)((bl * 8 + hh) * 256) * COP_STRIDE + tid * 16;
    float* yp = yraw + ((size_t)bl * 4096 + fq * 4) * 512 + hh * 64 + w * 16 + fr;
    const int l0 = cop_lds_of(tid), l1 = cop_lds_of(tid + 256), l2 = cop_lds_of(tid < 176 ? tid + 512 : 0);
    const bool has2 = tid < 176;
    const int qo0 = fr * 128 + (((0 * 4 + fq) ^ ((fr >> 1) & 7)) << 4), qo1 = fr * 128 + (((1 * 4 + fq) ^ ((fr >> 1) & 7)) << 4);
    const int q2o = 4096 + fr * 32 + fq * 8, bko = 4608 + fq * 1024 + fr * 16, vto = 8704 + (w * 16 + fr) * 32 + fq * 8, wco = 10752 + fq * 16;
    u32x4 sA[3], sB[3], sC[3], sD[3];
    __builtin_amdgcn_s_setprio(3);
#define CS_LOAD(S, C) do { const char* g_ = U + (size_t)(C) * COP_STRIDE; S[0] = *(const u32x4*)g_; S[1] = *(const u32x4*)(g_ + 4096); if (has2) S[2] = *(const u32x4*)(g_ + 8192); } while (0)
#define CS_WRITE(S, SLOT) do { char* d_ = smem + (SLOT) * 11008; *(u32x4*)(d_ + l0) = S[0]; *(u32x4*)(d_ + l1) = S[1]; if (has2) *(u32x4*)(d_ + l2) = S[2]; } while (0)
    sA[2] = (u32x4){0u, 0u, 0u, 0u}; sB[2] = sA[2]; sC[2] = sA[2]; sD[2] = sA[2];
    CS_LOAD(sA, 0); CS_LOAD(sB, 1); CS_LOAD(sC, 2); CS_LOAD(sD, 3);
    CopOps R0, R1;
    auto ldsload = [&](CopOps& r, const char* L) {
        r.qc[0][0] = *(const u32x4*)(L + qo0); r.qc[0][1] = *(const u32x4*)(L + qo1); r.qc[1][0] = *(const u32x4*)(L + 2048 + qo0); r.qc[1][1] = *(const u32x4*)(L + 2048 + qo1);
        r.q2 = *(const u32x2*)(L + q2o); r.vt = *(const u32x2*)(L + vto);
#pragma unroll
        for (int kt = 0; kt < 4; ++kt) { r.bk[kt] = *(const u32x4*)(L + bko + kt * 256); r.wc[kt] = *(const f32x4*)(L + wco + kt * 64); }
    };
    auto compute = [&](const int c, const CopOps& r) {
        const u32x4 (&qc)[2][2] = r.qc; const u32x4 (&bk)[4] = r.bk; const f32x4 (&wc)[4] = r.wc; const u32x2 q2 = r.q2, vt = r.vt;
        u32x4 hi[2], lo[2];
#pragma unroll
        for (int s = 0; s < 2; ++s) {
            const f32x4 a0 = st[2 * s], a1 = st[2 * s + 1];
            hi[s].x = pk_bf16(a0.x, a0.y); hi[s].y = pk_bf16(a0.z, a0.w); hi[s].z = pk_bf16(a1.x, a1.y); hi[s].w = pk_bf16(a1.z, a1.w);
            lo[s].x = pk_bf16(a0.x - bf_lo(hi[s].x), a0.y - bf_hi(hi[s].x)); lo[s].y = pk_bf16(a0.z - bf_lo(hi[s].y), a0.w - bf_hi(hi[s].y));
            lo[s].z = pk_bf16(a1.x - bf_lo(hi[s].z), a1.y - bf_hi(hi[s].z)); lo[s].w = pk_bf16(a1.z - bf_lo(hi[s].w), a1.w - bf_hi(hi[s].w));
        }
        f32x4 p1 = (f32x4){0.f, 0.f, 0.f, 0.f}, p2 = p1;
#pragma unroll
        for (int s = 0; s < 2; ++s) {
            p1 = __builtin_amdgcn_mfma_f32_16x16x32_bf16(__builtin_bit_cast(bf16x8, qc[0][s]), __builtin_bit_cast(bf16x8, hi[s]), p1, 0, 0, 0);
            p2 = __builtin_amdgcn_mfma_f32_16x16x32_bf16(__builtin_bit_cast(bf16x8, qc[1][s]), __builtin_bit_cast(bf16x8, hi[s]), p2, 0, 0, 0);
            p1 = __builtin_amdgcn_mfma_f32_16x16x32_bf16(__builtin_bit_cast(bf16x8, qc[0][s]), __builtin_bit_cast(bf16x8, lo[s]), p1, 0, 0, 0);
            p2 = __builtin_amdgcn_mfma_f32_16x16x32_bf16(__builtin_bit_cast(bf16x8, qc[1][s]), __builtin_bit_cast(bf16x8, lo[s]), p2, 0, 0, 0);
        }
        p2 = __builtin_amdgcn_mfma_f32_16x16x32_bf16(__builtin_bit_cast(bf16x8, ((u32x4){q2.x, q2.y, 0u, 0u})), __builtin_bit_cast(bf16x8, ((u32x4){vt.x, vt.y, 0u, 0u})), p2, 0, 0, 0);
#pragma unroll
        for (int j = 0; j < 4; ++j) yp[(size_t)(c * 16 + j) * 512] = p2[j];
        u32x4 xh, xl;
        xh.x = pk_bf16(-p1.x, -p1.y); xh.y = pk_bf16(-p1.z, -p1.w); xh.z = vt.x; xh.w = vt.y;
        xl.x = pk_bf16(-p1.x - bf_lo(xh.x), -p1.y - bf_hi(xh.x)); xl.y = pk_bf16(-p1.z - bf_lo(xh.y), -p1.w - bf_hi(xh.y)); xl.z = 0u; xl.w = 0u;
#pragma unroll
        for (int kt = 0; kt < 4; ++kt) {
            f32x4 acc = st[kt] * wc[kt];
            acc = __builtin_amdgcn_mfma_f32_16x16x32_bf16(__builtin_bit_cast(bf16x8, bk[kt]), __builtin_bit_cast(bf16x8, xh), acc, 0, 0, 0);
            acc = __builtin_amdgcn_mfma_f32_16x16x32_bf16(__builtin_bit_cast(bf16x8, bk[kt]), __builtin_bit_cast(bf16x8, xl), acc, 0, 0, 0);
            st[kt] = acc;
        }
    };
    CS_WRITE(sA, 0); CS_LOAD(sA, 4);
    __syncthreads();
    ldsload(R0, smem);
#define CS_STEP(S, C, RC, RN) do { if ((C) + 1 < 256) CS_WRITE(S, ((C) + 1) & 1); if ((C) + 5 < 256) CS_LOAD(S, (C) + 5); __syncthreads(); \
        if ((C) + 1 < 256) ldsload(RN, smem + (((C) + 1) & 1) * 11008); compute((C), RC); } while (0)
#pragma unroll 1
    for (int c = 0; c < 256; c += 4) { CS_STEP(sB, c, R0, R1); CS_STEP(sC, c + 1, R1, R0); CS_STEP(sD, c + 2, R0, R1); CS_STEP(sA, c + 3, R1, R0); }
#undef CS_STEP
#undef CS_LOAD
#undef CS_WRITE
    __builtin_amdgcn_s_setprio(0);
    __syncthreads();
}

__global__ void __launch_bounds__(256, 2) fwd_megakernel(Params p) {
    __shared__ __attribute__((aligned(16))) char smem[65536 + 64];
    cg::grid_group grid = cg::this_grid();
    if (threadIdx.x == 0) { ((volatile LAS unsigned*)(smem + 65536))[0] = 0u; ((volatile LAS unsigned*)(smem + 65536))[1] = 0u; }
    __syncthreads();
    const XcdBarrier xb = xcd_barrier_post((unsigned*)(p.ws + OFF_BAR), (volatile LAS unsigned*)(smem + 65536));
    const unsigned cu_key = (xb.x & 7u) * 256u + ((unsigned)__builtin_amdgcn_s_getreg((7 << 11) | (8 << 6) | 4) & 0xffu);
    if (threadIdx.x == 0) (void)xb_add((unsigned*)(p.ws + OFF_CUCNT) + cu_key, 1u);
    char* ws = p.ws;
    float* mod = (float*)(ws + OFF_MOD);
    const float* cs = (const float*)(ws + OFF_COS); const float* sn = (const float*)(ws + OFF_SIN);
    bf16_t* hbuf = (bf16_t*)(ws + OFF_H);
    bf16_t* proj = (bf16_t*)(ws + OFF_PROJ);
    bf16_t *sr = (bf16_t*)(ws + OFF_SR), *sk = (bf16_t*)(ws + OFF_SK), *sv = (bf16_t*)(ws + OFF_SV), *skk = (bf16_t*)(ws + OFF_SKK), *skka = (bf16_t*)(ws + OFF_SKKA);
    bf16_t* se = (bf16_t*)(ws + OFF_SW);
    float *rsq = (float*)(ws + OFF_RSQ), *rskv = (float*)(ws + OFF_RSKV);
    bf16_t *Qh = (bf16_t*)(ws + OFF_Q), *Kh = (bf16_t*)(ws + OFF_K), *Vt = (bf16_t*)(ws + OFF_VT);
    float* yraw = (float*)(ws + OFF_YRAW);
    bf16_t* ycat = (bf16_t*)(ws + OFF_YCAT);
    bf16_t* vfirst = (bf16_t*)(ws + OFF_VFIRST);
    int* ctrl = (int*)(ws + OFF_CTRL);
    volatile int* s_item = (volatile int*)(smem + 65536 + 16);

    for (int rep = 0; rep < REP_P0; ++rep) prologue(smem, p);
    grid.sync();
    bool scan_role;
    {
        const unsigned k2 = (cu_key & ~255u) + threadIdx.x;
        const int lidx = __syncthreads_count(k2 < cu_key && xb_ld((unsigned*)(p.ws + OFF_CUCNT) + k2) > 0u);
        scan_role = lidx < 24;
    }

    norm_phase(p.x, p.norm_g, mod, hbuf, 0);
    GSYNC();
#pragma unroll 1
    for (int l = 0; l < NL; ++l) {
        const float* modl = mod + (size_t)l * 8 * 3072;
#pragma unroll 1
        for (int half = 0; half < 2; ++half) {
            const int tgbase = half * TH;
            {
                EpiProj e{proj, rsq, rskv, smem};
                const bf16_t* A = hbuf; const bf16_t* Bt = (const bf16_t*)(ws + OFF_WIN) + (size_t)l * NP * 1024;
                const int xcd = blockIdx.x & 7, loc = blockIdx.x >> 3, nloc = gridDim.x >> 3;
                for (int rep = 0; rep < REP_P2; ++rep) {
                if (rep) xcd_barrier(xb);
                for (int jn = loc; jn < 432; jn += nloc) {
                    const int mg = jn / 216, rem = jn - mg * 216, nt = rem >> 3, mi = rem & 7, mt = xcd * 16 + mg * 8 + mi;
                    gemm_tile(smem, A, 1024, Bt, 1024, 1024, mt * 128, nt * 128, e);
                }
                }
            }
            GSYNC();
            {
                PrepArgs pa;
                pa.proj = proj; pa.mu = p.mu_shift + l * 1664; pa.muv = p.mu_vmix + (l > 0 ? (l - 1) * 32 : 0);
                pa.wdec = (const bf16_t*)(ws + OFF_WDEC) + (size_t)l * 512 * 64; pa.wicl = (const bf16_t*)(ws + OFF_WICL) + (size_t)l * 512 * 64;
                pa.wvm = (const bf16_t*)(ws + OFF_WVM) + (size_t)l * 512 * 32;
                pa.w0 = p.w0 + l * 512; pa.a0 = p.a0 + l * 512; pa.v0 = p.v0 + (l > 0 ? (l - 1) * 512 : 0); pa.k_k = p.k_k + l * 512; pa.k_a = p.k_a + l * 512;
                pa.cs = cs; pa.sn = sn; pa.sr = sr; pa.sk = sk; pa.sv = sv; pa.skk = skk; pa.skka = skka; pa.se = se; pa.vfirst = vfirst; pa.Kh = Kh;
                pa.layer = l; pa.tgbase = tgbase;
                EpiKV ekv{Kh, Vt, rskv, smem};
                EpiQ eq{Qh, rsq, cs, sn, tgbase, smem};
                const bf16_t* Bkv = (const bf16_t*)(ws + OFF_WUKV) + (size_t)l * 1024 * 256; const bf16_t* Bq = (const bf16_t*)(ws + OFF_WUQ) + (size_t)l * 768 * 384;
                for (int rep = 0; rep < REP_P3; ++rep) {
                if (rep) xcd_barrier(xb);
                {
                    for (int it = blockIdx.x; it < 1024; it += gridDim.x) prep_tile(smem, pa, it >> 2, it & 3);
                    const int xcd = blockIdx.x & 7, loc = blockIdx.x >> 3, nloc = gridDim.x >> 3;
                    for (int j = loc; j < 128; j += nloc) gemm_tile(smem, proj + O_CKV, NP, Bkv, 256, 256, (xcd * 16 + (j >> 3)) * 128, (j & 7) * 128, ekv);
                    for (int j = loc; j < 96; j += nloc) { const int ml = j / 6, nt = j - ml * 6; gemm_tile(smem, proj + O_CQ, NP, Bq, 384, 384, (xcd * 16 + ml) * 128, nt * 128, eq); }
                }
                }
            }
            GSYNC();
            {
                CopArgs ca{sr, sk, sv, skk, skka, se, ws + OFF_COPS};
                cop_phase(smem, ca);
            }
            GSYNC();
            {
                int* ctr = ctrl + (l * 2 + half);
                for (;;) {
                    __syncthreads();
                    if (threadIdx.x == 0) *s_item = atomicAdd(ctr, 1);
                    __syncthreads();
                    const int item = *s_item;
                    const int nconv = (half == 0 && l + 1 < NL) ? 512 : 0;
                    if (item >= 32 + 1024 + nconv) break;
                    if (item < 32) chunk_scan(smem, ws + OFF_COPS, yraw, item >> 3, item & 7);
                    else if (item < 32 + 1024) { const int t = item - 32, qt = 31 - (t >> 5), bh = t & 31; attn_tile(smem, Qh, Kh, Vt, proj, ycat, bh >> 3, bh & 7, qt); }
                    else convert_layer(smem, p, l + 1, item - (32 + 1024), 512);
                }
            }
            GSYNC();
            {
                FinArgs fa{yraw, sr, sk, sv, proj, p.lnx_w + l * 512, p.lnx_b + l * 512, p.r_k + l * 512, ycat, nullptr, nullptr};
                for (int rep = 0; rep < REP_P5; ++rep) { if (rep) xcd_barrier(xb); rwkv_finalize(fa); }
                const int ln = half == 0 ? l : l + 1, hn = half ^ 1;
                if (ln < NL) norm_phase(ln == 0 ? p.x : p.out, p.norm_g + ln * 1024, mod + (size_t)ln * 8 * 3072, hbuf, hn * TH);
            }
            GSYNC();
            {
                for (int rep = 0; rep < REP_P6; ++rep) {
                if (rep) xcd_barrier(xb);
                EpiOut eo{l == 0 ? p.x : p.out, p.out, modl, tgbase, rep == REP_P6 - 1 ? 1.0f : 0.0f};
                const bf16_t* Bo = (const bf16_t*)(ws + OFF_WOUT) + (size_t)l * 1024 * 1024;
                {
                    const int xcd = blockIdx.x & 7, loc = blockIdx.x >> 3, nloc = gridDim.x >> 3;
                    for (int j = loc; j < 128; j += nloc) gemm_tile(smem, ycat, 1024, Bo, 1024, 1024, (xcd * 16 + (j >> 3)) * 128, (j & 7) * 128, eo);
                }
                }
            }
        }
    }
    GSYNC();
    final_norm(p.out, p.final_g);
}

extern "C" void kernel_launch(void* const* d_in, const int* in_sizes, int n_in, void* d_out, int out_size, void* d_ws, size_t ws_size, hipStream_t stream) {
    static int grid_blocks = 0;
    if (!grid_blocks) {
        int dev = 0, cus = 0, per_cu = 0;
        (void)hipGetDevice(&dev);
        (void)hipDeviceGetAttribute(&cus, hipDeviceAttributeMultiprocessorCount, dev);
        (void)hipOccupancyMaxActiveBlocksPerMultiprocessor(&per_cu, fwd_megakernel, 256, 0);
        if (per_cu > 2) per_cu = 2;
        if (per_cu < 1) per_cu = 1;
        grid_blocks = cus * per_cu;
        if (grid_blocks % 8) grid_blocks -= grid_blocks % 8;
    }
    Params p{};
    p.x = (const float*)d_in[0]; p.c = (const float*)d_in[1]; p.pos = (const int*)d_in[2];
    p.norm_g = (const float*)d_in[3]; p.w_ada = (const float*)d_in[4]; p.b_ada = (const float*)d_in[5]; p.w_in = (const float*)d_in[6];
    p.w_vmd = (const float*)d_in[7]; p.mu_shift = (const float*)d_in[8]; p.mu_vmix = (const float*)d_in[9]; p.w0 = (const float*)d_in[10];
    p.w_dec = (const float*)d_in[11]; p.a0 = (const float*)d_in[12]; p.w_icl = (const float*)d_in[13]; p.v0 = (const float*)d_in[14];
    p.w_vmu = (const float*)d_in[15]; p.k_k = (const float*)d_in[16]; p.k_a = (const float*)d_in[17]; p.r_k = (const float*)d_in[18];
    p.lnx_w = (const float*)d_in[19]; p.lnx_b = (const float*)d_in[20]; p.qng = (const float*)d_in[21]; p.kvng = (const float*)d_in[22];
    p.w_uq = (const float*)d_in[23]; p.w_ukv = (const float*)d_in[24]; p.w_out = (const float*)d_in[25]; p.final_g = (const float*)d_in[26];
    p.out = (float*)d_out; p.ws = (char*)d_ws;
    (void)hipMemsetAsync((char*)d_ws + OFF_BAR, 0, 16384 + 4096 + 8192, stream);
    void* args[] = {&p};
    hipError_t e = hipLaunchCooperativeKernel((void*)fwd_megakernel, dim3(grid_blocks), dim3(256), args, 0, stream);
    if (e != hipSuccess) fprintf(stderr, "cooperative launch failed: %s (grid %d)\n", hipGetErrorString(e), grid_blocks);
}
```

```cpp
#include <hip/hip_runtime.h>
#include <hip/hip_cooperative_groups.h>
#include <cstdio>
#include <cstdint>
namespace cg = cooperative_groups;
constexpr int REP_P1 = 1, REP_P2 = 1, REP_P3 = 1, REP_P4 = 1, REP_P5 = 1, REP_P6 = 1, REP_SYNC = 1, REP_P0 = 1;
#define GSYNC() do { for (int r_ = 0; r_ < REP_SYNC; ++r_) xcd_barrier(xb); } while (0)


typedef unsigned short bf16_t;
typedef short bf16x8 __attribute__((ext_vector_type(8)));
typedef float f32x4 __attribute__((ext_vector_type(4)));
typedef float f32x2 __attribute__((ext_vector_type(2)));
typedef unsigned u32x4 __attribute__((ext_vector_type(4)));
typedef unsigned u32x2 __attribute__((ext_vector_type(2)));
#define LAS __attribute__((address_space(3)))

constexpr int DM = 1024, NB = 8, SEQ = 4096, NT = NB * SEQ, TH = NT / 2, NL = 4;
constexpr int NP = 3456;
constexpr int O_GR = 1664, O_CQ = 2176, O_CKV = 2560, O_KR = 2816, O_GM = 2848, INW = 3360;
constexpr float QSCALE = 0.10206207261596577f * 1.4426950408889634f;

constexpr size_t al256(size_t x) { return (x + 255) & ~(size_t)255; }
constexpr size_t OFF_BAR = 0;
constexpr size_t OFF_CTRL = 16384;
constexpr size_t OFF_CUCNT = 16384 + 4096;
constexpr size_t OFF_MOD = 16384 + 4096 + 8192;
constexpr size_t OFF_COS = OFF_MOD + al256((size_t)NL * NB * 3072 * 4);
constexpr size_t OFF_SIN = OFF_COS + (size_t)NT * 16 * 4;
constexpr size_t OFF_WIN = OFF_SIN + (size_t)NT * 16 * 4;
constexpr size_t OFF_WOUT = OFF_WIN + (size_t)NL * NP * 1024 * 2;
constexpr size_t OFF_WUQ = OFF_WOUT + (size_t)NL * 1024 * 1024 * 2;
constexpr size_t OFF_WUKV = OFF_WUQ + (size_t)NL * 768 * 384 * 2;
constexpr size_t OFF_WDEC = OFF_WUKV + (size_t)NL * 1024 * 256 * 2;
constexpr size_t OFF_WICL = OFF_WDEC + (size_t)NL * 512 * 64 * 2;
constexpr size_t OFF_WVM = OFF_WICL + (size_t)NL * 512 * 64 * 2;
constexpr size_t OFF_VFIRST = OFF_WVM + (size_t)NL * 512 * 32 * 2;
constexpr size_t OFF_H = OFF_VFIRST + (size_t)NT * 512 * 2;
constexpr int COP_STRIDE = 11008;
constexpr size_t OFF_COPS = OFF_H;
constexpr size_t OFF_PROJ = OFF_H + (size_t)8192 * COP_STRIDE;
constexpr size_t OFF_SR = OFF_PROJ + (size_t)TH * NP * 2;
constexpr size_t OFF_SK = OFF_SR + (size_t)TH * 512 * 2;
constexpr size_t OFF_SV = OFF_SK + (size_t)TH * 512 * 2;
constexpr size_t OFF_SKK = OFF_SV + (size_t)TH * 512 * 2;
constexpr size_t OFF_SKKA = OFF_SKK + (size_t)TH * 512 * 2;
constexpr size_t OFF_SW = OFF_SKKA + (size_t)TH * 512 * 2;
constexpr size_t OFF_RSQ = OFF_SW + (size_t)TH * 512 * 4;
constexpr size_t OFF_RSKV = OFF_RSQ + (size_t)TH * 8 * 4;
constexpr size_t OFF_Q = OFF_RSKV + (size_t)TH * 4 * 4;
constexpr size_t OFF_K = OFF_Q + (size_t)TH * 768 * 2;
constexpr size_t OFF_VT = OFF_K + (size_t)TH * 768 * 2;
constexpr size_t OFF_YRAW = OFF_VT + (size_t)TH * 512 * 2;
constexpr size_t OFF_YCAT = OFF_YRAW + (size_t)TH * 512 * 4;
constexpr size_t WS_TOTAL = OFF_YCAT + (size_t)TH * 1024 * 2;
static_assert(WS_TOTAL <= (size_t)536870912, "workspace exceeds 512 MiB");

struct Params {
    const float *x, *c; const int* pos;
    const float *norm_g, *w_ada, *b_ada, *w_in, *w_vmd, *mu_shift, *mu_vmix, *w0, *w_dec, *a0, *w_icl, *v0, *w_vmu;
    const float *k_k, *k_a, *r_k, *lnx_w, *lnx_b, *qng, *kvng, *w_uq, *w_ukv, *w_out, *final_g;
    float* out; char* ws;
};

__device__ __forceinline__ int otid() { int t = threadIdx.x; asm volatile("" : "+v"(t)); return t; }
__device__ __forceinline__ unsigned pk_bf16(float lo, float hi) { unsigned r; asm("v_cvt_pk_bf16_f32 %0, %1, %2" : "=v"(r) : "v"(lo), "v"(hi)); return r; }
__device__ __forceinline__ float bf_lo(unsigned u) { return __uint_as_float(u << 16); }
__device__ __forceinline__ float bf_hi(unsigned u) { return __uint_as_float(u & 0xffff0000u); }
__device__ __forceinline__ float sigmoidf_(float x) { return 1.0f / (1.0f + __expf(-x)); }
__device__ __forceinline__ float siluf_(float x) { return x / (1.0f + __expf(-x)); }
__device__ __forceinline__ float tanhf_(float x) { const float t = __expf(2.0f * x); return 1.0f - 2.0f / (t + 1.0f); }
template <int CTRL> __device__ __forceinline__ float dpp_add(float x) {
    return x + __int_as_float(__builtin_amdgcn_update_dpp(0, __float_as_int(x), CTRL, 0xf, 0xf, true));
}
__device__ __forceinline__ float dpp_sum16(float x) {
    x = dpp_add<0xB1>(x);
    x = dpp_add<0x4E>(x);
    x = dpp_add<0x141>(x);
    x = dpp_add<0x140>(x);
    return x;
}
__device__ __forceinline__ void dpp_sum16x2(float& a, float& b) {
    a = dpp_add<0xB1>(a); b = dpp_add<0xB1>(b);
    a = dpp_add<0x4E>(a); b = dpp_add<0x4E>(b);
    a = dpp_add<0x141>(a); b = dpp_add<0x141>(b);
    a = dpp_add<0x140>(a); b = dpp_add<0x140>(b);
}
__device__ __forceinline__ float wave_sum64(float x) {
    x += __shfl_xor(x, 1); x += __shfl_xor(x, 2); x += __shfl_xor(x, 4); x += __shfl_xor(x, 8); x += __shfl_xor(x, 16); x += __shfl_xor(x, 32);
    return x;
}


#define XB_TMO      128
#define XB_XCNT(j)  (256  + 64 * (j))
#define XB_XSUB(j)  (1280 + 64 * (j))
#define XB_XGEN(j)  (2304 + 64 * (j))
#define XB_TOP      3328
#define XB_TOPGEN   3392
#define XCD_BAR_WORDS 3456
#define XB_SPIN_CAP (1u << 18)
__device__ __forceinline__ unsigned xb_ld(unsigned* p)              { return __hip_atomic_load(p, __ATOMIC_RELAXED, __HIP_MEMORY_SCOPE_AGENT); }
__device__ __forceinline__ unsigned xb_add(unsigned* p, unsigned v) { return __hip_atomic_fetch_add(p, v, __ATOMIC_RELAXED, __HIP_MEMORY_SCOPE_AGENT); }
__device__ __forceinline__ unsigned xb_xcc_id() { return (unsigned)__builtin_amdgcn_s_getreg((3 << 11) | 20) & 0xFu; }
#define XB_SPIN(cond, bar) do { unsigned _sp = 0; while (cond) { __builtin_amdgcn_s_sleep(1); \
    if ((++_sp & 255u) == 0u) { if (xb_ld(&(bar)[XB_TMO])) break; if (_sp > XB_SPIN_CAP) { atomicAdd(&(bar)[XB_TMO], 1u); break; } } } } while (0)
struct XcdBarrier { unsigned* bar; unsigned x; volatile LAS unsigned* st; };
__device__ __forceinline__ XcdBarrier xcd_barrier_post(unsigned* bar, volatile LAS unsigned* st) {
    XcdBarrier b; b.bar = bar; b.x = xb_xcc_id(); b.st = st;
    if (threadIdx.x == 0) (void)xb_add(&bar[XB_XCNT(b.x)], 1u);
    return b;
}
__device__ __forceinline__ void xcd_barrier_complete(unsigned* bar, unsigned x, unsigned& nloc, unsigned& nx) {
    const unsigned G = gridDim.x * gridDim.y * gridDim.z;
    unsigned sum, cnt, mine, sp = 0u;
    for (;;) {
        sum = 0u; cnt = 0u; mine = 0u;
#pragma unroll
        for (unsigned j = 0; j < 16; ++j) { const unsigned c = xb_ld(&bar[XB_XCNT(j)]); sum += c; cnt += (c > 0u) ? 1u : 0u; mine = (j == x) ? c : mine; }
        if (sum == G) break;
        __builtin_amdgcn_s_sleep(1);
        if ((++sp & 255u) == 0u) { if (xb_ld(&bar[XB_TMO])) break; if (sp > XB_SPIN_CAP) { atomicAdd(&bar[XB_TMO], 1u); break; } }
    }
    nloc = mine > 0u ? mine : 1u; nx = cnt > 0u ? cnt : 1u;
}
__device__ __forceinline__ void xcd_barrier(const XcdBarrier& b) {
    asm volatile("s_waitcnt vmcnt(0)" ::: "memory");
    __syncthreads();
    if (threadIdx.x == 0) {
        unsigned* bar = b.bar;
        __builtin_amdgcn_s_waitcnt(0);
        unsigned nloc = b.st[0], nx = b.st[1];
        if (nloc == 0u) { xcd_barrier_complete(bar, b.x, nloc, nx); b.st[0] = nloc; b.st[1] = nx; }
        const unsigned old = xb_add(&bar[XB_XSUB(b.x)], 1u);
        const unsigned gen = old / nloc;
        if (old + 1u == (gen + 1u) * nloc) {
            __builtin_amdgcn_fence(__ATOMIC_RELEASE, "agent");
            asm volatile("s_waitcnt vmcnt(0)" ::: "memory");
            const unsigned og = xb_add(&bar[XB_TOP], 1u);
            const unsigned tg = og / nx;
            if (og + 1u == (tg + 1u) * nx) xb_add(&bar[XB_TOPGEN], 1u);
            else XB_SPIN(xb_ld(&bar[XB_TOPGEN]) == tg, bar);
            __builtin_amdgcn_fence(__ATOMIC_ACQUIRE, "agent");
            xb_add(&bar[XB_XGEN(b.x)], 1u);
            asm volatile("s_waitcnt vmcnt(0)" ::: "memory");
        } else {
            XB_SPIN(xb_ld(&bar[XB_XGEN(b.x)]) == gen, bar);
            __builtin_amdgcn_fence(__ATOMIC_ACQUIRE, "agent");
            asm volatile("s_waitcnt vmcnt(0)" ::: "memory");
        }
    }
    __syncthreads();
}

__device__ void transpose_job(float* tile, const float* __restrict__ src, int ld, int K, int N, bf16_t* __restrict__ dst, int dst_rows,
                              const float* __restrict__ kscale, const float* __restrict__ src2, int ld2, int n2lo, int n2hi, int& rot, int idx, int nidx) {
    const int nkt = (K + 63) >> 6, nnt = (dst_rows + 63) >> 6, ntiles = nkt * nnt;
    const int tid_ = otid(); const int tx = tid_ & 63, ty = tid_ >> 6;
    const int first = (idx + nidx - rot % nidx) % nidx;
    rot += ntiles;
    for (int t = first; t < ntiles; t += nidx) {
        const int kt = t % nkt, nt = t / nkt, k0 = kt * 64, n0 = nt * 64;
#pragma unroll 4
        for (int i = 0; i < 16; ++i) {
            const int k = k0 + ty + 4 * i, n = n0 + tx; float v = 0.f;
            if (k < K) {
                if (n < N) { v = src[(size_t)k * ld + n]; if (kscale) v *= kscale[k]; }
                else if (src2 && n >= n2lo && n < n2hi) v = src2[(size_t)k * ld2 + (n - n2lo)];
            }
            tile[(ty + 4 * i) * 65 + tx] = v;
        }
        __syncthreads();
#pragma unroll 4
        for (int i = 0; i < 16; ++i) {
            const int n = n0 + ty + 4 * i, k = k0 + tx;
            if (n < dst_rows && k < K) dst[(size_t)n * K + k] = (bf16_t)(pk_bf16(tile[tx * 65 + ty + 4 * i], 0.f) & 0xffffu);
        }
        __syncthreads();
    }
}

__device__ void mod_job(float* lds, const Params& p, float* __restrict__ mod) {
    float* cact = lds;
    float* red = lds + 8192;
    const int tid = otid();
    bool have = false;
    for (int it = (int)gridDim.x - 1 - (int)blockIdx.x; it < 192; it += gridDim.x) {
        if (!have) {
            for (int i = tid; i < 8192; i += 256) cact[i] = siluf_(p.c[i]);
            have = true;
            __syncthreads();
        }
        const int l = it / 48, n0 = (it % 48) * 64, kg = tid >> 6, n = n0 + (tid & 63);
        float a0 = 0.f, a1 = 0.f, a2 = 0.f, a3 = 0.f, a4 = 0.f, a5 = 0.f, a6 = 0.f, a7 = 0.f;
        const float* wp = p.w_ada + ((size_t)l * 1024 + kg * 256) * 3072 + n;
#pragma unroll 8
        for (int k = 0; k < 256; ++k) {
            const float w = wp[(size_t)k * 3072]; const int kk = kg * 256 + k;
            a0 += cact[kk] * w; a1 += cact[1024 + kk] * w; a2 += cact[2048 + kk] * w; a3 += cact[3072 + kk] * w;
            a4 += cact[4096 + kk] * w; a5 += cact[5120 + kk] * w; a6 += cact[6144 + kk] * w; a7 += cact[7168 + kk] * w;
        }
        float* rp = red + (kg * 64 + (tid & 63)) * 8;
        rp[0] = a0; rp[1] = a1; rp[2] = a2; rp[3] = a3; rp[4] = a4; rp[5] = a5; rp[6] = a6; rp[7] = a7;
        __syncthreads();
        {
#pragma unroll
            for (int q = 0; q < 2; ++q) {
                const int o = tid + 256 * q, nn = o >> 3, b = o & 7;
                const float s = red[(0 * 64 + nn) * 8 + b] + red[(1 * 64 + nn) * 8 + b] + red[(2 * 64 + nn) * 8 + b] + red[(3 * 64 + nn) * 8 + b];
                mod[((size_t)l * 8 + b) * 3072 + n0 + nn] = s + p.b_ada[l * 3072 + n0 + nn];
            }
        }
        __syncthreads();
    }
}

__device__ void convert_layer(char* smem, const Params& p, int l, int idx, int nidx) {
    char* ws = p.ws; float* tile = (float*)smem; int rot = 0;
    transpose_job(tile, p.w_in + (size_t)l * 1024 * INW, INW, 1024, INW, (bf16_t*)(ws + OFF_WIN) + (size_t)l * NP * 1024, NP, nullptr,
                  l > 0 ? p.w_vmd + (size_t)(l - 1) * 1024 * 32 : nullptr, 32, INW, INW + 32, rot, idx, nidx);
    transpose_job(tile, p.w_out + (size_t)l * 1024 * 1024, 1024, 1024, 1024, (bf16_t*)(ws + OFF_WOUT) + (size_t)l * 1024 * 1024, 1024, nullptr, nullptr, 0, 0, 0, rot, idx, nidx);
    transpose_job(tile, p.w_uq + (size_t)l * 384 * 768, 768, 384, 768, (bf16_t*)(ws + OFF_WUQ) + (size_t)l * 768 * 384, 768, p.qng + l * 384, nullptr, 0, 0, 0, rot, idx, nidx);
    transpose_job(tile, p.w_ukv + (size_t)l * 256 * 1024, 1024, 256, 1024, (bf16_t*)(ws + OFF_WUKV) + (size_t)l * 1024 * 256, 1024, p.kvng + l * 256, nullptr, 0, 0, 0, rot, idx, nidx);
    transpose_job(tile, p.w_dec + (size_t)l * 64 * 512, 512, 64, 512, (bf16_t*)(ws + OFF_WDEC) + (size_t)l * 512 * 64, 512, nullptr, nullptr, 0, 0, 0, rot, idx, nidx);
    transpose_job(tile, p.w_icl + (size_t)l * 64 * 512, 512, 64, 512, (bf16_t*)(ws + OFF_WICL) + (size_t)l * 512 * 64, 512, nullptr, nullptr, 0, 0, 0, rot, idx, nidx);
    if (l > 0)
        transpose_job(tile, p.w_vmu + (size_t)(l - 1) * 32 * 512, 512, 32, 512, (bf16_t*)(ws + OFF_WVM) + (size_t)l * 512 * 32, 512, nullptr, nullptr, 0, 0, 0, rot, idx, nidx);
}

__device__ void prologue(char* smem, const Params& p) {
    char* ws = p.ws;
    float* tile = (float*)smem;
    { const int t0_ = otid(); if (blockIdx.x == 0 && t0_ < 64) ((int*)(ws + OFF_CTRL))[t0_] = 0; }
    {
        float* cs = (float*)(ws + OFF_COS); float* sn = (float*)(ws + OFF_SIN);
        const int gt = blockIdx.x * 256 + otid(), ng = gridDim.x * 256;
        for (int e = gt; e < NT * 16; e += ng) {
            const int t = e >> 4, i = e & 15;
            const float inv = exp2f(-(float)i * (13.287712379549449f / 16.0f));
            const float ang = (float)p.pos[t] * inv;
            cs[e] = cosf(ang); sn[e] = sinf(ang);
        }
    }
    mod_job(tile, p, (float*)(ws + OFF_MOD));
    __syncthreads();
    convert_layer(smem, p, 0, blockIdx.x, gridDim.x);
}

__device__ void norm_phase(const float* __restrict__ xin, const float* __restrict__ g, const float* __restrict__ modl, bf16_t* __restrict__ h, int tbase) {
    const int tid_ = otid(); const int lane = tid_ & 63, gw = blockIdx.x * 4 + (tid_ >> 6), nw = gridDim.x * 4;
    for (int t = tbase + gw; t < tbase + TH; t += nw) {
        const float* xr = xin + (size_t)t * 1024;
        f32x4 v[4]; float ss = 0.f;
#pragma unroll
        for (int i = 0; i < 4; ++i) { v[i] = *(const f32x4*)(xr + i * 256 + lane * 4); ss += v[i].x * v[i].x + v[i].y * v[i].y + v[i].z * v[i].z + v[i].w * v[i].w; }
        ss = wave_sum64(ss);
        const float rstd = rsqrtf(ss * (1.0f / 1024.0f) + 1e-6f);
        const float* mb = modl + (size_t)(t >> 12) * 3072;
#pragma unroll
        for (int i = 0; i < 4; ++i) {
            const int col = i * 256 + lane * 4;
            const f32x4 gg = *(const f32x4*)(g + col), sh = *(const f32x4*)(mb + col), sc = *(const f32x4*)(mb + 1024 + col);
            const f32x4 o = v[i] * rstd * gg * (sc + 1.0f) + sh;
            u32x2 w; w.x = pk_bf16(o.x, o.y); w.y = pk_bf16(o.z, o.w);
            *(u32x2*)(h + (size_t)(t - tbase) * 1024 + col) = w;
        }
    }
}

__device__ void final_norm(float* __restrict__ xio, const float* __restrict__ g) {
    const int tid_ = otid(); const int lane = tid_ & 63, gw = blockIdx.x * 4 + (tid_ >> 6), nw = gridDim.x * 4;
    for (int t = gw; t < NT; t += nw) {
        float* xr = xio + (size_t)t * 1024;
        f32x4 v[4]; float ss = 0.f;
#pragma unroll
        for (int i = 0; i < 4; ++i) { v[i] = *(const f32x4*)(xr + i * 256 + lane * 4); ss += v[i].x * v[i].x + v[i].y * v[i].y + v[i].z * v[i].z + v[i].w * v[i].w; }
        ss = wave_sum64(ss);
        const float rstd = rsqrtf(ss * (1.0f / 1024.0f) + 1e-6f);
#pragma unroll
        for (int i = 0; i < 4; ++i) {
            const int col = i * 256 + lane * 4;
            const f32x4 gg = *(const f32x4*)(g + col);
            *(f32x4*)(xr + col) = v[i] * rstd * gg;
        }
    }
}

template <class Epi>
__device__ __forceinline__ void gemm_tile(char* smem, const bf16_t* __restrict__ A, int lda, const bf16_t* __restrict__ Bt, int ldb, int K, int row0, int col0, const Epi& epi) {
    const int tid = otid(), lane = tid & 63, wid = tid >> 6, wr = wid >> 1, wc = wid & 1, fr = lane & 15, fq = lane >> 4;
    f32x4 acc[4][4];
#pragma unroll
    for (int i = 0; i < 4; ++i)
#pragma unroll
        for (int j = 0; j < 4; ++j) acc[i][j] = (f32x4){0.f, 0.f, 0.f, 0.f};
    const int lrow = lane >> 3, lp = lane & 7;
    const int srow0 = wid * 32 + lrow;
    const bf16_t* gA = A + (size_t)(row0 + srow0) * lda;
    const bf16_t* gB = Bt + (size_t)(col0 + srow0) * ldb;
    int gc[4];
#pragma unroll
    for (int i = 0; i < 4; ++i) gc[i] = (lp ^ (((srow0 + 8 * i) >> 1) & 7)) * 8;
    LAS char* lbase = (LAS char*)smem + wid * 4096;
#define GEMM_STAGE(buf, kofs) do { _Pragma("unroll") for (int i = 0; i < 4; ++i) { \
        __builtin_amdgcn_global_load_lds((const unsigned*)(gA + (size_t)(8 * i) * lda + (kofs) + gc[i]), (LAS unsigned*)(lbase + (buf) * 32768 + i * 1024), 16, 0, 0); \
        __builtin_amdgcn_global_load_lds((const unsigned*)(gB + (size_t)(8 * i) * ldb + (kofs) + gc[i]), (LAS unsigned*)(lbase + (buf) * 32768 + 16384 + i * 1024), 16, 0, 0); } } while (0)
    GEMM_STAGE(0, 0);
    __syncthreads();
    const int nk = K >> 6;
    const int fsw = (fr >> 1) & 7;
    const int aoff = (wr * 64 + fr) * 128, boff = 16384 + (wc * 64 + fr) * 128;
#define GEMM_STEP(CB, NB_) do { \
        const char* cur = smem + (CB) * 32768; \
        bf16x8 af[2][4], bfr[2][4]; \
        _Pragma("unroll") for (int kk = 0; kk < 2; ++kk) { \
            const int csw = (((kk * 4 + fq) ^ fsw) << 4); \
            _Pragma("unroll") for (int i = 0; i < 4; ++i) { af[kk][i] = *(const bf16x8*)(cur + aoff + i * 2048 + csw); bfr[kk][i] = *(const bf16x8*)(cur + boff + i * 2048 + csw); } \
        } \
        __builtin_amdgcn_sched_barrier(0); \
        if (ks + 1 < nk) GEMM_STAGE(NB_, (ks + 1) * 64); \
        __builtin_amdgcn_sched_barrier(0); \
        _Pragma("unroll") for (int kk = 0; kk < 2; ++kk) \
            _Pragma("unroll") for (int mi = 0; mi < 4; ++mi) \
                _Pragma("unroll") for (int ni = 0; ni < 4; ++ni) acc[mi][ni] = __builtin_amdgcn_mfma_f32_16x16x32_bf16(bfr[kk][ni], af[kk][mi], acc[mi][ni], 0, 0, 0); \
        __builtin_amdgcn_sched_barrier(0); \
        __syncthreads(); \
        ++ks; } while (0)
#pragma unroll 1
    for (int ks = 0; ks < nk;) {
        GEMM_STEP(0, 1);
        GEMM_STEP(1, 0);
    }
#undef GEMM_STEP
#undef GEMM_STAGE
    epi(acc, row0 + wr * 64, col0 + wc * 64, fr, fq);
}

struct EpiProj {
    bf16_t* proj; float* rsq; float* rskv; char* smem;
    __device__ __forceinline__ void operator()(const f32x4 (&acc)[4][4], int rbase, int cbase, int fr, int fq) const {
        const bool isq = cbase >= O_CQ && cbase < O_CKV, iskv = cbase >= O_CKV && cbase < O_KR;
        const int row0 = rbase & ~127, col0 = cbase & ~127, wr = (rbase >> 6) & 1, wc = (cbase >> 6) & 1;
        const int tid = (wr * 2 + wc) * 64 + fq * 16 + fr;
#pragma unroll
        for (int mi = 0; mi < 4; ++mi) {
            const int tl = rbase + mi * 16 + fr; float ss = 0.f;
#pragma unroll
            for (int ni = 0; ni < 4; ++ni) {
                u32x2 w; w.x = pk_bf16(acc[mi][ni][0], acc[mi][ni][1]); w.y = pk_bf16(acc[mi][ni][2], acc[mi][ni][3]);
                *(u32x2*)(smem + (wr * 64 + mi * 16 + fr) * 272 + (wc * 64 + ni * 16 + fq * 4) * 2) = w;
                const float a = bf_lo(w.x), b = bf_hi(w.x), c = bf_lo(w.y), d = bf_hi(w.y);
                ss += a * a + b * b + c * c + d * d;
            }
            if (isq || iskv) {
                ss += __shfl_xor(ss, 16); ss += __shfl_xor(ss, 32);
                if (fq == 0) { if (isq) rsq[(size_t)tl * 8 + ((cbase - O_CQ) >> 6)] = ss; else rskv[(size_t)tl * 4 + ((cbase - O_CKV) >> 6)] = ss; }
            }
        }
        __syncthreads();
#pragma unroll
        for (int i = 0; i < 8; ++i) {
            const int q = tid + 256 * i, r = q >> 4, c = q & 15;
            *(u32x4*)(proj + (size_t)(row0 + r) * NP + col0 + c * 8) = *(const u32x4*)(smem + r * 272 + c * 16);
        }
        __syncthreads();
    }
};
struct EpiQ {
    bf16_t* Q; const float* rsq; const float* cs; const float* sn; int tgbase; char* smem;
    __device__ __forceinline__ void operator()(const f32x4 (&acc)[4][4], int rbase, int cbase, int fr, int fq) const {
        const int g0 = cbase >> 4;
        char* stg = smem + ((((rbase >> 6) & 1) * 2 + ((cbase >> 6) & 1)) * 9216);
#pragma unroll
        for (int mi = 0; mi < 4; ++mi) {
            const int tl = rbase + mi * 16 + fr;
            const f32x4 s0 = *(const f32x4*)(rsq + (size_t)tl * 8); const f32x2 s1 = *(const f32x2*)(rsq + (size_t)tl * 8 + 4);
            const float rs = rsqrtf((s0.x + s0.y + s0.z + s0.w + s1.x + s1.y) * (1.0f / 384.0f) + 1e-6f) * QSCALE;
            const f32x4 cc = *(const f32x4*)(cs + (size_t)(tgbase + tl) * 16 + fq * 4), sv = *(const f32x4*)(sn + (size_t)(tgbase + tl) * 16 + fq * 4);
            f32x4 v[4];
#pragma unroll
            for (int ni = 0; ni < 4; ++ni) v[ni] = acc[mi][ni] * rs;
#pragma unroll
            for (int ni = 0; ni < 4; ni += 2)
                if ((g0 + ni) % 6 == 4) { const f32x4 x1 = v[ni], x2 = v[ni + 1]; v[ni] = x1 * cc - x2 * sv; v[ni + 1] = x2 * cc + x1 * sv; }
#pragma unroll
            for (int ni = 0; ni < 4; ++ni) {
                u32x2 w; w.x = pk_bf16(v[ni][0], v[ni][1]); w.y = pk_bf16(v[ni][2], v[ni][3]);
                *(u32x2*)(stg + (mi * 16 + fr) * 144 + (ni * 16 + fq * 4) * 2) = w;
            }
        }
        {
            const int lane = fq * 16 + fr;
#pragma unroll
            for (int i = 0; i < 8; ++i) {
                const int q = lane + 64 * i, tk = q >> 3, c = q & 7;
                *(u32x4*)(Q + (size_t)(rbase + tk) * 768 + cbase + c * 8) = *(const u32x4*)(stg + tk * 144 + c * 16);
            }
        }
        __syncthreads();
    }
};
struct EpiKV {
    bf16_t* Kh; bf16_t* Vt; const float* rskv; char* smem;
    __device__ __forceinline__ void operator()(const f32x4 (&acc)[4][4], int rbase, int cbase, int fr, int fq) const {
        const int hh = cbase >> 7, part = (cbase >> 6) & 1, lane = fq * 16 + fr;
        char* stg = smem + ((((rbase >> 6) & 1) * 2 + part) * 9216);
#pragma unroll
        for (int mi = 0; mi < 4; ++mi) {
            const int tl = rbase + mi * 16 + fr;
            const f32x4 s0 = *(const f32x4*)(rskv + (size_t)tl * 4);
            const float rs = rsqrtf((s0.x + s0.y + s0.z + s0.w) * (1.0f / 256.0f) + 1e-6f);
#pragma unroll
            for (int ni = 0; ni < 4; ++ni) {
                const unsigned w0 = pk_bf16(acc[mi][ni][0] * rs, acc[mi][ni][1] * rs), w1 = pk_bf16(acc[mi][ni][2] * rs, acc[mi][ni][3] * rs);
                if (part == 0) { u32x2 w; w.x = w0; w.y = w1; *(u32x2*)(stg + (mi * 16 + fr) * 144 + (ni * 16 + fq * 4) * 2) = w; }
                else {
                    bf16_t* sp = (bf16_t*)(stg + (ni * 16 + fq * 4) * 144) + mi * 16 + fr;
                    sp[0] = (bf16_t)(w0 & 0xffffu); sp[72] = (bf16_t)(w0 >> 16); sp[144] = (bf16_t)(w1 & 0xffffu); sp[216] = (bf16_t)(w1 >> 16);
                }
            }
        }
        if (part == 0) {
#pragma unroll
            for (int i = 0; i < 8; ++i) {
                const int q = lane + 64 * i, tk = q >> 3, c = q & 7;
                *(u32x4*)(Kh + (size_t)(rbase + tk) * 768 + hh * 96 + c * 8) = *(const u32x4*)(stg + tk * 144 + c * 16);
            }
        } else {
            const int bl = rbase >> 12, s0 = rbase & 4095;
            bf16_t* vb = Vt + ((size_t)(bl * 8 + hh) * 64) * 4096 + s0;
#pragma unroll
            for (int i = 0; i < 8; ++i) {
                const int q = lane + 64 * i, dv = q >> 3, c = q & 7;
                *(u32x4*)(vb + (size_t)dv * 4096 + c * 8) = *(const u32x4*)(stg + dv * 144 + c * 16);
            }
        }
        __syncthreads();
    }
};
struct EpiOut {
    const float* xold; float* xnew; const float* modl; int tgbase; float fac;
    __device__ __forceinline__ void operator()(const f32x4 (&acc)[4][4], int rbase, int cbase, int fr, int fq) const {
#pragma unroll
        for (int mi = 0; mi < 4; ++mi) {
            const int tg = tgbase + rbase + mi * 16 + fr; const float* gp = modl + (size_t)(tg >> 12) * 3072 + 2048;
#pragma unroll
            for (int ni = 0; ni < 4; ++ni) {
                const int col = cbase + ni * 16 + fq * 4;
                const f32x4 xo = *(const f32x4*)(xold + (size_t)tg * 1024 + col), gt = *(const f32x4*)(gp + col);
                *(f32x4*)(xnew + (size_t)tg * 1024 + col) = xo + gt * acc[mi][ni] * fac;
            }
        }
    }
};

struct PrepArgs {
    const bf16_t* proj; const float* mu; const float* muv; const bf16_t* wdec; const bf16_t* wicl; const bf16_t* wvm;
    const float *w0, *a0, *v0, *k_k, *k_a; const float *cs, *sn;
    bf16_t *sr, *sk, *sv, *skk, *skka; bf16_t* se; bf16_t* vfirst; bf16_t* Kh; int layer; int tgbase;
};
__device__ __forceinline__ void lerp8(const bf16_t* cur, const bf16_t* prv, bool hp, const float* mu, float (&o)[8]) {
    const u32x4 c = *(const u32x4*)cur; u32x4 q = (u32x4){0u, 0u, 0u, 0u}; if (hp) q = *(const u32x4*)prv;
    const f32x4 m0 = *(const f32x4*)mu, m1 = *(const f32x4*)(mu + 4);
    const float cv[8] = {bf_lo(c.x), bf_hi(c.x), bf_lo(c.y), bf_hi(c.y), bf_lo(c.z), bf_hi(c.z), bf_lo(c.w), bf_hi(c.w)};
    const float pv[8] = {bf_lo(q.x), bf_hi(q.x), bf_lo(q.y), bf_hi(q.y), bf_lo(q.z), bf_hi(q.z), bf_lo(q.w), bf_hi(q.w)};
    const float mv[8] = {m0.x, m0.y, m0.z, m0.w, m1.x, m1.y, m1.z, m1.w};
#pragma unroll
    for (int j = 0; j < 8; ++j) o[j] = cv[j] + (pv[j] - cv[j]) * mv[j];
}
__device__ __forceinline__ f32x4 lerp4(const bf16_t* cur, const bf16_t* prv, bool hp, const float* mu) {
    const u32x2 c = *(const u32x2*)cur; u32x2 q = (u32x2){0u, 0u}; if (hp) q = *(const u32x2*)prv;
    const f32x4 m = *(const f32x4*)mu;
    const f32x4 cv = (f32x4){bf_lo(c.x), bf_hi(c.x), bf_lo(c.y), bf_hi(c.y)}, pv = (f32x4){bf_lo(q.x), bf_hi(q.x), bf_lo(q.y), bf_hi(q.y)};
    return cv + (pv - cv) * m;
}
__device__ __forceinline__ bf16x8 pack8(const float (&v)[8]) {
    u32x4 w; w.x = pk_bf16(v[0], v[1]); w.y = pk_bf16(v[2], v[3]); w.z = pk_bf16(v[4], v[5]); w.w = pk_bf16(v[6], v[7]);
    return __builtin_bit_cast(bf16x8, w);
}
__device__ __forceinline__ void store4(bf16_t* dst, const f32x4 v) { u32x2 w; w.x = pk_bf16(v.x, v.y); w.y = pk_bf16(v.z, v.w); *(u32x2*)dst = w; }

__device__ __forceinline__ void prep_tile(char* smem, const PrepArgs& a, int tile, int hg) {
    const int tid = otid(), lane = tid & 63, wid = tid >> 6, fr = lane & 15, fq = lane >> 4;
    const int tl = tile * 64 + wid * 16 + fr, tg = a.tgbase + tl;
    char* stg = smem + wid * 15872;
    const int tlw = tile * 64 + wid * 16;
    const bool hp = (tg & 4095) != 0;
    const bf16_t* pr = a.proj + (size_t)tl * NP; const bf16_t* pp = pr - NP;
    if (hg == 0) {
        const u32x2 u1 = *(const u32x2*)(pr + O_KR + fq * 4), u2 = *(const u32x2*)(pr + O_KR + 16 + fq * 4);
        const f32x4 x1 = (f32x4){bf_lo(u1.x), bf_hi(u1.x), bf_lo(u1.y), bf_hi(u1.y)}, x2 = (f32x4){bf_lo(u2.x), bf_hi(u2.x), bf_lo(u2.y), bf_hi(u2.y)};
        const f32x4 cc = *(const f32x4*)(a.cs + (size_t)tg * 16 + fq * 4), sv = *(const f32x4*)(a.sn + (size_t)tg * 16 + fq * 4);
        const f32x4 o1 = x1 * cc - x2 * sv, o2 = x2 * cc + x1 * sv;
        u32x2 w1, w2; w1.x = pk_bf16(o1.x, o1.y); w1.y = pk_bf16(o1.z, o1.w); w2.x = pk_bf16(o2.x, o2.y); w2.y = pk_bf16(o2.z, o2.w);
#pragma unroll
        for (int hh = 0; hh < 8; ++hh) { *(u32x2*)(a.Kh + (size_t)tl * 768 + hh * 96 + 64 + fq * 4) = w1; *(u32x2*)(a.Kh + (size_t)tl * 768 + hh * 96 + 80 + fq * 4) = w2; }
    }
    bf16x8 bw[2], ba[2], bv;
#pragma unroll
    for (int ks = 0; ks < 2; ++ks) {
        float t[8];
        lerp8(pr + 1536 + ks * 32 + fq * 8, pp + 1536 + ks * 32 + fq * 8, hp, a.mu + 1536 + ks * 32 + fq * 8, t);
#pragma unroll
        for (int j = 0; j < 8; ++j) t[j] = tanhf_(t[j]);
        bw[ks] = pack8(t);
        lerp8(pr + 1600 + ks * 32 + fq * 8, pp + 1600 + ks * 32 + fq * 8, hp, a.mu + 1600 + ks * 32 + fq * 8, t);
        ba[ks] = pack8(t);
    }
    const bool hasv = a.layer > 0;
    if (hasv) { float t[8]; lerp8(pr + INW + fq * 8, pp + INW + fq * 8, hp, a.muv + fq * 8, t); bv = pack8(t); }
    else bv = (bf16x8){0, 0, 0, 0, 0, 0, 0, 0};
#pragma unroll 1
    for (int hh = hg * 2; hh < hg * 2 + 2; ++hh) {
        float ss = 0.f;
#pragma unroll
        for (int nt = 0; nt < 4; ++nt) {
            const int ch = hh * 64 + nt * 16 + fq * 4;
            const f32x4 k4 = lerp4(pr + 512 + ch, pp + 512 + ch, hp, a.mu + 512 + ch);
            const f32x4 kr = k4 * *(const f32x4*)(a.k_k + ch);
            ss += kr.x * kr.x + kr.y * kr.y + kr.z * kr.z + kr.w * kr.w;
        }
        ss += __shfl_xor(ss, 16); ss += __shfl_xor(ss, 32);
        const float inv = 1.0f / fmaxf(sqrtf(ss), 1e-12f);
#pragma unroll
        for (int nt = 0; nt < 4; ++nt) {
            const int cb = hh * 64 + nt * 16, ch = cb + fq * 4;
            f32x4 accw = (f32x4){0.f, 0.f, 0.f, 0.f}, acca = accw, accv = accw;
#pragma unroll
            for (int ks = 0; ks < 2; ++ks) {
                const bf16x8 aw = *(const bf16x8*)(a.wdec + (size_t)(cb + fr) * 64 + ks * 32 + fq * 8);
                const bf16x8 ai = *(const bf16x8*)(a.wicl + (size_t)(cb + fr) * 64 + ks * 32 + fq * 8);
                accw = __builtin_amdgcn_mfma_f32_16x16x32_bf16(aw, bw[ks], accw, 0, 0, 0);
                acca = __builtin_amdgcn_mfma_f32_16x16x32_bf16(ai, ba[ks], acca, 0, 0, 0);
            }
            if (hasv) {
                const bf16x8 avm = *(const bf16x8*)(a.wvm + (size_t)(cb + fr) * 32 + fq * 8);
                accv = __builtin_amdgcn_mfma_f32_16x16x32_bf16(avm, bv, accv, 0, 0, 0);
            }
            const f32x4 r4 = lerp4(pr + ch, pp + ch, hp, a.mu + ch);
            const f32x4 k4 = lerp4(pr + 512 + ch, pp + 512 + ch, hp, a.mu + 512 + ch);
            f32x4 v4 = lerp4(pr + 1024 + ch, pp + 1024 + ch, hp, a.mu + 1024 + ch);
            const f32x4 w0v = *(const f32x4*)(a.w0 + ch), a0v = *(const f32x4*)(a.a0 + ch), kkv = *(const f32x4*)(a.k_k + ch), kav = *(const f32x4*)(a.k_a + ch);
            f32x4 dec, aa;
#pragma unroll
            for (int j = 0; j < 4; ++j) {
                dec[j] = 0.6065306597126334f * sigmoidf_(w0v[j] + accw[j]);
                aa[j] = sigmoidf_(a0v[j] + acca[j]);
            }
            if (hasv) {
                const f32x4 v0v = *(const f32x4*)(a.v0 + ch);
                const u32x2 uf = *(const u32x2*)(a.vfirst + (size_t)tg * 512 + ch);
                const f32x4 vf = (f32x4){bf_lo(uf.x), bf_hi(uf.x), bf_lo(uf.y), bf_hi(uf.y)};
#pragma unroll
                for (int j = 0; j < 4; ++j) v4[j] = v4[j] + (vf[j] - v4[j]) * sigmoidf_(v0v[j] + accv[j]);
            } else {
                store4(a.vfirst + (size_t)tg * 512 + ch, v4);
            }
            const f32x4 kk = k4 * kkv * inv;
            const f32x4 kp = k4 * ((aa - 1.0f) * kav + 1.0f);
            {
                const int so = fr * 144 + nt * 32 + fq * 8;
                store4((bf16_t*)(stg + so), r4); store4((bf16_t*)(stg + 2304 + so), kp); store4((bf16_t*)(stg + 4608 + so), v4);
                store4((bf16_t*)(stg + 6912 + so), kk); store4((bf16_t*)(stg + 9216 + so), kk * aa);
                store4((bf16_t*)(stg + 11520 + so), dec);
            }
        }
        {
#pragma unroll
            for (int i = 0; i < 2; ++i) {
                const int q = lane + 64 * i, tk = q >> 3, c = q & 7;
                const size_t go = (size_t)(tlw + tk) * 512 + hh * 64 + c * 8; const int lo = tk * 144 + c * 16;
                *(u32x4*)(a.sr + go) = *(const u32x4*)(stg + lo); *(u32x4*)(a.sk + go) = *(const u32x4*)(stg + 2304 + lo); *(u32x4*)(a.sv + go) = *(const u32x4*)(stg + 4608 + lo);
                *(u32x4*)(a.skk + go) = *(const u32x4*)(stg + 6912 + lo); *(u32x4*)(a.skka + go) = *(const u32x4*)(stg + 9216 + lo);
                *(u32x4*)(a.se + go) = *(const u32x4*)(stg + 11520 + lo);
            }
        }
    }
    __syncthreads();
}

struct ScanArgs { const bf16_t *sr, *sk, *sv, *skk, *skka; const float* sw; float* yraw; float* zbuf; float* sfin; };
__device__ __forceinline__ void cvt_store8(float* dst, const u32x4 u) {
    *(f32x4*)dst = (f32x4){bf_lo(u.x), bf_hi(u.x), bf_lo(u.y), bf_hi(u.y)};
    *(f32x4*)(dst + 4) = (f32x4){bf_lo(u.z), bf_hi(u.z), bf_lo(u.w), bf_hi(u.w)};
}
__device__ __forceinline__ void scan_tile(char* smem, const ScanArgs& a, int mode, int bl, int hh, int g) {
    const int tid = otid(), lane = tid & 63, wid = tid >> 6, rl = lane >> 4, c = lane & 15;
    float* L = (float*)smem;
    float* ybuf = L + 2 * 5376;
    const size_t tokbase = (size_t)bl * 4096 + (mode ? 2048 : 0);
    const int colh = hh * 64, i0 = g * 16;
    const bf16_t* src0 = (tid < 128) ? a.skk : a.skka;
    const bf16_t* src1 = (tid < 128) ? a.sk : a.sr;
    const int rem = tid & 127, tokA = rem >> 3, chA = rem & 7;
    const size_t gofsA = (size_t)tokA * 512 + colh + chA * 8;
    const int ldsA0 = (1 + (tid >> 7)) * 1024 + tokA * 64 + chA * 8, ldsA1 = (3 + (tid >> 7)) * 1024 + tokA * 64 + chA * 8;
    const size_t gofsW = (size_t)(tid >> 4) * 512 + colh + (tid & 15) * 4;
    const int ldsW = (tid >> 4) * 64 + (tid & 15) * 4;
    const size_t gofsV = (size_t)((tid & 31) >> 1) * 512 + colh + i0 + (tid & 1) * 8;
    const int ldsV = 5120 + ((tid & 31) >> 1) * 16 + (tid & 1) * 8;
    const bool ldv = tid < 32 && mode != 2;
    f32x2 S01 = (f32x2){0.f, 0.f}, S23 = (f32x2){0.f, 0.f};
    if (mode == 2) { const int d = (i0 + wid * 4 + rl) - c * 4; S01.x = d == 0 ? 1.f : 0.f; S01.y = d == 1 ? 1.f : 0.f; S23.x = d == 2 ? 1.f : 0.f; S23.y = d == 3 ? 1.f : 0.f; }
    u32x4 qa, qb, qv = (u32x4){0u, 0u, 0u, 0u}; f32x4 qw;
    {
        const size_t tb = tokbase * 512;
        qa = *(const u32x4*)(src0 + tb + gofsA); qb = *(const u32x4*)(src1 + tb + gofsA); qw = *(const f32x4*)(a.sw + tb + gofsW);
        if (ldv) qv = *(const u32x4*)(a.sv + tb + gofsV);
        cvt_store8(L + ldsA0, qa); cvt_store8(L + ldsA1, qb); *(f32x4*)(L + ldsW) = qw; if (tid < 32) { cvt_store8(L + ldsV, qv); if (mode == 2) cvt_store8(L + 5376 + ldsV, qv); }
    }
    __syncthreads();
    const int vofs = 5120 + wid * 4 + rl;
#pragma unroll 1
    for (int ch = 0; ch < 128; ++ch) {
        const float* cur = L + (ch & 1) * 5376;
        if (ch + 1 < 128) {
            const size_t tb = (tokbase + (size_t)(ch + 1) * 16) * 512;
            qa = *(const u32x4*)(src0 + tb + gofsA); qb = *(const u32x4*)(src1 + tb + gofsA); qw = *(const f32x4*)(a.sw + tb + gofsW);
            if (ldv) qv = *(const u32x4*)(a.sv + tb + gofsV);
        }
        float* yb = ybuf + (ch & 1) * 256;
        float ykeep = 0.f;
        f32x4 w4 = *(const f32x4*)(cur + c * 4), kk4 = *(const f32x4*)(cur + 1024 + c * 4), ka4 = *(const f32x4*)(cur + 2048 + c * 4);
        f32x4 k4 = *(const f32x4*)(cur + 3072 + c * 4), r4 = *(const f32x4*)(cur + 4096 + c * 4);
        float v = cur[vofs];
        float prevq = 0.f;
#pragma unroll
        for (int s = 0; s < 16; ++s) {
            f32x4 nw4 = w4, nkk4 = kk4, nka4 = ka4, nk4 = k4, nr4 = r4; float nv = v;
            if (s + 1 < 16) {
                nw4 = *(const f32x4*)(cur + (s + 1) * 64 + c * 4); nkk4 = *(const f32x4*)(cur + 1024 + (s + 1) * 64 + c * 4); nka4 = *(const f32x4*)(cur + 2048 + (s + 1) * 64 + c * 4);
                nk4 = *(const f32x4*)(cur + 3072 + (s + 1) * 64 + c * 4); nr4 = *(const f32x4*)(cur + 4096 + (s + 1) * 64 + c * 4);
                nv = cur[vofs + (s + 1) * 16];
            }
            const f32x2 pp = S01 * kk4.xy + S23 * kk4.zw;
            float sa = pp.x + pp.y;
            if (s > 0) { float yq = prevq; dpp_sum16x2(sa, yq); ykeep = (c == s - 1) ? yq : ykeep; }
            else sa = dpp_sum16(sa);
            const f32x2 sa2 = (f32x2){sa, sa}, v2 = (f32x2){v, v};
            S01 = S01 * w4.xy + (v2 * k4.xy - sa2 * ka4.xy);
            S23 = S23 * w4.zw + (v2 * k4.zw - sa2 * ka4.zw);
            const f32x2 qq = S01 * r4.xy + S23 * r4.zw;
            prevq = qq.x + qq.y;
            __builtin_amdgcn_sched_barrier(0);
            w4 = nw4; kk4 = nkk4; ka4 = nka4; k4 = nk4; r4 = nr4; v = nv;
        }
        { const float yq = dpp_sum16(prevq); ykeep = (c == 15) ? yq : ykeep; }
        yb[c * 16 + wid * 4 + rl] = ykeep;
        if (ch + 1 < 128) {
            float* nx = L + ((ch + 1) & 1) * 5376;
            cvt_store8(nx + ldsA0, qa); cvt_store8(nx + ldsA1, qb); *(f32x4*)(nx + ldsW) = qw; if (ldv) cvt_store8(nx + ldsV, qv);
        }
        __syncthreads();
        if (mode != 2) a.yraw[(tokbase + (size_t)ch * 16 + (tid >> 4)) * 512 + colh + i0 + (tid & 15)] = yb[tid];
        else a.zbuf[((size_t)bl * 2048 + (size_t)ch * 16 + (tid >> 4)) * 512 + colh + i0 + (tid & 15)] = yb[tid];
    }
    if (mode == 0) *(f32x4*)(a.sfin + ((size_t)((bl * 8 + hh) * 64 + i0 + wid * 4 + rl)) * 64 + c * 4) = (f32x4){S01.x, S01.y, S23.x, S23.y};
}

__device__ __forceinline__ void attn_tile(char* smem, const bf16_t* __restrict__ Qh, const bf16_t* __restrict__ Kh, const bf16_t* __restrict__ Vt,
                                          const bf16_t* __restrict__ proj, bf16_t* __restrict__ ycat, int bl, int hh, int qt) {
    const int tid = otid(), lane = tid & 63, wid = tid >> 6, fr = lane & 15, fq = lane >> 4;
    const int q0 = qt * 128, tok0 = bl * 4096, qw0 = q0 + wid * 32;
    bf16x8 qf[2][3];
#pragma unroll
    for (int qi = 0; qi < 2; ++qi)
#pragma unroll
        for (int ks = 0; ks < 3; ++ks) qf[qi][ks] = *(const bf16x8*)(Qh + (size_t)(tok0 + qw0 + qi * 16 + fr) * 768 + hh * 96 + ks * 32 + fq * 8);
    f32x4 o[4][2];
#pragma unroll
    for (int i = 0; i < 4; ++i) { o[i][0] = (f32x4){0.f, 0.f, 0.f, 0.f}; o[i][1] = o[i][0]; }
    float m[2] = {-1e30f, -1e30f}, lsum[2] = {0.f, 0.f};
    const int nkv = 2 * (qt + 1);
    const bf16_t* Kb = Kh + (size_t)tok0 * 768 + hh * 96;
    const bf16_t* Vb = Vt + ((size_t)((bl * 8 + hh) * 64)) * 4096;
    int gK[3], lK[3];
#pragma unroll
    for (int i = 0; i < 3; ++i) { const int cid = tid + 256 * i, key = cid / 12, cc = cid - key * 12; gK[i] = key * 768 + cc * 8; lK[i] = key * 224 + cc * 16; }
    int gV[2], lV[2];
#pragma unroll
    for (int i = 0; i < 2; ++i) { const int cid = tid + 256 * i, dv = cid >> 3, cc = cid & 7; gV[i] = dv * 4096 + cc * 8; lV[i] = 14336 + dv * 144 + cc * 16; }
    u32x4 rkA[3], rvA[2], rkB[3], rvB[2];
#define ATT_LOAD(RK, RV, T) do { _Pragma("unroll") for (int i = 0; i < 3; ++i) RK[i] = *(const u32x4*)(Kb + (size_t)((T) * 64) * 768 + gK[i]); \
                                 _Pragma("unroll") for (int i = 0; i < 2; ++i) RV[i] = *(const u32x4*)(Vb + (T) * 64 + gV[i]); } while (0)
#define ATT_WRITE(RK, RV, BUF) do { _Pragma("unroll") for (int i = 0; i < 3; ++i) *(u32x4*)(smem + (BUF) * 23552 + lK[i]) = RK[i]; \
                                    _Pragma("unroll") for (int i = 0; i < 2; ++i) *(u32x4*)(smem + (BUF) * 23552 + lV[i]) = RV[i]; } while (0)
    ATT_LOAD(rkA, rvA, 0);
    ATT_WRITE(rkA, rvA, 0);
    ATT_LOAD(rkA, rvA, 1);
    __syncthreads();
    auto compute = [&](const int j, const char* cur) {
        const int kv0 = j * 64;
        if (kv0 <= qw0 + 31) {
            f32x4 s[4][2];
            {
                bf16x8 kf[4][3];
#pragma unroll
                for (int kt = 0; kt < 4; ++kt)
#pragma unroll
                    for (int ks = 0; ks < 3; ++ks) kf[kt][ks] = *(const bf16x8*)(cur + (kt * 16 + fr) * 224 + (ks * 4 + fq) * 16);
                __builtin_amdgcn_sched_barrier(0);
#pragma unroll
                for (int kt = 0; kt < 4; ++kt)
#pragma unroll
                    for (int qi = 0; qi < 2; ++qi) {
                        f32x4 acc = (f32x4){0.f, 0.f, 0.f, 0.f};
#pragma unroll
                        for (int ks = 0; ks < 3; ++ks) acc = __builtin_amdgcn_mfma_f32_16x16x32_bf16(kf[kt][ks], qf[qi][ks], acc, 0, 0, 0);
                        s[kt][qi] = acc;
                    }
                __builtin_amdgcn_sched_barrier(0);
            }
            bf16x8 vfr[4][2];
#pragma unroll
            for (int dvt = 0; dvt < 4; ++dvt)
#pragma unroll
                for (int kb = 0; kb < 2; ++kb) {
                    const char* vp = cur + 14336 + (dvt * 16 + fr) * 144 + kb * 64 + fq * 8;
                    const u32x2 lo = *(const u32x2*)vp, hi = *(const u32x2*)(vp + 32);
                    vfr[dvt][kb] = __builtin_bit_cast(bf16x8, ((u32x4){lo.x, lo.y, hi.x, hi.y}));
                }
            __builtin_amdgcn_sched_barrier(0);
            if (kv0 + 63 > qw0) {
#pragma unroll
                for (int kt = 0; kt < 4; ++kt)
#pragma unroll
                    for (int qi = 0; qi < 2; ++qi)
#pragma unroll
                        for (int jj = 0; jj < 4; ++jj) { const int kpos = kv0 + kt * 16 + fq * 4 + jj, qpos = qw0 + qi * 16 + fr; if (kpos > qpos) s[kt][qi][jj] = -1e30f; }
            }
#pragma unroll
            for (int qi = 0; qi < 2; ++qi) {
                float mx = -1e30f;
#pragma unroll
                for (int kt = 0; kt < 4; ++kt) mx = fmaxf(mx, fmaxf(fmaxf(s[kt][qi][0], s[kt][qi][1]), fmaxf(s[kt][qi][2], s[kt][qi][3])));
                mx = fmaxf(mx, __shfl_xor(mx, 16)); mx = fmaxf(mx, __shfl_xor(mx, 32));
                const float mnew = fmaxf(m[qi], mx), alpha = __builtin_amdgcn_exp2f(m[qi] - mnew);
                m[qi] = mnew;
                float rs = 0.f;
#pragma unroll
                for (int kt = 0; kt < 4; ++kt)
#pragma unroll
                    for (int jj = 0; jj < 4; ++jj) { const float pexp = __builtin_amdgcn_exp2f(s[kt][qi][jj] - mnew); s[kt][qi][jj] = pexp; rs += pexp; }
                lsum[qi] = lsum[qi] * alpha + rs;
#pragma unroll
                for (int dvt = 0; dvt < 4; ++dvt) o[dvt][qi] = o[dvt][qi] * alpha;
            }
            bf16x8 pf[2][2];
#pragma unroll
            for (int kb = 0; kb < 2; ++kb)
#pragma unroll
                for (int qi = 0; qi < 2; ++qi) {
                    u32x4 t;
                    t.x = pk_bf16(s[2 * kb][qi][0], s[2 * kb][qi][1]); t.y = pk_bf16(s[2 * kb][qi][2], s[2 * kb][qi][3]);
                    t.z = pk_bf16(s[2 * kb + 1][qi][0], s[2 * kb + 1][qi][1]); t.w = pk_bf16(s[2 * kb + 1][qi][2], s[2 * kb + 1][qi][3]);
                    pf[kb][qi] = __builtin_bit_cast(bf16x8, t);
                }
            __builtin_amdgcn_sched_barrier(0);
#pragma unroll
            for (int dvt = 0; dvt < 4; ++dvt)
#pragma unroll
                for (int kb = 0; kb < 2; ++kb)
#pragma unroll
                    for (int qi = 0; qi < 2; ++qi) o[dvt][qi] = __builtin_amdgcn_mfma_f32_16x16x32_bf16(vfr[dvt][kb], pf[kb][qi], o[dvt][qi], 0, 0, 0);
        }
    };
#pragma unroll 1
    for (int j = 0; j < nkv; j += 2) {
        if (j + 2 < nkv) ATT_LOAD(rkB, rvB, j + 2);
        compute(j, smem);
        ATT_WRITE(rkA, rvA, 1);
        __syncthreads();
        if (j + 3 < nkv) ATT_LOAD(rkA, rvA, j + 3);
        compute(j + 1, smem + 23552);
        if (j + 2 < nkv) ATT_WRITE(rkB, rvB, 0);
        __syncthreads();
    }
#undef ATT_LOAD
#undef ATT_WRITE
#pragma unroll
    for (int qi = 0; qi < 2; ++qi) {
        float lt = lsum[qi]; lt += __shfl_xor(lt, 16); lt += __shfl_xor(lt, 32);
        const float inv = 1.0f / lt;
        const int tl = tok0 + qw0 + qi * 16 + fr;
#pragma unroll
        for (int dvt = 0; dvt < 4; ++dvt) {
            const int dv = dvt * 16 + fq * 4;
            const u32x2 gu = *(const u32x2*)(proj + (size_t)tl * NP + O_GM + hh * 64 + dv);
            const f32x4 gg = (f32x4){bf_lo(gu.x), bf_hi(gu.x), bf_lo(gu.y), bf_hi(gu.y)};
            f32x4 r;
#pragma unroll
            for (int jj = 0; jj < 4; ++jj) r[jj] = o[dvt][qi][jj] * inv * siluf_(gg[jj]);
            store4(ycat + (size_t)tl * 1024 + 512 + hh * 64 + dv, r);
        }
    }
}

struct FinArgs { const float* yraw; const bf16_t *sr, *sk, *sv; const bf16_t* proj; const float *lnw, *lnb, *rk; bf16_t* ycat; const float* zbuf; const float* sfin; };
__device__ void rwkv_finalize(const FinArgs& a) {
    const int tid_ = otid(); const int lane = tid_ & 63, gw = blockIdx.x * 4 + (tid_ >> 6), nw = gridDim.x * 4;
    for (int u = gw; u < TH * 2; u += nw) {
        const int tl = u >> 1, ch = ((u & 1) * 4 + (lane >> 4)) * 64 + (lane & 15) * 4;
        f32x4 y = *(const f32x4*)(a.yraw + (size_t)tl * 512 + ch);
        const float mean = dpp_sum16(y.x + y.y + y.z + y.w) * (1.0f / 64.0f);
        const f32x4 d = y - mean;
        const float var = dpp_sum16(d.x * d.x + d.y * d.y + d.z * d.z + d.w * d.w) * (1.0f / 64.0f);
        const float rstd = rsqrtf(var + 64e-5f);
        const u32x2 ur = *(const u32x2*)(a.sr + (size_t)tl * 512 + ch), uk = *(const u32x2*)(a.sk + (size_t)tl * 512 + ch), uv = *(const u32x2*)(a.sv + (size_t)tl * 512 + ch);
        const f32x4 r4 = (f32x4){bf_lo(ur.x), bf_hi(ur.x), bf_lo(ur.y), bf_hi(ur.y)}, k4 = (f32x4){bf_lo(uk.x), bf_hi(uk.x), bf_lo(uk.y), bf_hi(uk.y)};
        const f32x4 v4 = (f32x4){bf_lo(uv.x), bf_hi(uv.x), bf_lo(uv.y), bf_hi(uv.y)};
        const f32x4 rkv = *(const f32x4*)(a.rk + ch), lw = *(const f32x4*)(a.lnw + ch), lb = *(const f32x4*)(a.lnb + ch);
        const f32x4 t = r4 * k4 * rkv;
        const float bon = dpp_sum16(t.x + t.y + t.z + t.w);
        const u32x2 gu = *(const u32x2*)(a.proj + (size_t)tl * NP + O_GR + ch);
        const f32x4 gg = (f32x4){bf_lo(gu.x), bf_hi(gu.x), bf_lo(gu.y), bf_hi(gu.y)};
        f32x4 o = d * rstd * lw + lb + v4 * bon;
#pragma unroll
        for (int j = 0; j < 4; ++j) o[j] *= siluf_(gg[j]);
        store4(a.ycat + (size_t)tl * 1024 + ch, o);
    }
}


struct CopArgs { const bf16_t *sr, *sk, *sv, *skk, *skka; const bf16_t* se; char* cops; };
__device__ __forceinline__ float mm16(const float* A, float sa, float ia, const float* B, float sb, float ib, int t, int j) {
    float acc = 0.f;
#pragma unroll
    for (int i = 0; i < 16; ++i) { const float av = sa * A[t * 17 + i] + (i == t ? ia : 0.f); const float bv = sb * B[i * 17 + j] + (i == j ? ib : 0.f); acc += av * bv; }
    return acc;
}
__device__ __forceinline__ float mm16p(const float* A, const float* B, int t, int j) {
    float acc = 0.f;
#pragma unroll
    for (int q = 0; q < 4; ++q) {
        const f32x4 a4 = *(const f32x4*)(A + t * 20 + q * 4);
        acc += a4.x * B[(q * 4 + 0) * 20 + j] + a4.y * B[(q * 4 + 1) * 20 + j] + a4.z * B[(q * 4 + 2) * 20 + j] + a4.w * B[(q * 4 + 3) * 20 + j];
    }
    return acc;
}
__device__ __forceinline__ f32x4 mm16m(const float* A, const float* B, int fr, int fq) {
    f32x4 acc = (f32x4){0.f, 0.f, 0.f, 0.f};
#pragma unroll
    for (int m = 0; m < 4; ++m) acc = __builtin_amdgcn_mfma_f32_16x16x4f32(A[fr * 20 + 4 * m + fq], B[(4 * m + fq) * 20 + fr], acc, 0, 0, 0);
    return acc;
}
__device__ __forceinline__ void mm16st(float* D, const f32x4 acc, int fr, int fq, float diag) {
#pragma unroll
    for (int jj = 0; jj < 4; ++jj) D[(4 * fq + jj) * 20 + fr] = acc[jj] + ((4 * fq + jj) == fr ? diag : 0.f);
}
__device__ __forceinline__ f32x4 unpk4(const u32x2 u) { return (f32x4){bf_lo(u.x), bf_hi(u.x), bf_lo(u.y), bf_hi(u.y)}; }
__device__ __forceinline__ bf16_t bf1(float x) { return (bf16_t)(pk_bf16(x, 0.f) & 0xffffu); }
struct CopIn { u32x2 ue, ukk, uka, uk, ur, uv; };
__device__ __forceinline__ void cop_in_load(CopIn& r, const CopArgs& a, int unit, int t, int cq) {
    const int c = unit & 255, bh = unit >> 8;
    const size_t gofs = ((size_t)(bh >> 3) * 4096 + c * 16 + t) * 512 + (bh & 7) * 64 + cq * 4;
    r.ue = *(const u32x2*)(a.se + gofs);
    r.ukk = *(const u32x2*)(a.skk + gofs); r.uka = *(const u32x2*)(a.skka + gofs); r.uk = *(const u32x2*)(a.sk + gofs); r.ur = *(const u32x2*)(a.sr + gofs); r.uv = *(const u32x2*)(a.sv + gofs);
}
__device__ void cop_phase(char* smem, const CopArgs& a) {
    const int tid = otid(), t = tid >> 4, cq = tid & 15, j = cq;
    float* F = (float*)smem;
    float* Wc = F; float* KAP = F + 1088; float* RT = F + 2176; float* KT = F + 3264; float* BT = F + 4352;
    float* SM = F + 5440;
    bf16_t* STG = (bf16_t*)(F + 5440 + 15 * 320);
#define SMAT(i) (SM + (i) * 320)
    int unit = blockIdx.x;
    if (unit >= 8192) return;
    CopIn cur, nxt;
    cop_in_load(cur, a, unit, t, cq);
    nxt = cur;
#pragma unroll 1
    for (; unit < 8192; unit += gridDim.x) {
        if (unit + (int)gridDim.x < 8192) cop_in_load(nxt, a, unit + gridDim.x, t, cq);
        __syncthreads();
        *(f32x4*)(Wc + t * 68 + cq * 4) = unpk4(cur.ue);
        __syncthreads();
        if (tid < 64) {
            float x[16];
#pragma unroll
            for (int i = 0; i < 16; ++i) x[i] = Wc[i * 68 + tid];
#pragma unroll
            for (int i = 1; i < 16; ++i) x[i] += x[i - 1];
#pragma unroll
            for (int i = 0; i < 16; ++i) Wc[i * 68 + tid] = x[i];
        }
        __syncthreads();
        const f32x4 ct = *(const f32x4*)(Wc + t * 68 + cq * 4), cC = *(const f32x4*)(Wc + 15 * 68 + cq * 4);
        f32x4 cp = (f32x4){0.f, 0.f, 0.f, 0.f}; if (t > 0) cp = *(const f32x4*)(Wc + (t - 1) * 68 + cq * 4);
        const f32x4 Wt = (f32x4){__expf(-ct.x), __expf(-ct.y), __expf(-ct.z), __expf(-ct.w)}, Wp = (f32x4){__expf(-cp.x), __expf(-cp.y), __expf(-cp.z), __expf(-cp.w)};
        const f32x4 WC = (f32x4){__expf(-cC.x), __expf(-cC.y), __expf(-cC.z), __expf(-cC.w)};
        {
            const f32x4 rW = (f32x4){__expf(ct.x), __expf(ct.y), __expf(ct.z), __expf(ct.w)};
            *(f32x4*)(KAP + t * 68 + cq * 4) = unpk4(cur.ukk) * Wp;
            *(f32x4*)(RT + t * 68 + cq * 4) = unpk4(cur.ur) * Wt;
            *(f32x4*)(KT + t * 68 + cq * 4) = unpk4(cur.uk) * rW;
            *(f32x4*)(BT + t * 68 + cq * 4) = unpk4(cur.uka) * rW;
        }
        __syncthreads();
        {
            const int wv = tid >> 6, ln = tid & 63, gfr = ln & 15, gfq = ln >> 4;
            const float* X = (wv < 2 ? KAP : RT) + gfr * 68 + gfq * 16;
            const float* Y = ((wv & 1) ? BT : KT) + gfr * 68 + gfq * 16;
            f32x4 acc = (f32x4){0.f, 0.f, 0.f, 0.f};
#pragma unroll
            for (int q = 0; q < 4; ++q) {
                const f32x4 xa = *(const f32x4*)(X + q * 4), ya = *(const f32x4*)(Y + q * 4);
                acc = __builtin_amdgcn_mfma_f32_16x16x4f32(xa.x, ya.x, acc, 0, 0, 0);
                acc = __builtin_amdgcn_mfma_f32_16x16x4f32(xa.y, ya.y, acc, 0, 0, 0);
                acc = __builtin_amdgcn_mfma_f32_16x16x4f32(xa.z, ya.z, acc, 0, 0, 0);
                acc = __builtin_amdgcn_mfma_f32_16x16x4f32(xa.w, ya.w, acc, 0, 0, 0);
            }
#pragma unroll
            for (int jj = 0; jj < 4; ++jj) {
                const int tt = gfq * 4 + jj, jc = gfr;
                const float v = (wv < 2 ? jc < tt : jc <= tt) ? acc[jj] : 0.f;
                SMAT(wv)[tt * 20 + jc] = v;
                if (wv == 1) SMAT(12)[tt * 20 + jc] = (tt == jc ? 1.f : 0.f) - v;
            }
        }
        __syncthreads();
        {
            const int wv = tid >> 6, ln = tid & 63, mfr = ln & 15, mfq = ln >> 4;
            if (wv == 0) { const f32x4 v = mm16m(SMAT(1), SMAT(1), mfr, mfq); mm16st(SMAT(4), v, mfr, mfq, 0.f); mm16st(SMAT(13), v, mfr, mfq, 1.f); }
            __syncthreads();
            if (wv == 0) { const f32x4 v = mm16m(SMAT(4), SMAT(4), mfr, mfq); mm16st(SMAT(5), v, mfr, mfq, 0.f); mm16st(SMAT(14), v, mfr, mfq, 1.f); }
            else if (wv == 1) mm16st(SMAT(7), mm16m(SMAT(12), SMAT(13), mfr, mfq), mfr, mfq, 0.f);
            __syncthreads();
            if (wv == 0) mm16st(SMAT(6), mm16m(SMAT(5), SMAT(5), mfr, mfq), mfr, mfq, 1.f);
            else if (wv == 1) mm16st(SMAT(8), mm16m(SMAT(7), SMAT(14), mfr, mfq), mfr, mfq, 0.f);
            __syncthreads();
            if (wv == 0) mm16st(SMAT(9), mm16m(SMAT(8), SMAT(6), mfr, mfq), mfr, mfq, 0.f);
            __syncthreads();
            if (wv == 0) mm16st(SMAT(10), mm16m(SMAT(9), SMAT(0), mfr, mfq), mfr, mfq, 0.f);
            else if (wv == 1) mm16st(SMAT(11), mm16m(SMAT(3), SMAT(9), mfr, mfq), mfr, mfq, 0.f);
            __syncthreads();
        }
        char* U = a.cops + (size_t)unit * COP_STRIDE;
        if (tid < 64) {
            const int mfr = tid & 15, mfq = tid >> 4; const f32x4 v = mm16m(SMAT(11), SMAT(0), mfr, mfq);
#pragma unroll
            for (int jj = 0; jj < 4; ++jj) ((bf16_t*)(U + 4096))[(4 * mfq + jj) * 16 + mfr] = bf1(SMAT(2)[(4 * mfq + jj) * 20 + mfr] - v[jj]);
        }
        {
            const int wv = tid >> 6, ln = tid & 63, ofr = ln & 15, ofq = ln >> 4, k = wv * 16 + ofr;
            f32x4 a3 = (f32x4){0.f, 0.f, 0.f, 0.f}, a1 = a3, ak = a3;
#pragma unroll
            for (int m = 0; m < 4; ++m) {
                const int i = 4 * m + ofq;
                const float kapv = KAP[i * 68 + k], btv = BT[i * 68 + k];
                a3 = __builtin_amdgcn_mfma_f32_16x16x4f32(SMAT(9)[ofr * 20 + i], kapv, a3, 0, 0, 0);
                a1 = __builtin_amdgcn_mfma_f32_16x16x4f32(SMAT(11)[ofr * 20 + i], kapv, a1, 0, 0, 0);
                ak = __builtin_amdgcn_mfma_f32_16x16x4f32(SMAT(10)[i * 20 + ofr], btv, ak, 0, 0, 0);
            }
            const float wck = __expf(-Wc[15 * 68 + k]);
            const int pk = 32 * (k >> 5) + 8 * ((k >> 2) & 3) + 4 * ((k >> 4) & 1) + (k & 3);
            bf16_t* QST = STG + 3072;
            float bh[4], khv[4];
#pragma unroll
            for (int jj = 0; jj < 4; ++jj) {
                const int tt = 4 * ofq + jj;
                QST[tt * 64 + pk] = bf1(a3[jj]);
                QST[(16 + tt) * 64 + pk] = bf1(RT[tt * 68 + k] - a1[jj]);
                const float btk = BT[tt * 68 + k];
                bh[jj] = btk * wck; khv[jj] = (KT[tt * 68 + k] - ak[jj]) * wck;
            }
            u32x4 wbk; wbk.x = pk_bf16(bh[0], bh[1]); wbk.y = pk_bf16(bh[2], bh[3]); wbk.z = pk_bf16(khv[0], khv[1]); wbk.w = pk_bf16(khv[2], khv[3]);
            *(u32x4*)((char*)STG + (k * 32 + ofq * 8) * 2) = wbk;
        }
        STG[2048 + (cq * 4 + 0) * 16 + t] = (bf16_t)(cur.uv.x & 0xffffu); STG[2048 + (cq * 4 + 1) * 16 + t] = (bf16_t)(cur.uv.x >> 16);
        STG[2048 + (cq * 4 + 2) * 16 + t] = (bf16_t)(cur.uv.y & 0xffffu); STG[2048 + (cq * 4 + 3) * 16 + t] = (bf16_t)(cur.uv.y >> 16);
        if (tid < 64) ((float*)(U + 10752))[tid] = __expf(-Wc[15 * 68 + tid]);
        __syncthreads();
        *(u32x4*)(U + tid * 16) = *(const u32x4*)((const char*)STG + 6144 + tid * 16);
        *(u32x4*)(U + 4608 + tid * 16) = *(const u32x4*)((const char*)STG + tid * 16);
        if (tid < 128) *(u32x4*)(U + 8704 + tid * 16) = *(const u32x4*)((const char*)STG + 4096 + tid * 16);
        cur = nxt;
    }
#undef SMAT
}

__device__ __forceinline__ int cop_lds_of(int q) {
    if (q < 256) { const int row = q >> 3, pos = q & 7; return row * 128 + ((pos ^ ((row >> 1) & 7)) << 4); }
    if (q < 288) return q * 16;
    if (q < 544) { const int q2 = q - 288; return 4608 + (q2 & 3) * 1024 + (q2 >> 2) * 16; }
    return q * 16;
}
struct CopOps { u32x4 qc[2][2]; u32x2 q2; u32x4 bk[4]; u32x2 vt; f32x4 wc[4]; };
__device__ void chunk_scan(char* smem, const char* cops, float* yraw, int bl, int hh) {
    const int tid = otid(), lane = tid & 63, w = tid >> 6, fr = lane & 15, fq = lane >> 4;
    f32x4 st[4];
#pragma unroll
    for (int kt = 0; kt < 4; ++kt) st[kt] = (f32x4){0.f, 0.f, 0.f, 0.f};
    const char* U = cops + (size_t)((bl * 8 + hh) * 256) * COP_STRIDE + tid * 16;
    float* yp = yraw + ((size_t)bl * 4096 + fq * 4) * 512 + hh * 64 + w * 16 + fr;
    const int l0 = cop_lds_of(tid), l1 = cop_lds_of(tid + 256), l2 = cop_lds_of(tid < 176 ? tid + 512 : 0);
    const bool has2 = tid < 176;
    const int qo0 = fr * 128 + (((0 * 4 + fq) ^ ((fr >> 1) & 7)) << 4), qo1 = fr * 128 + (((1 * 4 + fq) ^ ((fr >> 1) & 7)) << 4);
    const int q2o = 4096 + fr * 32 + fq * 8, bko = 4608 + fq * 1024 + fr * 16, vto = 8704 + (w * 16 + fr) * 32 + fq * 8, wco = 10752 + fq * 16;
    u32x4 sA[3], sB[3], sC[3], sD[3];
    __builtin_amdgcn_s_setprio(3);
#define CS_LOAD(S, C) do { const char* g_ = U + (size_t)(C) * COP_STRIDE; S[0] = *(const u32x4*)g_; S[1] = *(const u32x4*)(g_ + 4096); if (has2) S[2] = *(const u32x4*)(g_ + 8192); } while (0)
#define CS_WRITE(S, SLOT) do { char* d_ = smem + (SLOT) * 11008; *(u32x4*)(d_ + l0) = S[0]; *(u32x4*)(d_ + l1) = S[1]; if (has2) *(u32x4*)(d_ + l2) = S[2]; } while (0)
    sA[2] = (u32x4){0u, 0u, 0u, 0u}; sB[2] = sA[2]; sC[2] = sA[2]; sD[2] = sA[2];
    CS_LOAD(sA, 0); CS_LOAD(sB, 1); CS_LOAD(sC, 2); CS_LOAD(sD, 3);
    CopOps R0, R1;
    auto ldsload = [&](CopOps& r, const char* L) {
        r.qc[0][0] = *(const u32x4*)(L + qo0); r.qc[0][1] = *(const u32x4*)(L + qo1); r.qc[1][0] = *(const u32x4*)(L + 2048 + qo0); r.qc[1][1] = *(const u32x4*)(L + 2048 + qo1);
        r.q2 = *(const u32x2*)(L + q2o); r.vt = *(const u32x2*)(L + vto);
#pragma unroll
        for (int kt = 0; kt < 4; ++kt) { r.bk[kt] = *(const u32x4*)(L + bko + kt * 256); r.wc[kt] = *(const f32x4*)(L + wco + kt * 64); }
    };
    auto compute = [&](const int c, const CopOps& r) {
        const u32x4 (&qc)[2][2] = r.qc; const u32x4 (&bk)[4] = r.bk; const f32x4 (&wc)[4] = r.wc; const u32x2 q2 = r.q2, vt = r.vt;
        u32x4 hi[2], lo[2];
#pragma unroll
        for (int s = 0; s < 2; ++s) {
            const f32x4 a0 = st[2 * s], a1 = st[2 * s + 1];
            hi[s].x = pk_bf16(a0.x, a0.y); hi[s].y = pk_bf16(a0.z, a0.w); hi[s].z = pk_bf16(a1.x, a1.y); hi[s].w = pk_bf16(a1.z, a1.w);
            lo[s].x = pk_bf16(a0.x - bf_lo(hi[s].x), a0.y - bf_hi(hi[s].x)); lo[s].y = pk_bf16(a0.z - bf_lo(hi[s].y), a0.w - bf_hi(hi[s].y));
            lo[s].z = pk_bf16(a1.x - bf_lo(hi[s].z), a1.y - bf_hi(hi[s].z)); lo[s].w = pk_bf16(a1.z - bf_lo(hi[s].w), a1.w - bf_hi(hi[s].w));
        }
        f32x4 p1 = (f32x4){0.f, 0.f, 0.f, 0.f}, p2 = p1;
#pragma unroll
        for (int s = 0; s < 2; ++s) {
            p1 = __builtin_amdgcn_mfma_f32_16x16x32_bf16(__builtin_bit_cast(bf16x8, qc[0][s]), __builtin_bit_cast(bf16x8, hi[s]), p1, 0, 0, 0);
            p2 = __builtin_amdgcn_mfma_f32_16x16x32_bf16(__builtin_bit_cast(bf16x8, qc[1][s]), __builtin_bit_cast(bf16x8, hi[s]), p2, 0, 0, 0);
            p1 = __builtin_amdgcn_mfma_f32_16x16x32_bf16(__builtin_bit_cast(bf16x8, qc[0][s]), __builtin_bit_cast(bf16x8, lo[s]), p1, 0, 0, 0);
            p2 = __builtin_amdgcn_mfma_f32_16x16x32_bf16(__builtin_bit_cast(bf16x8, qc[1][s]), __builtin_bit_cast(bf16x8, lo[s]), p2, 0, 0, 0);
        }
        p2 = __builtin_amdgcn_mfma_f32_16x16x32_bf16(__builtin_bit_cast(bf16x8, ((u32x4){q2.x, q2.y, 0u, 0u})), __builtin_bit_cast(bf16x8, ((u32x4){vt.x, vt.y, 0u, 0u})), p2, 0, 0, 0);
#pragma unroll
        for (int j = 0; j < 4; ++j) yp[(size_t)(c * 16 + j) * 512] = p2[j];
        u32x4 xh, xl;
        xh.x = pk_bf16(-p1.x, -p1.y); xh.y = pk_bf16(-p1.z, -p1.w); xh.z = vt.x; xh.w = vt.y;
        xl.x = pk_bf16(-p1.x - bf_lo(xh.x), -p1.y - bf_hi(xh.x)); xl.y = pk_bf16(-p1.z - bf_lo(xh.y), -p1.w - bf_hi(xh.y)); xl.z = 0u; xl.w = 0u;
#pragma unroll
        for (int kt = 0; kt < 4; ++kt) {
            f32x4 acc = st[kt] * wc[kt];
            acc = __builtin_amdgcn_mfma_f32_16x16x32_bf16(__builtin_bit_cast(bf16x8, bk[kt]), __builtin_bit_cast(bf16x8, xh), acc, 0, 0, 0);
            acc = __builtin_amdgcn_mfma_f32_16x16x32_bf16(__builtin_bit_cast(bf16x8, bk[kt]), __builtin_bit_cast(bf16x8, xl), acc, 0, 0, 0);
            st[kt] = acc;
        }
    };
    CS_WRITE(sA, 0); CS_LOAD(sA, 4);
    __syncthreads();
    ldsload(R0, smem);
#define CS_STEP(S, C, RC, RN) do { if ((C) + 1 < 256) CS_WRITE(S, ((C) + 1) & 1); if ((C) + 5 < 256) CS_LOAD(S, (C) + 5); __syncthreads(); \
        if ((C) + 1 < 256) ldsload(RN, smem + (((C) + 1) & 1) * 11008); compute((C), RC); } while (0)
#pragma unroll 1
    for (int c = 0; c < 256; c += 4) { CS_STEP(sB, c, R0, R1); CS_STEP(sC, c + 1, R1, R0); CS_STEP(sD, c + 2, R0, R1); CS_STEP(sA, c + 3, R1, R0); }
#undef CS_STEP
#undef CS_LOAD
#undef CS_WRITE
    __builtin_amdgcn_s_setprio(0);
    __syncthreads();
}

__global__ void __launch_bounds__(256, 2) fwd_megakernel(Params p) {
    __shared__ __attribute__((aligned(16))) char smem[65536 + 64];
    cg::grid_group grid = cg::this_grid();
    if (threadIdx.x == 0) { ((volatile LAS unsigned*)(smem + 65536))[0] = 0u; ((volatile LAS unsigned*)(smem + 65536))[1] = 0u; }
    __syncthreads();
    const XcdBarrier xb = xcd_barrier_post((unsigned*)(p.ws + OFF_BAR), (volatile LAS unsigned*)(smem + 65536));
    const unsigned cu_key = (xb.x & 7u) * 256u + ((unsigned)__builtin_amdgcn_s_getreg((7 << 11) | (8 << 6) | 4) & 0xffu);
    if (threadIdx.x == 0) (void)xb_add((unsigned*)(p.ws + OFF_CUCNT) + cu_key, 1u);
    char* ws = p.ws;
    float* mod = (float*)(ws + OFF_MOD);
    const float* cs = (const float*)(ws + OFF_COS); const float* sn = (const float*)(ws + OFF_SIN);
    bf16_t* hbuf = (bf16_t*)(ws + OFF_H);
    bf16_t* proj = (bf16_t*)(ws + OFF_PROJ);
    bf16_t *sr = (bf16_t*)(ws + OFF_SR), *sk = (bf16_t*)(ws + OFF_SK), *sv = (bf16_t*)(ws + OFF_SV), *skk = (bf16_t*)(ws + OFF_SKK), *skka = (bf16_t*)(ws + OFF_SKKA);
    bf16_t* se = (bf16_t*)(ws + OFF_SW);
    float *rsq = (float*)(ws + OFF_RSQ), *rskv = (float*)(ws + OFF_RSKV);
    bf16_t *Qh = (bf16_t*)(ws + OFF_Q), *Kh = (bf16_t*)(ws + OFF_K), *Vt = (bf16_t*)(ws + OFF_VT);
    float* yraw = (float*)(ws + OFF_YRAW);
    bf16_t* ycat = (bf16_t*)(ws + OFF_YCAT);
    bf16_t* vfirst = (bf16_t*)(ws + OFF_VFIRST);
    int* ctrl = (int*)(ws + OFF_CTRL);
    volatile int* s_item = (volatile int*)(smem + 65536 + 16);

    for (int rep = 0; rep < REP_P0; ++rep) prologue(smem, p);
    grid.sync();
    bool scan_role;
    {
        const unsigned k2 = (cu_key & ~255u) + threadIdx.x;
        const int lidx = __syncthreads_count(k2 < cu_key && xb_ld((unsigned*)(p.ws + OFF_CUCNT) + k2) > 0u);
        scan_role = lidx < 24;
    }

    norm_phase(p.x, p.norm_g, mod, hbuf, 0);
    GSYNC();
#pragma unroll 1
    for (int l = 0; l < NL; ++l) {
        const float* modl = mod + (size_t)l * 8 * 3072;
#pragma unroll 1
        for (int half = 0; half < 2; ++half) {
            const int tgbase = half * TH;
            {
                EpiProj e{proj, rsq, rskv, smem};
                const bf16_t* A = hbuf; const bf16_t* Bt = (const bf16_t*)(ws + OFF_WIN) + (size_t)l * NP * 1024;
                const int xcd = blockIdx.x & 7, loc = blockIdx.x >> 3, nloc = gridDim.x >> 3;
                for (int rep = 0; rep < REP_P2; ++rep) {
                if (rep) xcd_barrier(xb);
                for (int jn = loc; jn < 432; jn += nloc) {
                    const int mg = jn / 216, rem = jn - mg * 216, nt = rem >> 3, mi = rem & 7, mt = xcd * 16 + mg * 8 + mi;
                    gemm_tile(smem, A, 1024, Bt, 1024, 1024, mt * 128, nt * 128, e);
                }
                }
            }
            GSYNC();
            {
                PrepArgs pa;
                pa.proj = proj; pa.mu = p.mu_shift + l * 1664; pa.muv = p.mu_vmix + (l > 0 ? (l - 1) * 32 : 0);
                pa.wdec = (const bf16_t*)(ws + OFF_WDEC) + (size_t)l * 512 * 64; pa.wicl = (const bf16_t*)(ws + OFF_WICL) + (size_t)l * 512 * 64;
                pa.wvm = (const bf16_t*)(ws + OFF_WVM) + (size_t)l * 512 * 32;
                pa.w0 = p.w0 + l * 512; pa.a0 = p.a0 + l * 512; pa.v0 = p.v0 + (l > 0 ? (l - 1) * 512 : 0); pa.k_k = p.k_k + l * 512; pa.k_a = p.k_a + l * 512;
                pa.cs = cs; pa.sn = sn; pa.sr = sr; pa.sk = sk; pa.sv = sv; pa.skk = skk; pa.skka = skka; pa.se = se; pa.vfirst = vfirst; pa.Kh = Kh;
                pa.layer = l; pa.tgbase = tgbase;
                EpiKV ekv{Kh, Vt, rskv, smem};
                EpiQ eq{Qh, rsq, cs, sn, tgbase, smem};
                const bf16_t* Bkv = (const bf16_t*)(ws + OFF_WUKV) + (size_t)l * 1024 * 256; const bf16_t* Bq = (const bf16_t*)(ws + OFF_WUQ) + (size_t)l * 768 * 384;
                for (int rep = 0; rep < REP_P3; ++rep) {
                if (rep) xcd_barrier(xb);
                {
                    for (int it = blockIdx.x; it < 1024; it += gridDim.x) prep_tile(smem, pa, it >> 2, it & 3);
                    const int xcd = blockIdx.x & 7, loc = blockIdx.x >> 3, nloc = gridDim.x >> 3;
                    for (int j = loc; j < 128; j += nloc) gemm_tile(smem, proj + O_CKV, NP, Bkv, 256, 256, (xcd * 16 + (j >> 3)) * 128, (j & 7) * 128, ekv);
                    for (int j = loc; j < 96; j += nloc) { const int ml = j / 6, nt = j - ml * 6; gemm_tile(smem, proj + O_CQ, NP, Bq, 384, 384, (xcd * 16 + ml) * 128, nt * 128, eq); }
                }
                }
            }
            GSYNC();
            {
                CopArgs ca{sr, sk, sv, skk, skka, se, ws + OFF_COPS};
                cop_phase(smem, ca);
            }
            GSYNC();
            {
                int* ctr = ctrl + (l * 2 + half);
                for (;;) {
                    __syncthreads();
                    if (threadIdx.x == 0) *s_item = atomicAdd(ctr, 1);
                    __syncthreads();
                    const int item = *s_item;
                    const int nconv = (half == 0 && l + 1 < NL) ? 512 : 0;
                    if (item >= 32 + 1024 + nconv) break;
                    if (item < 32) chunk_scan(smem, ws + OFF_COPS, yraw, item >> 3, item & 7);
                    else if (item < 32 + 1024) { const int t = item - 32, qt = 31 - (t >> 5), bh = t & 31; attn_tile(smem, Qh, Kh, Vt, proj, ycat, bh >> 3, bh & 7, qt); }
                    else convert_layer(smem, p, l + 1, item - (32 + 1024), 512);
                }
            }
            GSYNC();
            {
                FinArgs fa{yraw, sr, sk, sv, proj, p.lnx_w + l * 512, p.lnx_b + l * 512, p.r_k + l * 512, ycat, nullptr, nullptr};
                for (int rep = 0; rep < REP_P5; ++rep) { if (rep) xcd_barrier(xb); rwkv_finalize(fa); }
                const int ln = half == 0 ? l : l + 1, hn = half ^ 1;
                if (ln < NL) norm_phase(ln == 0 ? p.x : p.out, p.norm_g + ln * 1024, mod + (size_t)ln * 8 * 3072, hbuf, hn * TH);
            }
            GSYNC();
            {
                for (int rep = 0; rep < REP_P6; ++rep) {
                if (rep) xcd_barrier(xb);
                EpiOut eo{l == 0 ? p.x : p.out, p.out, modl, tgbase, rep == REP_P6 - 1 ? 1.0f : 0.0f};
                const bf16_t* Bo = (const bf16_t*)(ws + OFF_WOUT) + (size_t)l * 1024 * 1024;
                {
                    const int xcd = blockIdx.x & 7, loc = blockIdx.x >> 3, nloc = gridDim.x >> 3;
                    for (int j = loc; j < 128; j += nloc) gemm_tile(smem, ycat, 1024, Bo, 1024, 1024, (xcd * 16 + (j >> 3)) * 128, (j & 7) * 128, eo);
                }
                }
            }
        }
    }
    GSYNC();
    final_norm(p.out, p.final_g);
}

extern "C" void kernel_launch(void* const* d_in, const int* in_sizes, int n_in, void* d_out, int out_size, void* d_ws, size_t ws_size, hipStream_t stream) {
    static int grid_blocks = 0;
    if (!grid_blocks) {
        int dev = 0, cus = 0, per_cu = 0;
        (void)hipGetDevice(&dev);
        (void)hipDeviceGetAttribute(&cus, hipDeviceAttributeMultiprocessorCount, dev);
        (void)hipOccupancyMaxActiveBlocksPerMultiprocessor(&per_cu, fwd_megakernel, 256, 0);
        if (per_cu > 2) per_cu = 2;
        if (per_cu < 1) per_cu = 1;
        grid_blocks = cus * per_cu;
        if (grid_blocks % 8) grid_blocks -= grid_blocks % 8;
    }
    Params p{};
    p.x = (const float*)d_in[0]; p.c = (const float*)d_in[1]; p.pos = (const int*)d_in[2];
    p.norm_g = (const float*)d_in[3]; p.w_ada = (const float*)d_in[4]; p.b_ada = (const float*)d_in[5]; p.w_in = (const float*)d_in[6];
    p.w_vmd = (const float*)d_in[7]; p.mu_shift = (const float*)d_in[8]; p.mu_vmix = (const float*)d_in[9]; p.w0 = (const float*)d_in[10];
    p.w_dec = (const float*)d_in[11]; p.a0 = (const float*)d_in[12]; p.w_icl = (const float*)d_in[13]; p.v0 = (const float*)d_in[14];
    p.w_vmu = (const float*)d_in[15]; p.k_k = (const float*)d_in[16]; p.k_a = (const float*)d_in[17]; p.r_k = (const float*)d_in[18];
    p.lnx_w = (const float*)d_in[19]; p.lnx_b = (const float*)d_in[20]; p.qng = (const float*)d_in[21]; p.kvng = (const float*)d_in[22];
    p.w_uq = (const float*)d_in[23]; p.w_ukv = (const float*)d_in[24]; p.w_out = (const float*)d_in[25]; p.final_g = (const float*)d_in[26];
    p.out = (float*)d_out; p.ws = (char*)d_ws;
    (void)hipMemsetAsync((char*)d_ws + OFF_BAR, 0, 16384 + 4096 + 8192, stream);
    void* args[] = {&p};
    hipError_t e = hipLaunchCooperativeKernel((void*)fwd_megakernel, dim3(grid_blocks), dim3(256), args, 0, stream);
    if (e != hipSuccess) fprintf(stderr, "cooperative launch failed: %s (grid %d)\n", hipGetErrorString(e), grid_blocks);
}
```

```cpp
#include <hip/hip_runtime.h>
#include <hip/hip_cooperative_groups.h>
#include <cstdio>
#include <cstdint>
namespace cg = cooperative_groups;
constexpr int REP_P1 = 1, REP_P2 = 1, REP_P3 = 1, REP_P4 = 1, REP_P5 = 1, REP_P6 = 1, REP_SYNC = 1, REP_P0 = 1;
#define GSYNC() do { for (int r_ = 0; r_ < REP_SYNC; ++r_) xcd_barrier(xb); } while (0)


typedef unsigned short bf16_t;
typedef short bf16x8 __attribute__((ext_vector_type(8)));
typedef float f32x4 __attribute__((ext_vector_type(4)));
typedef float f32x2 __attribute__((ext_vector_type(2)));
typedef unsigned u32x4 __attribute__((ext_vector_type(4)));
typedef unsigned u32x2 __attribute__((ext_vector_type(2)));
#define LAS __attribute__((address_space(3)))

constexpr int DM = 1024, NB = 8, SEQ = 4096, NT = NB * SEQ, TH = NT / 2, NL = 4;
constexpr int NP = 3456;
constexpr int O_GR = 1664, O_CQ = 2176, O_CKV = 2560, O_KR = 2816, O_GM = 2848, INW = 3360;
constexpr float QSCALE = 0.10206207261596577f * 1.4426950408889634f;

constexpr size_t al256(size_t x) { return (x + 255) & ~(size_t)255; }
constexpr size_t OFF_BAR = 0;
constexpr size_t OFF_CTRL = 16384;
constexpr size_t OFF_CUCNT = 16384 + 4096;
constexpr size_t OFF_MOD = 16384 + 4096 + 8192;
constexpr size_t OFF_COS = OFF_MOD + al256((size_t)NL * NB * 3072 * 4);
constexpr size_t OFF_SIN = OFF_COS + (size_t)NT * 16 * 4;
constexpr size_t OFF_WIN = OFF_SIN + (size_t)NT * 16 * 4;
constexpr size_t OFF_WOUT = OFF_WIN + (size_t)NL * NP * 1024 * 2;
constexpr size_t OFF_WUQ = OFF_WOUT + (size_t)NL * 1024 * 1024 * 2;
constexpr size_t OFF_WUKV = OFF_WUQ + (size_t)NL * 768 * 384 * 2;
constexpr size_t OFF_WDEC = OFF_WUKV + (size_t)NL * 1024 * 256 * 2;
constexpr size_t OFF_WICL = OFF_WDEC + (size_t)NL * 512 * 64 * 2;
constexpr size_t OFF_WVM = OFF_WICL + (size_t)NL * 512 * 64 * 2;
constexpr size_t OFF_VFIRST = OFF_WVM + (size_t)NL * 512 * 32 * 2;
constexpr size_t OFF_H = OFF_VFIRST + (size_t)NT * 512 * 2;
constexpr int COP_STRIDE = 11008;
constexpr size_t OFF_COPS = OFF_H;
constexpr size_t OFF_PROJ = OFF_H + (size_t)8192 * COP_STRIDE;
constexpr size_t OFF_SR = OFF_PROJ + (size_t)TH * NP * 2;
constexpr size_t OFF_SK = OFF_SR + (size_t)TH * 512 * 2;
constexpr size_t OFF_SV = OFF_SK + (size_t)TH * 512 * 2;
constexpr size_t OFF_SKK = OFF_SV + (size_t)TH * 512 * 2;
constexpr size_t OFF_SKKA = OFF_SKK + (size_t)TH * 512 * 2;
constexpr size_t OFF_SW = OFF_SKKA + (size_t)TH * 512 * 2;
constexpr size_t OFF_RSQ = OFF_SW + (size_t)TH * 512 * 4;
constexpr size_t OFF_RSKV = OFF_RSQ + (size_t)TH * 8 * 4;
constexpr size_t OFF_Q = OFF_RSKV + (size_t)TH * 4 * 4;
constexpr size_t OFF_K = OFF_Q + (size_t)TH * 768 * 2;
constexpr size_t OFF_VT = OFF_K + (size_t)TH * 768 * 2;
constexpr size_t OFF_YRAW = OFF_VT + (size_t)TH * 512 * 2;
constexpr size_t OFF_YCAT = OFF_YRAW + (size_t)TH * 512 * 4;
constexpr size_t WS_TOTAL = OFF_YCAT + (size_t)TH * 1024 * 2;
static_assert(WS_TOTAL <= (size_t)536870912, "workspace exceeds 512 MiB");

struct Params {
    const float *x, *c; const int* pos;
    const float *norm_g, *w_ada, *b_ada, *w_in, *w_vmd, *mu_shift, *mu_vmix, *w0, *w_dec, *a0, *w_icl, *v0, *w_vmu;
    const float *k_k, *k_a, *r_k, *lnx_w, *lnx_b, *qng, *kvng, *w_uq, *w_ukv, *w_out, *final_g;
    float* out; char* ws;
};

__device__ __forceinline__ int otid() { int t = threadIdx.x; asm volatile("" : "+v"(t)); return t; }
__device__ __forceinline__ unsigned pk_bf16(float lo, float hi) { unsigned r; asm("v_cvt_pk_bf16_f32 %0, %1, %2" : "=v"(r) : "v"(lo), "v"(hi)); return r; }
__device__ __forceinline__ float bf_lo(unsigned u) { return __uint_as_float(u << 16); }
__device__ __forceinline__ float bf_hi(unsigned u) { return __uint_as_float(u & 0xffff0000u); }
__device__ __forceinline__ float sigmoidf_(float x) { return __builtin_amdgcn_rcpf(1.0f + __expf(-x)); }
__device__ __forceinline__ float siluf_(float x) { return x * __builtin_amdgcn_rcpf(1.0f + __expf(-x)); }
__device__ __forceinline__ float tanhf_(float x) { const float t = __expf(2.0f * x); return 1.0f - 2.0f * __builtin_amdgcn_rcpf(t + 1.0f); }
template <int CTRL> __device__ __forceinline__ float dpp_add(float x) {
    return x + __int_as_float(__builtin_amdgcn_update_dpp(0, __float_as_int(x), CTRL, 0xf, 0xf, true));
}
__device__ __forceinline__ float dpp_sum16(float x) {
    x = dpp_add<0xB1>(x);
    x = dpp_add<0x4E>(x);
    x = dpp_add<0x141>(x);
    x = dpp_add<0x140>(x);
    return x;
}
__device__ __forceinline__ void dpp_sum16x2(float& a, float& b) {
    a = dpp_add<0xB1>(a); b = dpp_add<0xB1>(b);
    a = dpp_add<0x4E>(a); b = dpp_add<0x4E>(b);
    a = dpp_add<0x141>(a); b = dpp_add<0x141>(b);
    a = dpp_add<0x140>(a); b = dpp_add<0x140>(b);
}
__device__ __forceinline__ float wave_sum64(float x) {
    x += __shfl_xor(x, 1); x += __shfl_xor(x, 2); x += __shfl_xor(x, 4); x += __shfl_xor(x, 8); x += __shfl_xor(x, 16); x += __shfl_xor(x, 32);
    return x;
}


#define XB_TMO      128
#define XB_XCNT(j)  (256  + 64 * (j))
#define XB_XSUB(j)  (1280 + 64 * (j))
#define XB_XGEN(j)  (2304 + 64 * (j))
#define XB_TOP      3328
#define XB_TOPGEN   3392
#define XCD_BAR_WORDS 3456
#define XB_SPIN_CAP (1u << 18)
__device__ __forceinline__ unsigned xb_ld(unsigned* p)              { return __hip_atomic_load(p, __ATOMIC_RELAXED, __HIP_MEMORY_SCOPE_AGENT); }
__device__ __forceinline__ unsigned xb_add(unsigned* p, unsigned v) { return __hip_atomic_fetch_add(p, v, __ATOMIC_RELAXED, __HIP_MEMORY_SCOPE_AGENT); }
__device__ __forceinline__ unsigned xb_xcc_id() { return (unsigned)__builtin_amdgcn_s_getreg((3 << 11) | 20) & 0xFu; }
#define XB_SPIN(cond, bar) do { unsigned _sp = 0; while (cond) { __builtin_amdgcn_s_sleep(1); \
    if ((++_sp & 255u) == 0u) { if (xb_ld(&(bar)[XB_TMO])) break; if (_sp > XB_SPIN_CAP) { atomicAdd(&(bar)[XB_TMO], 1u); break; } } } } while (0)
struct XcdBarrier { unsigned* bar; unsigned x; volatile LAS unsigned* st; };
__device__ __forceinline__ XcdBarrier xcd_barrier_post(unsigned* bar, volatile LAS unsigned* st) {
    XcdBarrier b; b.bar = bar; b.x = xb_xcc_id(); b.st = st;
    if (threadIdx.x == 0) (void)xb_add(&bar[XB_XCNT(b.x)], 1u);
    return b;
}
__device__ __forceinline__ void xcd_barrier_complete(unsigned* bar, unsigned x, unsigned& nloc, unsigned& nx) {
    const unsigned G = gridDim.x * gridDim.y * gridDim.z;
    unsigned sum, cnt, mine, sp = 0u;
    for (;;) {
        sum = 0u; cnt = 0u; mine = 0u;
#pragma unroll
        for (unsigned j = 0; j < 16; ++j) { const unsigned c = xb_ld(&bar[XB_XCNT(j)]); sum += c; cnt += (c > 0u) ? 1u : 0u; mine = (j == x) ? c : mine; }
        if (sum == G) break;
        __builtin_amdgcn_s_sleep(1);
        if ((++sp & 255u) == 0u) { if (xb_ld(&bar[XB_TMO])) break; if (sp > XB_SPIN_CAP) { atomicAdd(&bar[XB_TMO], 1u); break; } }
    }
    nloc = mine > 0u ? mine : 1u; nx = cnt > 0u ? cnt : 1u;
}
__device__ __forceinline__ void xcd_barrier(const XcdBarrier& b) {
    asm volatile("s_waitcnt vmcnt(0)" ::: "memory");
    __syncthreads();
    if (threadIdx.x == 0) {
        unsigned* bar = b.bar;
        __builtin_amdgcn_s_waitcnt(0);
        unsigned nloc = b.st[0], nx = b.st[1];
        if (nloc == 0u) { xcd_barrier_complete(bar, b.x, nloc, nx); b.st[0] = nloc; b.st[1] = nx; }
        const unsigned old = xb_add(&bar[XB_XSUB(b.x)], 1u);
        const unsigned gen = old / nloc;
        if (old + 1u == (gen + 1u) * nloc) {
            __builtin_amdgcn_fence(__ATOMIC_RELEASE, "agent");
            asm volatile("s_waitcnt vmcnt(0)" ::: "memory");
            const unsigned og = xb_add(&bar[XB_TOP], 1u);
            const unsigned tg = og / nx;
            if (og + 1u == (tg + 1u) * nx) xb_add(&bar[XB_TOPGEN], 1u);
            else XB_SPIN(xb_ld(&bar[XB_TOPGEN]) == tg, bar);
            __builtin_amdgcn_fence(__ATOMIC_ACQUIRE, "agent");
            xb_add(&bar[XB_XGEN(b.x)], 1u);
            asm volatile("s_waitcnt vmcnt(0)" ::: "memory");
        } else {
            XB_SPIN(xb_ld(&bar[XB_XGEN(b.x)]) == gen, bar);
            __builtin_amdgcn_fence(__ATOMIC_ACQUIRE, "agent");
            asm volatile("s_waitcnt vmcnt(0)" ::: "memory");
        }
    }
    __syncthreads();
}

__device__ void transpose_job(float* tile, const float* __restrict__ src, int ld, int K, int N, bf16_t* __restrict__ dst, int dst_rows,
                              const float* __restrict__ kscale, const float* __restrict__ src2, int ld2, int n2lo, int n2hi, int& rot, int idx, int nidx) {
    const int nkt = (K + 63) >> 6, nnt = (dst_rows + 63) >> 6, ntiles = nkt * nnt;
    const int tid_ = otid(); const int tx = tid_ & 63, ty = tid_ >> 6;
    const int first = (idx + nidx - rot % nidx) % nidx;
    rot += ntiles;
    for (int t = first; t < ntiles; t += nidx) {
        const int kt = t % nkt, nt = t / nkt, k0 = kt * 64, n0 = nt * 64;
#pragma unroll 4
        for (int i = 0; i < 16; ++i) {
            const int k = k0 + ty + 4 * i, n = n0 + tx; float v = 0.f;
            if (k < K) {
                if (n < N) { v = src[(size_t)k * ld + n]; if (kscale) v *= kscale[k]; }
                else if (src2 && n >= n2lo && n < n2hi) v = src2[(size_t)k * ld2 + (n - n2lo)];
            }
            tile[(ty + 4 * i) * 65 + tx] = v;
        }
        __syncthreads();
#pragma unroll 4
        for (int i = 0; i < 16; ++i) {
            const int n = n0 + ty + 4 * i, k = k0 + tx;
            if (n < dst_rows && k < K) dst[(size_t)n * K + k] = (bf16_t)(pk_bf16(tile[tx * 65 + ty + 4 * i], 0.f) & 0xffffu);
        }
        __syncthreads();
    }
}

__device__ void mod_job(float* lds, const Params& p, float* __restrict__ mod) {
    float* cact = lds;
    float* red = lds + 8192;
    const int tid = otid();
    bool have = false;
    for (int it = (int)gridDim.x - 1 - (int)blockIdx.x; it < 192; it += gridDim.x) {
        if (!have) {
            for (int i = tid; i < 8192; i += 256) cact[i] = siluf_(p.c[i]);
            have = true;
            __syncthreads();
        }
        const int l = it / 48, n0 = (it % 48) * 64, kg = tid >> 6, n = n0 + (tid & 63);
        float a0 = 0.f, a1 = 0.f, a2 = 0.f, a3 = 0.f, a4 = 0.f, a5 = 0.f, a6 = 0.f, a7 = 0.f;
        const float* wp = p.w_ada + ((size_t)l * 1024 + kg * 256) * 3072 + n;
#pragma unroll 8
        for (int k = 0; k < 256; ++k) {
            const float w = wp[(size_t)k * 3072]; const int kk = kg * 256 + k;
            a0 += cact[kk] * w; a1 += cact[1024 + kk] * w; a2 += cact[2048 + kk] * w; a3 += cact[3072 + kk] * w;
            a4 += cact[4096 + kk] * w; a5 += cact[5120 + kk] * w; a6 += cact[6144 + kk] * w; a7 += cact[7168 + kk] * w;
        }
        float* rp = red + (kg * 64 + (tid & 63)) * 8;
        rp[0] = a0; rp[1] = a1; rp[2] = a2; rp[3] = a3; rp[4] = a4; rp[5] = a5; rp[6] = a6; rp[7] = a7;
        __syncthreads();
        {
#pragma unroll
            for (int q = 0; q < 2; ++q) {
                const int o = tid + 256 * q, nn = o >> 3, b = o & 7;
                const float s = red[(0 * 64 + nn) * 8 + b] + red[(1 * 64 + nn) * 8 + b] + red[(2 * 64 + nn) * 8 + b] + red[(3 * 64 + nn) * 8 + b];
                mod[((size_t)l * 8 + b) * 3072 + n0 + nn] = s + p.b_ada[l * 3072 + n0 + nn];
            }
        }
        __syncthreads();
    }
}

__device__ void convert_layer(char* smem, const Params& p, int l, int idx, int nidx) {
    char* ws = p.ws; float* tile = (float*)smem; int rot = 0;
    transpose_job(tile, p.w_in + (size_t)l * 1024 * INW, INW, 1024, INW, (bf16_t*)(ws + OFF_WIN) + (size_t)l * NP * 1024, NP, nullptr,
                  l > 0 ? p.w_vmd + (size_t)(l - 1) * 1024 * 32 : nullptr, 32, INW, INW + 32, rot, idx, nidx);
    transpose_job(tile, p.w_out + (size_t)l * 1024 * 1024, 1024, 1024, 1024, (bf16_t*)(ws + OFF_WOUT) + (size_t)l * 1024 * 1024, 1024, nullptr, nullptr, 0, 0, 0, rot, idx, nidx);
    transpose_job(tile, p.w_uq + (size_t)l * 384 * 768, 768, 384, 768, (bf16_t*)(ws + OFF_WUQ) + (size_t)l * 768 * 384, 768, p.qng + l * 384, nullptr, 0, 0, 0, rot, idx, nidx);
    transpose_job(tile, p.w_ukv + (size_t)l * 256 * 1024, 1024, 256, 1024, (bf16_t*)(ws + OFF_WUKV) + (size_t)l * 1024 * 256, 1024, p.kvng + l * 256, nullptr, 0, 0, 0, rot, idx, nidx);
    transpose_job(tile, p.w_dec + (size_t)l * 64 * 512, 512, 64, 512, (bf16_t*)(ws + OFF_WDEC) + (size_t)l * 512 * 64, 512, nullptr, nullptr, 0, 0, 0, rot, idx, nidx);
    transpose_job(tile, p.w_icl + (size_t)l * 64 * 512, 512, 64, 512, (bf16_t*)(ws + OFF_WICL) + (size_t)l * 512 * 64, 512, nullptr, nullptr, 0, 0, 0, rot, idx, nidx);
    if (l > 0)
        transpose_job(tile, p.w_vmu + (size_t)(l - 1) * 32 * 512, 512, 32, 512, (bf16_t*)(ws + OFF_WVM) + (size_t)l * 512 * 32, 512, nullptr, nullptr, 0, 0, 0, rot, idx, nidx);
}

__device__ void prologue(char* smem, const Params& p) {
    char* ws = p.ws;
    float* tile = (float*)smem;
    { const int t0_ = otid(); if (blockIdx.x == 0 && t0_ < 64) ((int*)(ws + OFF_CTRL))[t0_] = 0; }
    {
        float* cs = (float*)(ws + OFF_COS); float* sn = (float*)(ws + OFF_SIN);
        const int gt = blockIdx.x * 256 + otid(), ng = gridDim.x * 256;
        for (int e = gt; e < NT * 16; e += ng) {
            const int t = e >> 4, i = e & 15;
            const float inv = exp2f(-(float)i * (13.287712379549449f / 16.0f));
            const float ang = (float)p.pos[t] * inv;
            cs[e] = cosf(ang); sn[e] = sinf(ang);
        }
    }
    mod_job(tile, p, (float*)(ws + OFF_MOD));
    __syncthreads();
    convert_layer(smem, p, 0, blockIdx.x, gridDim.x);
}

__device__ void norm_phase(const float* __restrict__ xin, const float* __restrict__ g, const float* __restrict__ modl, bf16_t* __restrict__ h, int tbase) {
    const int tid_ = otid(); const int lane = tid_ & 63, gw = blockIdx.x * 4 + (tid_ >> 6), nw = gridDim.x * 4;
    for (int t = tbase + gw; t < tbase + TH; t += nw) {
        const float* xr = xin + (size_t)t * 1024;
        f32x4 v[4]; float ss = 0.f;
#pragma unroll
        for (int i = 0; i < 4; ++i) { v[i] = *(const f32x4*)(xr + i * 256 + lane * 4); ss += v[i].x * v[i].x + v[i].y * v[i].y + v[i].z * v[i].z + v[i].w * v[i].w; }
        ss = wave_sum64(ss);
        const float rstd = rsqrtf(ss * (1.0f / 1024.0f) + 1e-6f);
        const float* mb = modl + (size_t)(t >> 12) * 3072;
#pragma unroll
        for (int i = 0; i < 4; ++i) {
            const int col = i * 256 + lane * 4;
            const f32x4 gg = *(const f32x4*)(g + col), sh = *(const f32x4*)(mb + col), sc = *(const f32x4*)(mb + 1024 + col);
            const f32x4 o = v[i] * rstd * gg * (sc + 1.0f) + sh;
            u32x2 w; w.x = pk_bf16(o.x, o.y); w.y = pk_bf16(o.z, o.w);
            *(u32x2*)(h + (size_t)(t - tbase) * 1024 + col) = w;
        }
    }
}

__device__ void final_norm(float* __restrict__ xio, const float* __restrict__ g) {
    const int tid_ = otid(); const int lane = tid_ & 63, gw = blockIdx.x * 4 + (tid_ >> 6), nw = gridDim.x * 4;
    for (int t = gw; t < NT; t += nw) {
        float* xr = xio + (size_t)t * 1024;
        f32x4 v[4]; float ss = 0.f;
#pragma unroll
        for (int i = 0; i < 4; ++i) { v[i] = *(const f32x4*)(xr + i * 256 + lane * 4); ss += v[i].x * v[i].x + v[i].y * v[i].y + v[i].z * v[i].z + v[i].w * v[i].w; }
        ss = wave_sum64(ss);
        const float rstd = rsqrtf(ss * (1.0f / 1024.0f) + 1e-6f);
#pragma unroll
        for (int i = 0; i < 4; ++i) {
            const int col = i * 256 + lane * 4;
            const f32x4 gg = *(const f32x4*)(g + col);
            *(f32x4*)(xr + col) = v[i] * rstd * gg;
        }
    }
}

template <class Epi>
__device__ __forceinline__ void gemm_tile(char* smem, const bf16_t* __restrict__ A, int lda, const bf16_t* __restrict__ Bt, int ldb, int K, int row0, int col0, const Epi& epi) {
    const int tid = otid(), lane = tid & 63, wid = tid >> 6, wr = wid >> 1, wc = wid & 1, fr = lane & 15, fq = lane >> 4;
    f32x4 acc[4][4];
#pragma unroll
    for (int i = 0; i < 4; ++i)
#pragma unroll
        for (int j = 0; j < 4; ++j) acc[i][j] = (f32x4){0.f, 0.f, 0.f, 0.f};
    const int lrow = lane >> 3, lp = lane & 7;
    const int srow0 = wid * 32 + lrow;
    const bf16_t* gA = A + (size_t)(row0 + srow0) * lda;
    const bf16_t* gB = Bt + (size_t)(col0 + srow0) * ldb;
    int gc[4];
#pragma unroll
    for (int i = 0; i < 4; ++i) gc[i] = (lp ^ (((srow0 + 8 * i) >> 1) & 7)) * 8;
    LAS char* lbase = (LAS char*)smem + wid * 4096;
#define GEMM_STAGE(buf, kofs) do { _Pragma("unroll") for (int i = 0; i < 4; ++i) { \
        __builtin_amdgcn_global_load_lds((const unsigned*)(gA + (size_t)(8 * i) * lda + (kofs) + gc[i]), (LAS unsigned*)(lbase + (buf) * 32768 + i * 1024), 16, 0, 0); \
        __builtin_amdgcn_global_load_lds((const unsigned*)(gB + (size_t)(8 * i) * ldb + (kofs) + gc[i]), (LAS unsigned*)(lbase + (buf) * 32768 + 16384 + i * 1024), 16, 0, 0); } } while (0)
    GEMM_STAGE(0, 0);
    __syncthreads();
    const int nk = K >> 6;
    const int fsw = (fr >> 1) & 7;
    const int aoff = (wr * 64 + fr) * 128, boff = 16384 + (wc * 64 + fr) * 128;
#define GEMM_STEP(CB, NB_) do { \
        const char* cur = smem + (CB) * 32768; \
        bf16x8 af[2][4], bfr[2][4]; \
        _Pragma("unroll") for (int kk = 0; kk < 2; ++kk) { \
            const int csw = (((kk * 4 + fq) ^ fsw) << 4); \
            _Pragma("unroll") for (int i = 0; i < 4; ++i) { af[kk][i] = *(const bf16x8*)(cur + aoff + i * 2048 + csw); bfr[kk][i] = *(const bf16x8*)(cur + boff + i * 2048 + csw); } \
        } \
        __builtin_amdgcn_sched_barrier(0); \
        if (ks + 1 < nk) GEMM_STAGE(NB_, (ks + 1) * 64); \
        __builtin_amdgcn_sched_barrier(0); \
        _Pragma("unroll") for (int kk = 0; kk < 2; ++kk) \
            _Pragma("unroll") for (int mi = 0; mi < 4; ++mi) \
                _Pragma("unroll") for (int ni = 0; ni < 4; ++ni) acc[mi][ni] = __builtin_amdgcn_mfma_f32_16x16x32_bf16(bfr[kk][ni], af[kk][mi], acc[mi][ni], 0, 0, 0); \
        __builtin_amdgcn_sched_barrier(0); \
        __syncthreads(); \
        ++ks; } while (0)
#pragma unroll 1
    for (int ks = 0; ks < nk;) {
        GEMM_STEP(0, 1);
        GEMM_STEP(1, 0);
    }
#undef GEMM_STEP
#undef GEMM_STAGE
    epi(acc, row0 + wr * 64, col0 + wc * 64, fr, fq);
}

struct EpiProj {
    bf16_t* proj; float* rsq; float* rskv; char* smem;
    __device__ __forceinline__ void operator()(const f32x4 (&acc)[4][4], int rbase, int cbase, int fr, int fq) const {
        const bool isq = cbase >= O_CQ && cbase < O_CKV, iskv = cbase >= O_CKV && cbase < O_KR;
        const int row0 = rbase & ~127, col0 = cbase & ~127, wr = (rbase >> 6) & 1, wc = (cbase >> 6) & 1;
        const int tid = (wr * 2 + wc) * 64 + fq * 16 + fr;
#pragma unroll
        for (int mi = 0; mi < 4; ++mi) {
            const int tl = rbase + mi * 16 + fr; float ss = 0.f;
#pragma unroll
            for (int ni = 0; ni < 4; ++ni) {
                u32x2 w; w.x = pk_bf16(acc[mi][ni][0], acc[mi][ni][1]); w.y = pk_bf16(acc[mi][ni][2], acc[mi][ni][3]);
                *(u32x2*)(smem + (wr * 64 + mi * 16 + fr) * 272 + (wc * 64 + ni * 16 + fq * 4) * 2) = w;
                const float a = bf_lo(w.x), b = bf_hi(w.x), c = bf_lo(w.y), d = bf_hi(w.y);
                ss += a * a + b * b + c * c + d * d;
            }
            if (isq || iskv) {
                ss += __shfl_xor(ss, 16); ss += __shfl_xor(ss, 32);
                if (fq == 0) { if (isq) rsq[(size_t)tl * 8 + ((cbase - O_CQ) >> 6)] = ss; else rskv[(size_t)tl * 4 + ((cbase - O_CKV) >> 6)] = ss; }
            }
        }
        __syncthreads();
#pragma unroll
        for (int i = 0; i < 8; ++i) {
            const int q = tid + 256 * i, r = q >> 4, c = q & 15;
            *(u32x4*)(proj + (size_t)(row0 + r) * NP + col0 + c * 8) = *(const u32x4*)(smem + r * 272 + c * 16);
        }
        __syncthreads();
    }
};
struct EpiQ {
    bf16_t* Q; const float* rsq; const float* cs; const float* sn; int tgbase; char* smem;
    __device__ __forceinline__ void operator()(const f32x4 (&acc)[4][4], int rbase, int cbase, int fr, int fq) const {
        const int g0 = cbase >> 4;
        char* stg = smem + ((((rbase >> 6) & 1) * 2 + ((cbase >> 6) & 1)) * 9216);
#pragma unroll
        for (int mi = 0; mi < 4; ++mi) {
            const int tl = rbase + mi * 16 + fr;
            const f32x4 s0 = *(const f32x4*)(rsq + (size_t)tl * 8); const f32x2 s1 = *(const f32x2*)(rsq + (size_t)tl * 8 + 4);
            const float rs = rsqrtf((s0.x + s0.y + s0.z + s0.w + s1.x + s1.y) * (1.0f / 384.0f) + 1e-6f) * QSCALE;
            const f32x4 cc = *(const f32x4*)(cs + (size_t)(tgbase + tl) * 16 + fq * 4), sv = *(const f32x4*)(sn + (size_t)(tgbase + tl) * 16 + fq * 4);
            f32x4 v[4];
#pragma unroll
            for (int ni = 0; ni < 4; ++ni) v[ni] = acc[mi][ni] * rs;
#pragma unroll
            for (int ni = 0; ni < 4; ni += 2)
                if ((g0 + ni) % 6 == 4) { const f32x4 x1 = v[ni], x2 = v[ni + 1]; v[ni] = x1 * cc - x2 * sv; v[ni + 1] = x2 * cc + x1 * sv; }
#pragma unroll
            for (int ni = 0; ni < 4; ++ni) {
                u32x2 w; w.x = pk_bf16(v[ni][0], v[ni][1]); w.y = pk_bf16(v[ni][2], v[ni][3]);
                *(u32x2*)(stg + (mi * 16 + fr) * 144 + (ni * 16 + fq * 4) * 2) = w;
            }
        }
        {
            const int lane = fq * 16 + fr;
#pragma unroll
            for (int i = 0; i < 8; ++i) {
                const int q = lane + 64 * i, tk = q >> 3, c = q & 7;
                *(u32x4*)(Q + (size_t)(rbase + tk) * 768 + cbase + c * 8) = *(const u32x4*)(stg + tk * 144 + c * 16);
            }
        }
        __syncthreads();
    }
};
struct EpiKV {
    bf16_t* Kh; bf16_t* Vt; const float* rskv; char* smem;
    __device__ __forceinline__ void operator()(const f32x4 (&acc)[4][4], int rbase, int cbase, int fr, int fq) const {
        const int hh = cbase >> 7, part = (cbase >> 6) & 1, lane = fq * 16 + fr;
        char* stg = smem + ((((rbase >> 6) & 1) * 2 + part) * 9216);
#pragma unroll
        for (int mi = 0; mi < 4; ++mi) {
            const int tl = rbase + mi * 16 + fr;
            const f32x4 s0 = *(const f32x4*)(rskv + (size_t)tl * 4);
            const float rs = rsqrtf((s0.x + s0.y + s0.z + s0.w) * (1.0f / 256.0f) + 1e-6f);
#pragma unroll
            for (int ni = 0; ni < 4; ++ni) {
                const unsigned w0 = pk_bf16(acc[mi][ni][0] * rs, acc[mi][ni][1] * rs), w1 = pk_bf16(acc[mi][ni][2] * rs, acc[mi][ni][3] * rs);
                if (part == 0) { u32x2 w; w.x = w0; w.y = w1; *(u32x2*)(stg + (mi * 16 + fr) * 144 + (ni * 16 + fq * 4) * 2) = w; }
                else {
                    bf16_t* sp = (bf16_t*)(stg + (ni * 16 + fq * 4) * 144) + mi * 16 + fr;
                    sp[0] = (bf16_t)(w0 & 0xffffu); sp[72] = (bf16_t)(w0 >> 16); sp[144] = (bf16_t)(w1 & 0xffffu); sp[216] = (bf16_t)(w1 >> 16);
                }
            }
        }
        if (part == 0) {
#pragma unroll
            for (int i = 0; i < 8; ++i) {
                const int q = lane + 64 * i, tk = q >> 3, c = q & 7;
                *(u32x4*)(Kh + (size_t)(rbase + tk) * 768 + hh * 96 + c * 8) = *(const u32x4*)(stg + tk * 144 + c * 16);
            }
        } else {
            const int bl = rbase >> 12, s0 = rbase & 4095;
            bf16_t* vb = Vt + ((size_t)(bl * 8 + hh) * 64) * 4096 + s0;
#pragma unroll
            for (int i = 0; i < 8; ++i) {
                const int q = lane + 64 * i, dv = q >> 3, c = q & 7;
                *(u32x4*)(vb + (size_t)dv * 4096 + c * 8) = *(const u32x4*)(stg + dv * 144 + c * 16);
            }
        }
        __syncthreads();
    }
};
struct EpiOut {
    const float* xold; float* xnew; const float* modl; int tgbase; float fac;
    __device__ __forceinline__ void operator()(const f32x4 (&acc)[4][4], int rbase, int cbase, int fr, int fq) const {
#pragma unroll
        for (int mi = 0; mi < 4; ++mi) {
            const int tg = tgbase + rbase + mi * 16 + fr; const float* gp = modl + (size_t)(tg >> 12) * 3072 + 2048;
#pragma unroll
            for (int ni = 0; ni < 4; ++ni) {
                const int col = cbase + ni * 16 + fq * 4;
                const f32x4 xo = *(const f32x4*)(xold + (size_t)tg * 1024 + col), gt = *(const f32x4*)(gp + col);
                *(f32x4*)(xnew + (size_t)tg * 1024 + col) = xo + gt * acc[mi][ni] * fac;
            }
        }
    }
};

struct PrepArgs {
    const bf16_t* proj; const float* mu; const float* muv; const bf16_t* wdec; const bf16_t* wicl; const bf16_t* wvm;
    const float *w0, *a0, *v0, *k_k, *k_a; const float *cs, *sn;
    bf16_t *sr, *sk, *sv, *skk, *skka; bf16_t* se; bf16_t* vfirst; bf16_t* Kh; int layer; int tgbase;
};
__device__ __forceinline__ void lerp8(const bf16_t* cur, const bf16_t* prv, bool hp, const float* mu, float (&o)[8]) {
    const u32x4 c = *(const u32x4*)cur; u32x4 q = (u32x4){0u, 0u, 0u, 0u}; if (hp) q = *(const u32x4*)prv;
    const f32x4 m0 = *(const f32x4*)mu, m1 = *(const f32x4*)(mu + 4);
    const float cv[8] = {bf_lo(c.x), bf_hi(c.x), bf_lo(c.y), bf_hi(c.y), bf_lo(c.z), bf_hi(c.z), bf_lo(c.w), bf_hi(c.w)};
    const float pv[8] = {bf_lo(q.x), bf_hi(q.x), bf_lo(q.y), bf_hi(q.y), bf_lo(q.z), bf_hi(q.z), bf_lo(q.w), bf_hi(q.w)};
    const float mv[8] = {m0.x, m0.y, m0.z, m0.w, m1.x, m1.y, m1.z, m1.w};
#pragma unroll
    for (int j = 0; j < 8; ++j) o[j] = cv[j] + (pv[j] - cv[j]) * mv[j];
}
__device__ __forceinline__ f32x4 lerp4(const bf16_t* cur, const bf16_t* prv, bool hp, const float* mu) {
    const u32x2 c = *(const u32x2*)cur; u32x2 q = (u32x2){0u, 0u}; if (hp) q = *(const u32x2*)prv;
    const f32x4 m = *(const f32x4*)mu;
    const f32x4 cv = (f32x4){bf_lo(c.x), bf_hi(c.x), bf_lo(c.y), bf_hi(c.y)}, pv = (f32x4){bf_lo(q.x), bf_hi(q.x), bf_lo(q.y), bf_hi(q.y)};
    return cv + (pv - cv) * m;
}
__device__ __forceinline__ bf16x8 pack8(const float (&v)[8]) {
    u32x4 w; w.x = pk_bf16(v[0], v[1]); w.y = pk_bf16(v[2], v[3]); w.z = pk_bf16(v[4], v[5]); w.w = pk_bf16(v[6], v[7]);
    return __builtin_bit_cast(bf16x8, w);
}
__device__ __forceinline__ void store4(bf16_t* dst, const f32x4 v) { u32x2 w; w.x = pk_bf16(v.x, v.y); w.y = pk_bf16(v.z, v.w); *(u32x2*)dst = w; }

__device__ __forceinline__ void prep_tile(char* smem, const PrepArgs& a, int tile, int hg) {
    const int tid = otid(), lane = tid & 63, wid = tid >> 6, fr = lane & 15, fq = lane >> 4;
    const int tl = tile * 64 + wid * 16 + fr, tg = a.tgbase + tl;
    char* stg = smem + wid * 15872;
    const int tlw = tile * 64 + wid * 16;
    const bool hp = (tg & 4095) != 0;
    const bf16_t* pr = a.proj + (size_t)tl * NP; const bf16_t* pp = pr - NP;
    if (hg == 0) {
        const u32x2 u1 = *(const u32x2*)(pr + O_KR + fq * 4), u2 = *(const u32x2*)(pr + O_KR + 16 + fq * 4);
        const f32x4 x1 = (f32x4){bf_lo(u1.x), bf_hi(u1.x), bf_lo(u1.y), bf_hi(u1.y)}, x2 = (f32x4){bf_lo(u2.x), bf_hi(u2.x), bf_lo(u2.y), bf_hi(u2.y)};
        const f32x4 cc = *(const f32x4*)(a.cs + (size_t)tg * 16 + fq * 4), sv = *(const f32x4*)(a.sn + (size_t)tg * 16 + fq * 4);
        const f32x4 o1 = x1 * cc - x2 * sv, o2 = x2 * cc + x1 * sv;
        u32x2 w1, w2; w1.x = pk_bf16(o1.x, o1.y); w1.y = pk_bf16(o1.z, o1.w); w2.x = pk_bf16(o2.x, o2.y); w2.y = pk_bf16(o2.z, o2.w);
#pragma unroll
        for (int hh = 0; hh < 8; ++hh) { *(u32x2*)(a.Kh + (size_t)tl * 768 + hh * 96 + 64 + fq * 4) = w1; *(u32x2*)(a.Kh + (size_t)tl * 768 + hh * 96 + 80 + fq * 4) = w2; }
    }
    bf16x8 bw[2], ba[2], bv;
#pragma unroll
    for (int ks = 0; ks < 2; ++ks) {
        float t[8];
        lerp8(pr + 1536 + ks * 32 + fq * 8, pp + 1536 + ks * 32 + fq * 8, hp, a.mu + 1536 + ks * 32 + fq * 8, t);
#pragma unroll
        for (int j = 0; j < 8; ++j) t[j] = tanhf_(t[j]);
        bw[ks] = pack8(t);
        lerp8(pr + 1600 + ks * 32 + fq * 8, pp + 1600 + ks * 32 + fq * 8, hp, a.mu + 1600 + ks * 32 + fq * 8, t);
        ba[ks] = pack8(t);
    }
    const bool hasv = a.layer > 0;
    if (hasv) { float t[8]; lerp8(pr + INW + fq * 8, pp + INW + fq * 8, hp, a.muv + fq * 8, t); bv = pack8(t); }
    else bv = (bf16x8){0, 0, 0, 0, 0, 0, 0, 0};
#pragma unroll 1
    for (int hh = hg * 2; hh < hg * 2 + 2; ++hh) {
        float ss = 0.f;
#pragma unroll
        for (int nt = 0; nt < 4; ++nt) {
            const int ch = hh * 64 + nt * 16 + fq * 4;
            const f32x4 k4 = lerp4(pr + 512 + ch, pp + 512 + ch, hp, a.mu + 512 + ch);
            const f32x4 kr = k4 * *(const f32x4*)(a.k_k + ch);
            ss += kr.x * kr.x + kr.y * kr.y + kr.z * kr.z + kr.w * kr.w;
        }
        ss += __shfl_xor(ss, 16); ss += __shfl_xor(ss, 32);
        const float inv = 1.0f / fmaxf(sqrtf(ss), 1e-12f);
#pragma unroll
        for (int nt = 0; nt < 4; ++nt) {
            const int cb = hh * 64 + nt * 16, ch = cb + fq * 4;
            f32x4 accw = (f32x4){0.f, 0.f, 0.f, 0.f}, acca = accw, accv = accw;
#pragma unroll
            for (int ks = 0; ks < 2; ++ks) {
                const bf16x8 aw = *(const bf16x8*)(a.wdec + (size_t)(cb + fr) * 64 + ks * 32 + fq * 8);
                const bf16x8 ai = *(const bf16x8*)(a.wicl + (size_t)(cb + fr) * 64 + ks * 32 + fq * 8);
                accw = __builtin_amdgcn_mfma_f32_16x16x32_bf16(aw, bw[ks], accw, 0, 0, 0);
                acca = __builtin_amdgcn_mfma_f32_16x16x32_bf16(ai, ba[ks], acca, 0, 0, 0);
            }
            if (hasv) {
                const bf16x8 avm = *(const bf16x8*)(a.wvm + (size_t)(cb + fr) * 32 + fq * 8);
                accv = __builtin_amdgcn_mfma_f32_16x16x32_bf16(avm, bv, accv, 0, 0, 0);
            }
            const f32x4 r4 = lerp4(pr + ch, pp + ch, hp, a.mu + ch);
            const f32x4 k4 = lerp4(pr + 512 + ch, pp + 512 + ch, hp, a.mu + 512 + ch);
            f32x4 v4 = lerp4(pr + 1024 + ch, pp + 1024 + ch, hp, a.mu + 1024 + ch);
            const f32x4 w0v = *(const f32x4*)(a.w0 + ch), a0v = *(const f32x4*)(a.a0 + ch), kkv = *(const f32x4*)(a.k_k + ch), kav = *(const f32x4*)(a.k_a + ch);
            f32x4 dec, aa;
#pragma unroll
            for (int j = 0; j < 4; ++j) {
                dec[j] = 0.6065306597126334f * sigmoidf_(w0v[j] + accw[j]);
                aa[j] = sigmoidf_(a0v[j] + acca[j]);
            }
            if (hasv) {
                const f32x4 v0v = *(const f32x4*)(a.v0 + ch);
                const u32x2 uf = *(const u32x2*)(a.vfirst + (size_t)tg * 512 + ch);
                const f32x4 vf = (f32x4){bf_lo(uf.x), bf_hi(uf.x), bf_lo(uf.y), bf_hi(uf.y)};
#pragma unroll
                for (int j = 0; j < 4; ++j) v4[j] = v4[j] + (vf[j] - v4[j]) * sigmoidf_(v0v[j] + accv[j]);
            } else {
                store4(a.vfirst + (size_t)tg * 512 + ch, v4);
            }
            const f32x4 kk = k4 * kkv * inv;
            const f32x4 kp = k4 * ((aa - 1.0f) * kav + 1.0f);
            {
                const int so = fr * 144 + nt * 32 + fq * 8;
                store4((bf16_t*)(stg + so), r4); store4((bf16_t*)(stg + 2304 + so), kp); store4((bf16_t*)(stg + 4608 + so), v4);
                store4((bf16_t*)(stg + 6912 + so), kk); store4((bf16_t*)(stg + 9216 + so), kk * aa);
                store4((bf16_t*)(stg + 11520 + so), dec);
            }
        }
        {
#pragma unroll
            for (int i = 0; i < 2; ++i) {
                const int q = lane + 64 * i, tk = q >> 3, c = q & 7;
                const size_t go = (size_t)(tlw + tk) * 512 + hh * 64 + c * 8; const int lo = tk * 144 + c * 16;
                *(u32x4*)(a.sr + go) = *(const u32x4*)(stg + lo); *(u32x4*)(a.sk + go) = *(const u32x4*)(stg + 2304 + lo); *(u32x4*)(a.sv + go) = *(const u32x4*)(stg + 4608 + lo);
                *(u32x4*)(a.skk + go) = *(const u32x4*)(stg + 6912 + lo); *(u32x4*)(a.skka + go) = *(const u32x4*)(stg + 9216 + lo);
                *(u32x4*)(a.se + go) = *(const u32x4*)(stg + 11520 + lo);
            }
        }
    }
    __syncthreads();
}

struct ScanArgs { const bf16_t *sr, *sk, *sv, *skk, *skka; const float* sw; float* yraw; float* zbuf; float* sfin; };
__device__ __forceinline__ void cvt_store8(float* dst, const u32x4 u) {
    *(f32x4*)dst = (f32x4){bf_lo(u.x), bf_hi(u.x), bf_lo(u.y), bf_hi(u.y)};
    *(f32x4*)(dst + 4) = (f32x4){bf_lo(u.z), bf_hi(u.z), bf_lo(u.w), bf_hi(u.w)};
}
__device__ __forceinline__ void scan_tile(char* smem, const ScanArgs& a, int mode, int bl, int hh, int g) {
    const int tid = otid(), lane = tid & 63, wid = tid >> 6, rl = lane >> 4, c = lane & 15;
    float* L = (float*)smem;
    float* ybuf = L + 2 * 5376;
    const size_t tokbase = (size_t)bl * 4096 + (mode ? 2048 : 0);
    const int colh = hh * 64, i0 = g * 16;
    const bf16_t* src0 = (tid < 128) ? a.skk : a.skka;
    const bf16_t* src1 = (tid < 128) ? a.sk : a.sr;
    const int rem = tid & 127, tokA = rem >> 3, chA = rem & 7;
    const size_t gofsA = (size_t)tokA * 512 + colh + chA * 8;
    const int ldsA0 = (1 + (tid >> 7)) * 1024 + tokA * 64 + chA * 8, ldsA1 = (3 + (tid >> 7)) * 1024 + tokA * 64 + chA * 8;
    const size_t gofsW = (size_t)(tid >> 4) * 512 + colh + (tid & 15) * 4;
    const int ldsW = (tid >> 4) * 64 + (tid & 15) * 4;
    const size_t gofsV = (size_t)((tid & 31) >> 1) * 512 + colh + i0 + (tid & 1) * 8;
    const int ldsV = 5120 + ((tid & 31) >> 1) * 16 + (tid & 1) * 8;
    const bool ldv = tid < 32 && mode != 2;
    f32x2 S01 = (f32x2){0.f, 0.f}, S23 = (f32x2){0.f, 0.f};
    if (mode == 2) { const int d = (i0 + wid * 4 + rl) - c * 4; S01.x = d == 0 ? 1.f : 0.f; S01.y = d == 1 ? 1.f : 0.f; S23.x = d == 2 ? 1.f : 0.f; S23.y = d == 3 ? 1.f : 0.f; }
    u32x4 qa, qb, qv = (u32x4){0u, 0u, 0u, 0u}; f32x4 qw;
    {
        const size_t tb = tokbase * 512;
        qa = *(const u32x4*)(src0 + tb + gofsA); qb = *(const u32x4*)(src1 + tb + gofsA); qw = *(const f32x4*)(a.sw + tb + gofsW);
        if (ldv) qv = *(const u32x4*)(a.sv + tb + gofsV);
        cvt_store8(L + ldsA0, qa); cvt_store8(L + ldsA1, qb); *(f32x4*)(L + ldsW) = qw; if (tid < 32) { cvt_store8(L + ldsV, qv); if (mode == 2) cvt_store8(L + 5376 + ldsV, qv); }
    }
    __syncthreads();
    const int vofs = 5120 + wid * 4 + rl;
#pragma unroll 1
    for (int ch = 0; ch < 128; ++ch) {
        const float* cur = L + (ch & 1) * 5376;
        if (ch + 1 < 128) {
            const size_t tb = (tokbase + (size_t)(ch + 1) * 16) * 512;
            qa = *(const u32x4*)(src0 + tb + gofsA); qb = *(const u32x4*)(src1 + tb + gofsA); qw = *(const f32x4*)(a.sw + tb + gofsW);
            if (ldv) qv = *(const u32x4*)(a.sv + tb + gofsV);
        }
        float* yb = ybuf + (ch & 1) * 256;
        float ykeep = 0.f;
        f32x4 w4 = *(const f32x4*)(cur + c * 4), kk4 = *(const f32x4*)(cur + 1024 + c * 4), ka4 = *(const f32x4*)(cur + 2048 + c * 4);
        f32x4 k4 = *(const f32x4*)(cur + 3072 + c * 4), r4 = *(const f32x4*)(cur + 4096 + c * 4);
        float v = cur[vofs];
        float prevq = 0.f;
#pragma unroll
        for (int s = 0; s < 16; ++s) {
            f32x4 nw4 = w4, nkk4 = kk4, nka4 = ka4, nk4 = k4, nr4 = r4; float nv = v;
            if (s + 1 < 16) {
                nw4 = *(const f32x4*)(cur + (s + 1) * 64 + c * 4); nkk4 = *(const f32x4*)(cur + 1024 + (s + 1) * 64 + c * 4); nka4 = *(const f32x4*)(cur + 2048 + (s + 1) * 64 + c * 4);
                nk4 = *(const f32x4*)(cur + 3072 + (s + 1) * 64 + c * 4); nr4 = *(const f32x4*)(cur + 4096 + (s + 1) * 64 + c * 4);
                nv = cur[vofs + (s + 1) * 16];
            }
            const f32x2 pp = S01 * kk4.xy + S23 * kk4.zw;
            float sa = pp.x + pp.y;
            if (s > 0) { float yq = prevq; dpp_sum16x2(sa, yq); ykeep = (c == s - 1) ? yq : ykeep; }
            else sa = dpp_sum16(sa);
            const f32x2 sa2 = (f32x2){sa, sa}, v2 = (f32x2){v, v};
            S01 = S01 * w4.xy + (v2 * k4.xy - sa2 * ka4.xy);
            S23 = S23 * w4.zw + (v2 * k4.zw - sa2 * ka4.zw);
            const f32x2 qq = S01 * r4.xy + S23 * r4.zw;
            prevq = qq.x + qq.y;
            __builtin_amdgcn_sched_barrier(0);
            w4 = nw4; kk4 = nkk4; ka4 = nka4; k4 = nk4; r4 = nr4; v = nv;
        }
        { const float yq = dpp_sum16(prevq); ykeep = (c == 15) ? yq : ykeep; }
        yb[c * 16 + wid * 4 + rl] = ykeep;
        if (ch + 1 < 128) {
            float* nx = L + ((ch + 1) & 1) * 5376;
            cvt_store8(nx + ldsA0, qa); cvt_store8(nx + ldsA1, qb); *(f32x4*)(nx + ldsW) = qw; if (ldv) cvt_store8(nx + ldsV, qv);
        }
        __syncthreads();
        if (mode != 2) a.yraw[(tokbase + (size_t)ch * 16 + (tid >> 4)) * 512 + colh + i0 + (tid & 15)] = yb[tid];
        else a.zbuf[((size_t)bl * 2048 + (size_t)ch * 16 + (tid >> 4)) * 512 + colh + i0 + (tid & 15)] = yb[tid];
    }
    if (mode == 0) *(f32x4*)(a.sfin + ((size_t)((bl * 8 + hh) * 64 + i0 + wid * 4 + rl)) * 64 + c * 4) = (f32x4){S01.x, S01.y, S23.x, S23.y};
}

__device__ __forceinline__ void attn_tile(char* smem, const bf16_t* __restrict__ Qh, const bf16_t* __restrict__ Kh, const bf16_t* __restrict__ Vt,
                                          const bf16_t* __restrict__ proj, bf16_t* __restrict__ ycat, int bl, int hh, int qt) {
    const int tid = otid(), lane = tid & 63, wid = tid >> 6, fr = lane & 15, fq = lane >> 4;
    const int q0 = qt * 128, tok0 = bl * 4096, qw0 = q0 + wid * 32;
    bf16x8 qf[2][3];
#pragma unroll
    for (int qi = 0; qi < 2; ++qi)
#pragma unroll
        for (int ks = 0; ks < 3; ++ks) qf[qi][ks] = *(const bf16x8*)(Qh + (size_t)(tok0 + qw0 + qi * 16 + fr) * 768 + hh * 96 + ks * 32 + fq * 8);
    f32x4 o[4][2];
#pragma unroll
    for (int i = 0; i < 4; ++i) { o[i][0] = (f32x4){0.f, 0.f, 0.f, 0.f}; o[i][1] = o[i][0]; }
    float m[2] = {-1e30f, -1e30f}, lsum[2] = {0.f, 0.f};
    const int nkv = 2 * (qt + 1);
    const bf16_t* Kb = Kh + (size_t)tok0 * 768 + hh * 96;
    const bf16_t* Vb = Vt + ((size_t)((bl * 8 + hh) * 64)) * 4096;
    int gK[3], lK[3];
#pragma unroll
    for (int i = 0; i < 3; ++i) { const int cid = tid + 256 * i, key = cid / 12, cc = cid - key * 12; gK[i] = key * 768 + cc * 8; lK[i] = key * 224 + cc * 16; }
    int gV[2], lV[2];
#pragma unroll
    for (int i = 0; i < 2; ++i) { const int cid = tid + 256 * i, dv = cid >> 3, cc = cid & 7; gV[i] = dv * 4096 + cc * 8; lV[i] = 14336 + dv * 144 + cc * 16; }
    u32x4 rkA[3], rvA[2], rkB[3], rvB[2];
#define ATT_LOAD(RK, RV, T) do { _Pragma("unroll") for (int i = 0; i < 3; ++i) RK[i] = *(const u32x4*)(Kb + (size_t)((T) * 64) * 768 + gK[i]); \
                                 _Pragma("unroll") for (int i = 0; i < 2; ++i) RV[i] = *(const u32x4*)(Vb + (T) * 64 + gV[i]); } while (0)
#define ATT_WRITE(RK, RV, BUF) do { _Pragma("unroll") for (int i = 0; i < 3; ++i) *(u32x4*)(smem + (BUF) * 23552 + lK[i]) = RK[i]; \
                                    _Pragma("unroll") for (int i = 0; i < 2; ++i) *(u32x4*)(smem + (BUF) * 23552 + lV[i]) = RV[i]; } while (0)
    ATT_LOAD(rkA, rvA, 0);
    ATT_WRITE(rkA, rvA, 0);
    ATT_LOAD(rkA, rvA, 1);
    __syncthreads();
    auto compute = [&](const int j, const char* cur) {
        const int kv0 = j * 64;
        if (kv0 <= qw0 + 31) {
            f32x4 s[4][2];
            {
                bf16x8 kf[4][3];
#pragma unroll
                for (int kt = 0; kt < 4; ++kt)
#pragma unroll
                    for (int ks = 0; ks < 3; ++ks) kf[kt][ks] = *(const bf16x8*)(cur + (kt * 16 + fr) * 224 + (ks * 4 + fq) * 16);
                __builtin_amdgcn_sched_barrier(0);
#pragma unroll
                for (int kt = 0; kt < 4; ++kt)
#pragma unroll
                    for (int qi = 0; qi < 2; ++qi) {
                        f32x4 acc = (f32x4){0.f, 0.f, 0.f, 0.f};
#pragma unroll
                        for (int ks = 0; ks < 3; ++ks) acc = __builtin_amdgcn_mfma_f32_16x16x32_bf16(kf[kt][ks], qf[qi][ks], acc, 0, 0, 0);
                        s[kt][qi] = acc;
                    }
                __builtin_amdgcn_sched_barrier(0);
            }
            bf16x8 vfr[4][2];
#pragma unroll
            for (int dvt = 0; dvt < 4; ++dvt)
#pragma unroll
                for (int kb = 0; kb < 2; ++kb) {
                    const char* vp = cur + 14336 + (dvt * 16 + fr) * 144 + kb * 64 + fq * 8;
                    const u32x2 lo = *(const u32x2*)vp, hi = *(const u32x2*)(vp + 32);
                    vfr[dvt][kb] = __builtin_bit_cast(bf16x8, ((u32x4){lo.x, lo.y, hi.x, hi.y}));
                }
            __builtin_amdgcn_sched_barrier(0);
            if (kv0 + 63 > qw0) {
#pragma unroll
                for (int kt = 0; kt < 4; ++kt)
#pragma unroll
                    for (int qi = 0; qi < 2; ++qi)
#pragma unroll
                        for (int jj = 0; jj < 4; ++jj) { const int kpos = kv0 + kt * 16 + fq * 4 + jj, qpos = qw0 + qi * 16 + fr; if (kpos > qpos) s[kt][qi][jj] = -1e30f; }
            }
#pragma unroll
            for (int qi = 0; qi < 2; ++qi) {
                float mx = -1e30f;
#pragma unroll
                for (int kt = 0; kt < 4; ++kt) mx = fmaxf(mx, fmaxf(fmaxf(s[kt][qi][0], s[kt][qi][1]), fmaxf(s[kt][qi][2], s[kt][qi][3])));
                mx = fmaxf(mx, __shfl_xor(mx, 16)); mx = fmaxf(mx, __shfl_xor(mx, 32));
                const float mnew = fmaxf(m[qi], mx), alpha = __builtin_amdgcn_exp2f(m[qi] - mnew);
                m[qi] = mnew;
                float rs = 0.f;
#pragma unroll
                for (int kt = 0; kt < 4; ++kt)
#pragma unroll
                    for (int jj = 0; jj < 4; ++jj) { const float pexp = __builtin_amdgcn_exp2f(s[kt][qi][jj] - mnew); s[kt][qi][jj] = pexp; rs += pexp; }
                lsum[qi] = lsum[qi] * alpha + rs;
#pragma unroll
                for (int dvt = 0; dvt < 4; ++dvt) o[dvt][qi] = o[dvt][qi] * alpha;
            }
            bf16x8 pf[2][2];
#pragma unroll
            for (int kb = 0; kb < 2; ++kb)
#pragma unroll
                for (int qi = 0; qi < 2; ++qi) {
                    u32x4 t;
                    t.x = pk_bf16(s[2 * kb][qi][0], s[2 * kb][qi][1]); t.y = pk_bf16(s[2 * kb][qi][2], s[2 * kb][qi][3]);
                    t.z = pk_bf16(s[2 * kb + 1][qi][0], s[2 * kb + 1][qi][1]); t.w = pk_bf16(s[2 * kb + 1][qi][2], s[2 * kb + 1][qi][3]);
                    pf[kb][qi] = __builtin_bit_cast(bf16x8, t);
                }
            __builtin_amdgcn_sched_barrier(0);
#pragma unroll
            for (int dvt = 0; dvt < 4; ++dvt)
#pragma unroll
                for (int kb = 0; kb < 2; ++kb)
#pragma unroll
                    for (int qi = 0; qi < 2; ++qi) o[dvt][qi] = __builtin_amdgcn_mfma_f32_16x16x32_bf16(vfr[dvt][kb], pf[kb][qi], o[dvt][qi], 0, 0, 0);
        }
    };
#pragma unroll 1
    for (int j = 0; j < nkv; j += 2) {
        if (j + 2 < nkv) ATT_LOAD(rkB, rvB, j + 2);
        compute(j, smem);
        ATT_WRITE(rkA, rvA, 1);
        __syncthreads();
        if (j + 3 < nkv) ATT_LOAD(rkA, rvA, j + 3);
        compute(j + 1, smem + 23552);
        if (j + 2 < nkv) ATT_WRITE(rkB, rvB, 0);
        __syncthreads();
    }
#undef ATT_LOAD
#undef ATT_WRITE
#pragma unroll
    for (int qi = 0; qi < 2; ++qi) {
        float lt = lsum[qi]; lt += __shfl_xor(lt, 16); lt += __shfl_xor(lt, 32);
        const float inv = 1.0f / lt;
        const int tl = tok0 + qw0 + qi * 16 + fr;
#pragma unroll
        for (int dvt = 0; dvt < 4; ++dvt) {
            const int dv = dvt * 16 + fq * 4;
            const u32x2 gu = *(const u32x2*)(proj + (size_t)tl * NP + O_GM + hh * 64 + dv);
            const f32x4 gg = (f32x4){bf_lo(gu.x), bf_hi(gu.x), bf_lo(gu.y), bf_hi(gu.y)};
            f32x4 r;
#pragma unroll
            for (int jj = 0; jj < 4; ++jj) r[jj] = o[dvt][qi][jj] * inv * siluf_(gg[jj]);
            store4(ycat + (size_t)tl * 1024 + 512 + hh * 64 + dv, r);
        }
    }
}

struct FinArgs { const float* yraw; const bf16_t *sr, *sk, *sv; const bf16_t* proj; const float *lnw, *lnb, *rk; bf16_t* ycat; const float* zbuf; const float* sfin; };
__device__ void rwkv_finalize(const FinArgs& a) {
    const int tid_ = otid(); const int lane = tid_ & 63, gw = blockIdx.x * 4 + (tid_ >> 6), nw = gridDim.x * 4;
    for (int u = gw; u < TH * 2; u += nw) {
        const int tl = u >> 1, ch = ((u & 1) * 4 + (lane >> 4)) * 64 + (lane & 15) * 4;
        f32x4 y = *(const f32x4*)(a.yraw + (size_t)tl * 512 + ch);
        const float mean = dpp_sum16(y.x + y.y + y.z + y.w) * (1.0f / 64.0f);
        const f32x4 d = y - mean;
        const float var = dpp_sum16(d.x * d.x + d.y * d.y + d.z * d.z + d.w * d.w) * (1.0f / 64.0f);
        const float rstd = rsqrtf(var + 64e-5f);
        const u32x2 ur = *(const u32x2*)(a.sr + (size_t)tl * 512 + ch), uk = *(const u32x2*)(a.sk + (size_t)tl * 512 + ch), uv = *(const u32x2*)(a.sv + (size_t)tl * 512 + ch);
        const f32x4 r4 = (f32x4){bf_lo(ur.x), bf_hi(ur.x), bf_lo(ur.y), bf_hi(ur.y)}, k4 = (f32x4){bf_lo(uk.x), bf_hi(uk.x), bf_lo(uk.y), bf_hi(uk.y)};
        const f32x4 v4 = (f32x4){bf_lo(uv.x), bf_hi(uv.x), bf_lo(uv.y), bf_hi(uv.y)};
        const f32x4 rkv = *(const f32x4*)(a.rk + ch), lw = *(const f32x4*)(a.lnw + ch), lb = *(const f32x4*)(a.lnb + ch);
        const f32x4 t = r4 * k4 * rkv;
        const float bon = dpp_sum16(t.x + t.y + t.z + t.w);
        const u32x2 gu = *(const u32x2*)(a.proj + (size_t)tl * NP + O_GR + ch);
        const f32x4 gg = (f32x4){bf_lo(gu.x), bf_hi(gu.x), bf_lo(gu.y), bf_hi(gu.y)};
        f32x4 o = d * rstd * lw + lb + v4 * bon;
#pragma unroll
        for (int j = 0; j < 4; ++j) o[j] *= siluf_(gg[j]);
        store4(a.ycat + (size_t)tl * 1024 + ch, o);
    }
}


struct CopArgs { const bf16_t *sr, *sk, *sv, *skk, *skka; const bf16_t* se; char* cops; };
__device__ __forceinline__ float mm16(const float* A, float sa, float ia, const float* B, float sb, float ib, int t, int j) {
    float acc = 0.f;
#pragma unroll
    for (int i = 0; i < 16; ++i) { const float av = sa * A[t * 17 + i] + (i == t ? ia : 0.f); const float bv = sb * B[i * 17 + j] + (i == j ? ib : 0.f); acc += av * bv; }
    return acc;
}
__device__ __forceinline__ float mm16p(const float* A, const float* B, int t, int j) {
    float acc = 0.f;
#pragma unroll
    for (int q = 0; q < 4; ++q) {
        const f32x4 a4 = *(const f32x4*)(A + t * 20 + q * 4);
        acc += a4.x * B[(q * 4 + 0) * 20 + j] + a4.y * B[(q * 4 + 1) * 20 + j] + a4.z * B[(q * 4 + 2) * 20 + j] + a4.w * B[(q * 4 + 3) * 20 + j];
    }
    return acc;
}
__device__ __forceinline__ f32x4 mm16m(const float* A, const float* B, int fr, int fq) {
    f32x4 acc = (f32x4){0.f, 0.f, 0.f, 0.f};
#pragma unroll
    for (int m = 0; m < 4; ++m) acc = __builtin_amdgcn_mfma_f32_16x16x4f32(A[fr * 20 + 4 * m + fq], B[(4 * m + fq) * 20 + fr], acc, 0, 0, 0);
    return acc;
}
__device__ __forceinline__ void mm16st(float* D, const f32x4 acc, int fr, int fq, float diag) {
#pragma unroll
    for (int jj = 0; jj < 4; ++jj) D[(4 * fq + jj) * 20 + fr] = acc[jj] + ((4 * fq + jj) == fr ? diag : 0.f);
}
__device__ __forceinline__ f32x4 unpk4(const u32x2 u) { return (f32x4){bf_lo(u.x), bf_hi(u.x), bf_lo(u.y), bf_hi(u.y)}; }
__device__ __forceinline__ bf16_t bf1(float x) { return (bf16_t)(pk_bf16(x, 0.f) & 0xffffu); }
struct CopIn { u32x2 ue, ukk, uka, uk, ur, uv; };
__device__ __forceinline__ void cop_in_load(CopIn& r, const CopArgs& a, int unit, int t, int cq) {
    const int c = unit & 255, bh = unit >> 8;
    const size_t gofs = ((size_t)(bh >> 3) * 4096 + c * 16 + t) * 512 + (bh & 7) * 64 + cq * 4;
    r.ue = *(const u32x2*)(a.se + gofs);
    r.ukk = *(const u32x2*)(a.skk + gofs); r.uka = *(const u32x2*)(a.skka + gofs); r.uk = *(const u32x2*)(a.sk + gofs); r.ur = *(const u32x2*)(a.sr + gofs); r.uv = *(const u32x2*)(a.sv + gofs);
}
__device__ void cop_phase(char* smem, const CopArgs& a) {
    const int tid = otid(), t = tid >> 4, cq = tid & 15, j = cq;
    float* F = (float*)smem;
    float* Wc = F; float* KAP = F + 1088; float* RT = F + 2176; float* KT = F + 3264; float* BT = F + 4352;
    float* SM = F + 5440;
    bf16_t* STG = (bf16_t*)(F + 5440 + 15 * 320);
#define SMAT(i) (SM + (i) * 320)
    int unit = blockIdx.x;
    if (unit >= 8192) return;
    CopIn cur, nxt;
    cop_in_load(cur, a, unit, t, cq);
    nxt = cur;
#pragma unroll 1
    for (; unit < 8192; unit += gridDim.x) {
        if (unit + (int)gridDim.x < 8192) cop_in_load(nxt, a, unit + gridDim.x, t, cq);
        __syncthreads();
        *(f32x4*)(Wc + t * 68 + cq * 4) = unpk4(cur.ue);
        __syncthreads();
        if (tid < 64) {
            float x[16];
#pragma unroll
            for (int i = 0; i < 16; ++i) x[i] = Wc[i * 68 + tid];
#pragma unroll
            for (int i = 1; i < 16; ++i) x[i] += x[i - 1];
#pragma unroll
            for (int i = 0; i < 16; ++i) Wc[i * 68 + tid] = x[i];
        }
        __syncthreads();
        const f32x4 ct = *(const f32x4*)(Wc + t * 68 + cq * 4), cC = *(const f32x4*)(Wc + 15 * 68 + cq * 4);
        f32x4 cp = (f32x4){0.f, 0.f, 0.f, 0.f}; if (t > 0) cp = *(const f32x4*)(Wc + (t - 1) * 68 + cq * 4);
        const f32x4 Wt = (f32x4){__expf(-ct.x), __expf(-ct.y), __expf(-ct.z), __expf(-ct.w)}, Wp = (f32x4){__expf(-cp.x), __expf(-cp.y), __expf(-cp.z), __expf(-cp.w)};
        const f32x4 WC = (f32x4){__expf(-cC.x), __expf(-cC.y), __expf(-cC.z), __expf(-cC.w)};
        {
            const f32x4 rW = (f32x4){__expf(ct.x), __expf(ct.y), __expf(ct.z), __expf(ct.w)};
            *(f32x4*)(KAP + t * 68 + cq * 4) = unpk4(cur.ukk) * Wp;
            *(f32x4*)(RT + t * 68 + cq * 4) = unpk4(cur.ur) * Wt;
            *(f32x4*)(KT + t * 68 + cq * 4) = unpk4(cur.uk) * rW;
            *(f32x4*)(BT + t * 68 + cq * 4) = unpk4(cur.uka) * rW;
        }
        __syncthreads();
        {
            const int wv = tid >> 6, ln = tid & 63, gfr = ln & 15, gfq = ln >> 4;
            const float* X = (wv < 2 ? KAP : RT) + gfr * 68 + gfq * 16;
            const float* Y = ((wv & 1) ? BT : KT) + gfr * 68 + gfq * 16;
            f32x4 acc = (f32x4){0.f, 0.f, 0.f, 0.f};
#pragma unroll
            for (int q = 0; q < 4; ++q) {
                const f32x4 xa = *(const f32x4*)(X + q * 4), ya = *(const f32x4*)(Y + q * 4);
                acc = __builtin_amdgcn_mfma_f32_16x16x4f32(xa.x, ya.x, acc, 0, 0, 0);
                acc = __builtin_amdgcn_mfma_f32_16x16x4f32(xa.y, ya.y, acc, 0, 0, 0);
                acc = __builtin_amdgcn_mfma_f32_16x16x4f32(xa.z, ya.z, acc, 0, 0, 0);
                acc = __builtin_amdgcn_mfma_f32_16x16x4f32(xa.w, ya.w, acc, 0, 0, 0);
            }
#pragma unroll
            for (int jj = 0; jj < 4; ++jj) {
                const int tt = gfq * 4 + jj, jc = gfr;
                const float v = (wv < 2 ? jc < tt : jc <= tt) ? acc[jj] : 0.f;
                SMAT(wv)[tt * 20 + jc] = v;
                if (wv == 1) SMAT(12)[tt * 20 + jc] = (tt == jc ? 1.f : 0.f) - v;
            }
        }
        __syncthreads();
        {
            const int wv = tid >> 6, ln = tid & 63, mfr = ln & 15, mfq = ln >> 4;
            if (wv == 0) { const f32x4 v = mm16m(SMAT(1), SMAT(1), mfr, mfq); mm16st(SMAT(4), v, mfr, mfq, 0.f); mm16st(SMAT(13), v, mfr, mfq, 1.f); }
            __syncthreads();
            if (wv == 0) { const f32x4 v = mm16m(SMAT(4), SMAT(4), mfr, mfq); mm16st(SMAT(5), v, mfr, mfq, 0.f); mm16st(SMAT(14), v, mfr, mfq, 1.f); }
            else if (wv == 1) mm16st(SMAT(7), mm16m(SMAT(12), SMAT(13), mfr, mfq), mfr, mfq, 0.f);
            __syncthreads();
            if (wv == 0) mm16st(SMAT(6), mm16m(SMAT(5), SMAT(5), mfr, mfq), mfr, mfq, 1.f);
            else if (wv == 1) mm16st(SMAT(8), mm16m(SMAT(7), SMAT(14), mfr, mfq), mfr, mfq, 0.f);
            __syncthreads();
            if (wv == 0) mm16st(SMAT(9), mm16m(SMAT(8), SMAT(6), mfr, mfq), mfr, mfq, 0.f);
            __syncthreads();
            if (wv == 0) mm16st(SMAT(10), mm16m(SMAT(9), SMAT(0), mfr, mfq), mfr, mfq, 0.f);
            else if (wv == 1) mm16st(SMAT(11), mm16m(SMAT(3), SMAT(9), mfr, mfq), mfr, mfq, 0.f);
            __syncthreads();
        }
        char* U = a.cops + (size_t)unit * COP_STRIDE;
        if (tid < 64) {
            const int mfr = tid & 15, mfq = tid >> 4; const f32x4 v = mm16m(SMAT(11), SMAT(0), mfr, mfq);
#pragma unroll
            for (int jj = 0; jj < 4; ++jj) ((bf16_t*)(U + 4096))[(4 * mfq + jj) * 16 + mfr] = bf1(SMAT(2)[(4 * mfq + jj) * 20 + mfr] - v[jj]);
        }
        {
            const int wv = tid >> 6, ln = tid & 63, ofr = ln & 15, ofq = ln >> 4, k = wv * 16 + ofr;
            f32x4 a3 = (f32x4){0.f, 0.f, 0.f, 0.f}, a1 = a3, ak = a3;
#pragma unroll
            for (int m = 0; m < 4; ++m) {
                const int i = 4 * m + ofq;
                const float kapv = KAP[i * 68 + k], btv = BT[i * 68 + k];
                a3 = __builtin_amdgcn_mfma_f32_16x16x4f32(SMAT(9)[ofr * 20 + i], kapv, a3, 0, 0, 0);
                a1 = __builtin_amdgcn_mfma_f32_16x16x4f32(SMAT(11)[ofr * 20 + i], kapv, a1, 0, 0, 0);
                ak = __builtin_amdgcn_mfma_f32_16x16x4f32(SMAT(10)[i * 20 + ofr], btv, ak, 0, 0, 0);
            }
            const float wck = __expf(-Wc[15 * 68 + k]);
            const int pk = 32 * (k >> 5) + 8 * ((k >> 2) & 3) + 4 * ((k >> 4) & 1) + (k & 3);
            bf16_t* QST = STG + 3072;
            float bh[4], khv[4];
#pragma unroll
            for (int jj = 0; jj < 4; ++jj) {
                const int tt = 4 * ofq + jj;
                QST[tt * 64 + pk] = bf1(a3[jj]);
                QST[(16 + tt) * 64 + pk] = bf1(RT[tt * 68 + k] - a1[jj]);
                const float btk = BT[tt * 68 + k];
                bh[jj] = btk * wck; khv[jj] = (KT[tt * 68 + k] - ak[jj]) * wck;
            }
            u32x4 wbk; wbk.x = pk_bf16(bh[0], bh[1]); wbk.y = pk_bf16(bh[2], bh[3]); wbk.z = pk_bf16(khv[0], khv[1]); wbk.w = pk_bf16(khv[2], khv[3]);
            *(u32x4*)((char*)STG + (k * 32 + ofq * 8) * 2) = wbk;
        }
        STG[2048 + (cq * 4 + 0) * 16 + t] = (bf16_t)(cur.uv.x & 0xffffu); STG[2048 + (cq * 4 + 1) * 16 + t] = (bf16_t)(cur.uv.x >> 16);
        STG[2048 + (cq * 4 + 2) * 16 + t] = (bf16_t)(cur.uv.y & 0xffffu); STG[2048 + (cq * 4 + 3) * 16 + t] = (bf16_t)(cur.uv.y >> 16);
        if (tid < 64) ((float*)(U + 10752))[tid] = __expf(-Wc[15 * 68 + tid]);
        __syncthreads();
        *(u32x4*)(U + tid * 16) = *(const u32x4*)((const char*)STG + 6144 + tid * 16);
        *(u32x4*)(U + 4608 + tid * 16) = *(const u32x4*)((const char*)STG + tid * 16);
        if (tid < 128) *(u32x4*)(U + 8704 + tid * 16) = *(const u32x4*)((const char*)STG + 4096 + tid * 16);
        cur = nxt;
    }
#undef SMAT
}

__device__ __forceinline__ int cop_lds_of(int q) {
    if (q < 256) { const int row = q >> 3, pos = q & 7; return row * 128 + ((pos ^ ((row >> 1) & 7)) << 4); }
    if (q < 288) return q * 16;
    if (q < 544) { const int q2 = q - 288; return 4608 + (q2 & 3) * 1024 + (q2 >> 2) * 16; }
    return q * 16;
}
struct CopOps { u32x4 qc[2][2]; u32x2 q2; u32x4 bk[4]; u32x2 vt; f32x4 wc[4]; };
__device__ void chunk_scan(char* smem, const char* cops, float* yraw, int bl, int hh) {
    const int tid = otid(), lane = tid & 63, w = tid >> 6, fr = lane & 15, fq = lane >> 4;
    f32x4 st[4];
#pragma unroll
    for (int kt = 0; kt < 4; ++kt) st[kt] = (f32x4){0.f, 0.f, 0.f, 0.f};
    const char* U = cops + (size_t)((bl * 8 + hh) * 256) * COP_STRIDE + tid * 16;
    float* yp = yraw + ((size_t)bl * 4096 + fq * 4) * 512 + hh * 64 + w * 16 + fr;
    const int l0 = cop_lds_of(tid), l1 = cop_lds_of(tid + 256), l2 = cop_lds_of(tid < 176 ? tid + 512 : 0);
    const bool has2 = tid < 176;
    const int qo0 = fr * 128 + (((0 * 4 + fq) ^ ((fr >> 1) & 7)) << 4), qo1 = fr * 128 + (((1 * 4 + fq) ^ ((fr >> 1) & 7)) << 4);
    const int q2o = 4096 + fr * 32 + fq * 8, bko = 4608 + fq * 1024 + fr * 16, vto = 8704 + (w * 16 + fr) * 32 + fq * 8, wco = 10752 + fq * 16;
    u32x4 sA[3], sB[3], sC[3], sD[3];
    __builtin_amdgcn_s_setprio(3);
#define CS_LOAD(S, C) do { const char* g_ = U + (size_t)(C) * COP_STRIDE; S[0] = *(const u32x4*)g_; S[1] = *(const u32x4*)(g_ + 4096); if (has2) S[2] = *(const u32x4*)(g_ + 8192); } while (0)
#define CS_WRITE(S, SLOT) do { char* d_ = smem + (SLOT) * 11008; *(u32x4*)(d_ + l0) = S[0]; *(u32x4*)(d_ + l1) = S[1]; if (has2) *(u32x4*)(d_ + l2) = S[2]; } while (0)
    sA[2] = (u32x4){0u, 0u, 0u, 0u}; sB[2] = sA[2]; sC[2] = sA[2]; sD[2] = sA[2];
    CS_LOAD(sA, 0); CS_LOAD(sB, 1); CS_LOAD(sC, 2); CS_LOAD(sD, 3);
    CopOps R0, R1;
    auto ldsload = [&](CopOps& r, const char* L) {
        r.qc[0][0] = *(const u32x4*)(L + qo0); r.qc[0][1] = *(const u32x4*)(L + qo1); r.qc[1][0] = *(const u32x4*)(L + 2048 + qo0); r.qc[1][1] = *(const u32x4*)(L + 2048 + qo1);
        r.q2 = *(const u32x2*)(L + q2o); r.vt = *(const u32x2*)(L + vto);
#pragma unroll
        for (int kt = 0; kt < 4; ++kt) { r.bk[kt] = *(const u32x4*)(L + bko + kt * 256); r.wc[kt] = *(const f32x4*)(L + wco + kt * 64); }
    };
    auto compute = [&](const int c, const CopOps& r) {
        const u32x4 (&qc)[2][2] = r.qc; const u32x4 (&bk)[4] = r.bk; const f32x4 (&wc)[4] = r.wc; const u32x2 q2 = r.q2, vt = r.vt;
        u32x4 hi[2], lo[2];
#pragma unroll
        for (int s = 0; s < 2; ++s) {
            const f32x4 a0 = st[2 * s], a1 = st[2 * s + 1];
            hi[s].x = pk_bf16(a0.x, a0.y); hi[s].y = pk_bf16(a0.z, a0.w); hi[s].z = pk_bf16(a1.x, a1.y); hi[s].w = pk_bf16(a1.z, a1.w);
            lo[s].x = pk_bf16(a0.x - bf_lo(hi[s].x), a0.y - bf_hi(hi[s].x)); lo[s].y = pk_bf16(a0.z - bf_lo(hi[s].y), a0.w - bf_hi(hi[s].y));
            lo[s].z = pk_bf16(a1.x - bf_lo(hi[s].z), a1.y - bf_hi(hi[s].z)); lo[s].w = pk_bf16(a1.z - bf_lo(hi[s].w), a1.w - bf_hi(hi[s].w));
        }
        f32x4 p1 = (f32x4){0.f, 0.f, 0.f, 0.f}, p2 = p1;
#pragma unroll
        for (int s = 0; s < 2; ++s) {
            p1 = __builtin_amdgcn_mfma_f32_16x16x32_bf16(__builtin_bit_cast(bf16x8, qc[0][s]), __builtin_bit_cast(bf16x8, hi[s]), p1, 0, 0, 0);
            p2 = __builtin_amdgcn_mfma_f32_16x16x32_bf16(__builtin_bit_cast(bf16x8, qc[1][s]), __builtin_bit_cast(bf16x8, hi[s]), p2, 0, 0, 0);
            p1 = __builtin_amdgcn_mfma_f32_16x16x32_bf16(__builtin_bit_cast(bf16x8, qc[0][s]), __builtin_bit_cast(bf16x8, lo[s]), p1, 0, 0, 0);
            p2 = __builtin_amdgcn_mfma_f32_16x16x32_bf16(__builtin_bit_cast(bf16x8, qc[1][s]), __builtin_bit_cast(bf16x8, lo[s]), p2, 0, 0, 0);
        }
        p2 = __builtin_amdgcn_mfma_f32_16x16x32_bf16(__builtin_bit_cast(bf16x8, ((u32x4){q2.x, q2.y, 0u, 0u})), __builtin_bit_cast(bf16x8, ((u32x4){vt.x, vt.y, 0u, 0u})), p2, 0, 0, 0);
#pragma unroll
        for (int j = 0; j < 4; ++j) yp[(size_t)(c * 16 + j) * 512] = p2[j];
        u32x4 xh, xl;
        xh.x = pk_bf16(-p1.x, -p1.y); xh.y = pk_bf16(-p1.z, -p1.w); xh.z = vt.x; xh.w = vt.y;
        xl.x = pk_bf16(-p1.x - bf_lo(xh.x), -p1.y - bf_hi(xh.x)); xl.y = pk_bf16(-p1.z - bf_lo(xh.y), -p1.w - bf_hi(xh.y)); xl.z = 0u; xl.w = 0u;
#pragma unroll
        for (int kt = 0; kt < 4; ++kt) {
            f32x4 acc = st[kt] * wc[kt];
            acc = __builtin_amdgcn_mfma_f32_16x16x32_bf16(__builtin_bit_cast(bf16x8, bk[kt]), __builtin_bit_cast(bf16x8, xh), acc, 0, 0, 0);
            acc = __builtin_amdgcn_mfma_f32_16x16x32_bf16(__builtin_bit_cast(bf16x8, bk[kt]), __builtin_bit_cast(bf16x8, xl), acc, 0, 0, 0);
            st[kt] = acc;
        }
    };
    CS_WRITE(sA, 0); CS_LOAD(sA, 4);
    __syncthreads();
    ldsload(R0, smem);
#define CS_STEP(S, C, RC, RN) do { if ((C) + 1 < 256) CS_WRITE(S, ((C) + 1) & 1); if ((C) + 5 < 256) CS_LOAD(S, (C) + 5); __syncthreads(); \
        if ((C) + 1 < 256) ldsload(RN, smem + (((C) + 1) & 1) * 11008); compute((C), RC); } while (0)
#pragma unroll 1
    for (int c = 0; c < 256; c += 4) { CS_STEP(sB, c, R0, R1); CS_STEP(sC, c + 1, R1, R0); CS_STEP(sD, c + 2, R0, R1); CS_STEP(sA, c + 3, R1, R0); }
#undef CS_STEP
#undef CS_LOAD
#undef CS_WRITE
    __builtin_amdgcn_s_setprio(0);
    __syncthreads();
}

__global__ void __launch_bounds__(256, 2) fwd_megakernel(Params p) {
    __shared__ __attribute__((aligned(16))) char smem[65536 + 64];
    cg::grid_group grid = cg::this_grid();
    if (threadIdx.x == 0) { ((volatile LAS unsigned*)(smem + 65536))[0] = 0u; ((volatile LAS unsigned*)(smem + 65536))[1] = 0u; }
    __syncthreads();
    const XcdBarrier xb = xcd_barrier_post((unsigned*)(p.ws + OFF_BAR), (volatile LAS unsigned*)(smem + 65536));
    const unsigned cu_key = (xb.x & 7u) * 256u + ((unsigned)__builtin_amdgcn_s_getreg((7 << 11) | (8 << 6) | 4) & 0xffu);
    if (threadIdx.x == 0) (void)xb_add((unsigned*)(p.ws + OFF_CUCNT) + cu_key, 1u);
    char* ws = p.ws;
    float* mod = (float*)(ws + OFF_MOD);
    const float* cs = (const float*)(ws + OFF_COS); const float* sn = (const float*)(ws + OFF_SIN);
    bf16_t* hbuf = (bf16_t*)(ws + OFF_H);
    bf16_t* proj = (bf16_t*)(ws + OFF_PROJ);
    bf16_t *sr = (bf16_t*)(ws + OFF_SR), *sk = (bf16_t*)(ws + OFF_SK), *sv = (bf16_t*)(ws + OFF_SV), *skk = (bf16_t*)(ws + OFF_SKK), *skka = (bf16_t*)(ws + OFF_SKKA);
    bf16_t* se = (bf16_t*)(ws + OFF_SW);
    float *rsq = (float*)(ws + OFF_RSQ), *rskv = (float*)(ws + OFF_RSKV);
    bf16_t *Qh = (bf16_t*)(ws + OFF_Q), *Kh = (bf16_t*)(ws + OFF_K), *Vt = (bf16_t*)(ws + OFF_VT);
    float* yraw = (float*)(ws + OFF_YRAW);
    bf16_t* ycat = (bf16_t*)(ws + OFF_YCAT);
    bf16_t* vfirst = (bf16_t*)(ws + OFF_VFIRST);
    int* ctrl = (int*)(ws + OFF_CTRL);
    volatile int* s_item = (volatile int*)(smem + 65536 + 16);

    for (int rep = 0; rep < REP_P0; ++rep) prologue(smem, p);
    grid.sync();
    bool scan_role;
    {
        const unsigned k2 = (cu_key & ~255u) + threadIdx.x;
        const int lidx = __syncthreads_count(k2 < cu_key && xb_ld((unsigned*)(p.ws + OFF_CUCNT) + k2) > 0u);
        scan_role = lidx < 24;
    }

    norm_phase(p.x, p.norm_g, mod, hbuf, 0);
    GSYNC();
#pragma unroll 1
    for (int l = 0; l < NL; ++l) {
        const float* modl = mod + (size_t)l * 8 * 3072;
#pragma unroll 1
        for (int half = 0; half < 2; ++half) {
            const int tgbase = half * TH;
            {
                EpiProj e{proj, rsq, rskv, smem};
                const bf16_t* A = hbuf; const bf16_t* Bt = (const bf16_t*)(ws + OFF_WIN) + (size_t)l * NP * 1024;
                const int xcd = blockIdx.x & 7, loc = blockIdx.x >> 3, nloc = gridDim.x >> 3;
                for (int rep = 0; rep < REP_P2; ++rep) {
                if (rep) xcd_barrier(xb);
                for (int jn = loc; jn < 432; jn += nloc) {
                    const int mg = jn / 216, rem = jn - mg * 216, nt = rem >> 3, mi = rem & 7, mt = xcd * 16 + mg * 8 + mi;
                    gemm_tile(smem, A, 1024, Bt, 1024, 1024, mt * 128, nt * 128, e);
                }
                }
            }
            GSYNC();
            {
                PrepArgs pa;
                pa.proj = proj; pa.mu = p.mu_shift + l * 1664; pa.muv = p.mu_vmix + (l > 0 ? (l - 1) * 32 : 0);
                pa.wdec = (const bf16_t*)(ws + OFF_WDEC) + (size_t)l * 512 * 64; pa.wicl = (const bf16_t*)(ws + OFF_WICL) + (size_t)l * 512 * 64;
                pa.wvm = (const bf16_t*)(ws + OFF_WVM) + (size_t)l * 512 * 32;
                pa.w0 = p.w0 + l * 512; pa.a0 = p.a0 + l * 512; pa.v0 = p.v0 + (l > 0 ? (l - 1) * 512 : 0); pa.k_k = p.k_k + l * 512; pa.k_a = p.k_a + l * 512;
                pa.cs = cs; pa.sn = sn; pa.sr = sr; pa.sk = sk; pa.sv = sv; pa.skk = skk; pa.skka = skka; pa.se = se; pa.vfirst = vfirst; pa.Kh = Kh;
                pa.layer = l; pa.tgbase = tgbase;
                EpiKV ekv{Kh, Vt, rskv, smem};
                EpiQ eq{Qh, rsq, cs, sn, tgbase, smem};
                const bf16_t* Bkv = (const bf16_t*)(ws + OFF_WUKV) + (size_t)l * 1024 * 256; const bf16_t* Bq = (const bf16_t*)(ws + OFF_WUQ) + (size_t)l * 768 * 384;
                for (int rep = 0; rep < REP_P3; ++rep) {
                if (rep) xcd_barrier(xb);
                {
                    for (int it = blockIdx.x; it < 1024; it += gridDim.x) prep_tile(smem, pa, it >> 2, it & 3);
                    const int xcd = blockIdx.x & 7, loc = blockIdx.x >> 3, nloc = gridDim.x >> 3;
                    for (int j = loc; j < 128; j += nloc) gemm_tile(smem, proj + O_CKV, NP, Bkv, 256, 256, (xcd * 16 + (j >> 3)) * 128, (j & 7) * 128, ekv);
                    for (int j = loc; j < 96; j += nloc) { const int ml = j / 6, nt = j - ml * 6; gemm_tile(smem, proj + O_CQ, NP, Bq, 384, 384, (xcd * 16 + ml) * 128, nt * 128, eq); }
                }
                }
            }
            GSYNC();
            {
                CopArgs ca{sr, sk, sv, skk, skka, se, ws + OFF_COPS};
                cop_phase(smem, ca);
            }
            GSYNC();
            {
                int* ctr = ctrl + (l * 2 + half);
                for (;;) {
                    __syncthreads();
                    if (threadIdx.x == 0) *s_item = atomicAdd(ctr, 1);
                    __syncthreads();
                    const int item = *s_item;
                    const int nconv = (half == 0 && l + 1 < NL) ? 512 : 0;
                    if (item >= 32 + 1024 + nconv) break;
                    if (item < 32) chunk_scan(smem, ws + OFF_COPS, yraw, item >> 3, item & 7);
                    else if (item < 32 + 1024) { const int t = item - 32, qt = 31 - (t >> 5), bh = t & 31; attn_tile(smem, Qh, Kh, Vt, proj, ycat, bh >> 3, bh & 7, qt); }
                    else convert_layer(smem, p, l + 1, item - (32 + 1024), 512);
                }
            }
            GSYNC();
            {
                FinArgs fa{yraw, sr, sk, sv, proj, p.lnx_w + l * 512, p.lnx_b + l * 512, p.r_k + l * 512, ycat, nullptr, nullptr};
                for (int rep = 0; rep < REP_P5; ++rep) { if (rep) xcd_barrier(xb); rwkv_finalize(fa); }
                const int ln = half == 0 ? l : l + 1, hn = half ^ 1;
                if (ln < NL) norm_phase(ln == 0 ? p.x : p.out, p.norm_g + ln * 1024, mod + (size_t)ln * 8 * 3072, hbuf, hn * TH);
            }
            GSYNC();
            {
                for (int rep = 0; rep < REP_P6; ++rep) {
                if (rep) xcd_barrier(xb);
                EpiOut eo{l == 0 ? p.x : p.out, p.out, modl, tgbase, rep == REP_P6 - 1 ? 1.0f : 0.0f};
                const bf16_t* Bo = (const bf16_t*)(ws + OFF_WOUT) + (size_t)l * 1024 * 1024;
                {
                    const int xcd = blockIdx.x & 7, loc = blockIdx.x >> 3, nloc = gridDim.x >> 3;
                    for (int j = loc; j < 128; j += nloc) gemm_tile(smem, ycat, 1024, Bo, 1024, 1024, (xcd * 16 + (j >> 3)) * 128, (j & 7) * 128, eo);
                }
                }
            }
        }
    }
    GSYNC();
    final_norm(p.out, p.final_g);
}

extern "C" void kernel_launch(void* const* d_in, const int* in_sizes, int n_in, void* d_out, int out_size, void* d_ws, size_t ws_size, hipStream_t stream) {
    static int grid_blocks = 0;
    if (!grid_blocks) {
        int dev = 0, cus = 0, per_cu = 0;
        (void)hipGetDevice(&dev);
        (void)hipDeviceGetAttribute(&cus, hipDeviceAttributeMultiprocessorCount, dev);
        (void)hipOccupancyMaxActiveBlocksPerMultiprocessor(&per_cu, fwd_megakernel, 256, 0);
        if (per_cu > 2) per_cu = 2;
        if (per_cu < 1) per_cu = 1;
        grid_blocks = cus * per_cu;
        if (grid_blocks % 8) grid_blocks -= grid_blocks % 8;
    }
    Params p{};
    p.x = (const float*)d_in[0]; p.c = (const float*)d_in[1]; p.pos = (const int*)d_in[2];
    p.norm_g = (const float*)d_in[3]; p.w_ada = (const float*)d_in[4]; p.b_ada = (const float*)d_in[5]; p.w_in = (const float*)d_in[6];
    p.w_vmd = (const float*)d_in[7]; p.mu_shift = (const float*)d_in[8]; p.mu_vmix = (const float*)d_in[9]; p.w0 = (const float*)d_in[10];
    p.w_dec = (const float*)d_in[11]; p.a0 = (const float*)d_in[12]; p.w_icl = (const float*)d_in[13]; p.v0 = (const float*)d_in[14];
    p.w_vmu = (const float*)d_in[15]; p.k_k = (const float*)d_in[16]; p.k_a = (const float*)d_in[17]; p.r_k = (const float*)d_in[18];
    p.lnx_w = (const float*)d_in[19]; p.lnx_b = (const float*)d_in[20]; p.qng = (const float*)d_in[21]; p.kvng = (const float*)d_in[22];
    p.w_uq = (const float*)d_in[23]; p.w_ukv = (const float*)d_in[24]; p.w_out = (const float*)d_in[25]; p.final_g = (const float*)d_in[26];
    p.out = (float*)d_out; p.ws = (char*)d_ws;
    (void)hipMemsetAsync((char*)d_ws + OFF_BAR, 0, 16384 + 4096 + 8192, stream);
    void* args[] = {&p};
    hipError_t e = hipLaunchCooperativeKernel((void*)fwd_megakernel, dim3(grid_blocks), dim3(256), args, 0, stream);
    if (e != hipSuccess) fprintf(stderr, "cooperative launch failed: %s (grid %d)\n", hipGetErrorString(e), grid_blocks);
}
```

```cpp
#include <hip/hip_runtime.h>
#include <hip/hip_cooperative_groups.h>
#include <cstdio>
#include <cstdint>
namespace cg = cooperative_groups;
constexpr int REP_P1 = 1, REP_P2 = 1, REP_P3 = 1, REP_P4 = 1, REP_P5 = 1, REP_P6 = 1, REP_SYNC = 1, REP_P0 = 1;
#define GSYNC() do { for (int r_ = 0; r_ < REP_SYNC; ++r_) xcd_barrier(xb); } while (0)


typedef unsigned short bf16_t;
typedef short bf16x8 __attribute__((ext_vector_type(8)));
typedef float f32x4 __attribute__((ext_vector_type(4)));
typedef float f32x2 __attribute__((ext_vector_type(2)));
typedef unsigned u32x4 __attribute__((ext_vector_type(4)));
typedef unsigned u32x2 __attribute__((ext_vector_type(2)));
#define LAS __attribute__((address_space(3)))

constexpr int DM = 1024, NB = 8, SEQ = 4096, NT = NB * SEQ, TH = NT / 2, NL = 4;
constexpr int NP = 3456;
constexpr int O_GR = 1664, O_CQ = 2176, O_CKV = 2560, O_KR = 2816, O_GM = 2848, INW = 3360;
constexpr float QSCALE = 0.10206207261596577f * 1.4426950408889634f;

constexpr size_t al256(size_t x) { return (x + 255) & ~(size_t)255; }
constexpr size_t OFF_BAR = 0;
constexpr size_t OFF_CTRL = 16384;
constexpr size_t OFF_CUCNT = 16384 + 4096;
constexpr size_t OFF_MOD = 16384 + 4096 + 8192;
constexpr size_t OFF_COS = OFF_MOD + al256((size_t)NL * NB * 3072 * 4);
constexpr size_t OFF_SIN = OFF_COS + (size_t)NT * 16 * 4;
constexpr size_t OFF_WIN = OFF_SIN + (size_t)NT * 16 * 4;
constexpr size_t OFF_WOUT = OFF_WIN + (size_t)NL * NP * 1024 * 2;
constexpr size_t OFF_WUQ = OFF_WOUT + (size_t)NL * 1024 * 1024 * 2;
constexpr size_t OFF_WUKV = OFF_WUQ + (size_t)NL * 768 * 384 * 2;
constexpr size_t OFF_WDEC = OFF_WUKV + (size_t)NL * 1024 * 256 * 2;
constexpr size_t OFF_WICL = OFF_WDEC + (size_t)NL * 512 * 64 * 2;
constexpr size_t OFF_WVM = OFF_WICL + (size_t)NL * 512 * 64 * 2;
constexpr size_t OFF_VFIRST = OFF_WVM + (size_t)NL * 512 * 32 * 2;
constexpr size_t OFF_H = OFF_VFIRST + (size_t)NT * 512 * 2;
constexpr int COP_STRIDE = 11008;
constexpr size_t OFF_COPS = OFF_H;
constexpr size_t OFF_PROJ = OFF_H + (size_t)8192 * COP_STRIDE;
constexpr size_t OFF_SR = OFF_PROJ + (size_t)TH * NP * 2;
constexpr size_t OFF_SK = OFF_SR + (size_t)TH * 512 * 2;
constexpr size_t OFF_SV = OFF_SK + (size_t)TH * 512 * 2;
constexpr size_t OFF_SKK = OFF_SV + (size_t)TH * 512 * 2;
constexpr size_t OFF_SKKA = OFF_SKK + (size_t)TH * 512 * 2;
constexpr size_t OFF_SW = OFF_SKKA + (size_t)TH * 512 * 2;
constexpr size_t OFF_RSQ = OFF_SW + (size_t)TH * 512 * 4;
constexpr size_t OFF_RSKV = OFF_RSQ + (size_t)TH * 8 * 4;
constexpr size_t OFF_Q = OFF_RSKV + (size_t)TH * 4 * 4;
constexpr size_t OFF_K = OFF_Q + (size_t)TH * 768 * 2;
constexpr size_t OFF_VT = OFF_K + (size_t)TH * 768 * 2;
constexpr size_t OFF_YRAW = OFF_VT + (size_t)TH * 512 * 2;
constexpr size_t OFF_YCAT = OFF_YRAW + (size_t)TH * 512 * 4;
constexpr size_t WS_TOTAL = OFF_YCAT + (size_t)TH * 1024 * 2;
static_assert(WS_TOTAL <= (size_t)536870912, "workspace exceeds 512 MiB");

struct Params {
    const float *x, *c; const int* pos;
    const float *norm_g, *w_ada, *b_ada, *w_in, *w_vmd, *mu_shift, *mu_vmix, *w0, *w_dec, *a0, *w_icl, *v0, *w_vmu;
    const float *k_k, *k_a, *r_k, *lnx_w, *lnx_b, *qng, *kvng, *w_uq, *w_ukv, *w_out, *final_g;
    float* out; char* ws;
};

__device__ __forceinline__ int otid() { int t = threadIdx.x; asm volatile("" : "+v"(t)); return t; }
__device__ __forceinline__ unsigned pk_bf16(float lo, float hi) { unsigned r; asm("v_cvt_pk_bf16_f32 %0, %1, %2" : "=v"(r) : "v"(lo), "v"(hi)); return r; }
__device__ __forceinline__ float bf_lo(unsigned u) { return __uint_as_float(u << 16); }
__device__ __forceinline__ float bf_hi(unsigned u) { return __uint_as_float(u & 0xffff0000u); }
__device__ __forceinline__ float sigmoidf_(float x) { return __builtin_amdgcn_rcpf(1.0f + __expf(-x)); }
__device__ __forceinline__ float siluf_(float x) { return x * __builtin_amdgcn_rcpf(1.0f + __expf(-x)); }
__device__ __forceinline__ float tanhf_(float x) { const float t = __expf(2.0f * x); return 1.0f - 2.0f * __builtin_amdgcn_rcpf(t + 1.0f); }
template <int CTRL> __device__ __forceinline__ float dpp_add(float x) {
    return x + __int_as_float(__builtin_amdgcn_update_dpp(0, __float_as_int(x), CTRL, 0xf, 0xf, true));
}
__device__ __forceinline__ float dpp_sum16(float x) {
    x = dpp_add<0xB1>(x);
    x = dpp_add<0x4E>(x);
    x = dpp_add<0x141>(x);
    x = dpp_add<0x140>(x);
    return x;
}
__device__ __forceinline__ void dpp_sum16x2(float& a, float& b) {
    a = dpp_add<0xB1>(a); b = dpp_add<0xB1>(b);
    a = dpp_add<0x4E>(a); b = dpp_add<0x4E>(b);
    a = dpp_add<0x141>(a); b = dpp_add<0x141>(b);
    a = dpp_add<0x140>(a); b = dpp_add<0x140>(b);
}
__device__ __forceinline__ float wave_sum64(float x) {
    x += __shfl_xor(x, 1); x += __shfl_xor(x, 2); x += __shfl_xor(x, 4); x += __shfl_xor(x, 8); x += __shfl_xor(x, 16); x += __shfl_xor(x, 32);
    return x;
}


#define XB_TMO      128
#define XB_XCNT(j)  (256  + 64 * (j))
#define XB_XSUB(j)  (1280 + 64 * (j))
#define XB_XGEN(j)  (2304 + 64 * (j))
#define XB_TOP      3328
#define XB_TOPGEN   3392
#define XCD_BAR_WORDS 3456
#define XB_SPIN_CAP (1u << 18)
__device__ __forceinline__ unsigned xb_ld(unsigned* p)              { return __hip_atomic_load(p, __ATOMIC_RELAXED, __HIP_MEMORY_SCOPE_AGENT); }
__device__ __forceinline__ unsigned xb_add(unsigned* p, unsigned v) { return __hip_atomic_fetch_add(p, v, __ATOMIC_RELAXED, __HIP_MEMORY_SCOPE_AGENT); }
__device__ __forceinline__ unsigned xb_xcc_id() { return (unsigned)__builtin_amdgcn_s_getreg((3 << 11) | 20) & 0xFu; }
#define XB_SPIN(cond, bar) do { unsigned _sp = 0; while (cond) { __builtin_amdgcn_s_sleep(1); \
    if ((++_sp & 255u) == 0u) { if (xb_ld(&(bar)[XB_TMO])) break; if (_sp > XB_SPIN_CAP) { atomicAdd(&(bar)[XB_TMO], 1u); break; } } } } while (0)
struct XcdBarrier { unsigned* bar; unsigned x; volatile LAS unsigned* st; };
__device__ __forceinline__ XcdBarrier xcd_barrier_post(unsigned* bar, volatile LAS unsigned* st) {
    XcdBarrier b; b.bar = bar; b.x = xb_xcc_id(); b.st = st;
    if (threadIdx.x == 0) (void)xb_add(&bar[XB_XCNT(b.x)], 1u);
    return b;
}
__device__ __forceinline__ void xcd_barrier_complete(unsigned* bar, unsigned x, unsigned& nloc, unsigned& nx) {
    const unsigned G = gridDim.x * gridDim.y * gridDim.z;
    unsigned sum, cnt, mine, sp = 0u;
    for (;;) {
        sum = 0u; cnt = 0u; mine = 0u;
#pragma unroll
        for (unsigned j = 0; j < 16; ++j) { const unsigned c = xb_ld(&bar[XB_XCNT(j)]); sum += c; cnt += (c > 0u) ? 1u : 0u; mine = (j == x) ? c : mine; }
        if (sum == G) break;
        __builtin_amdgcn_s_sleep(1);
        if ((++sp & 255u) == 0u) { if (xb_ld(&bar[XB_TMO])) break; if (sp > XB_SPIN_CAP) { atomicAdd(&bar[XB_TMO], 1u); break; } }
    }
    nloc = mine > 0u ? mine : 1u; nx = cnt > 0u ? cnt : 1u;
}
__device__ __forceinline__ void xcd_barrier(const XcdBarrier& b) {
    asm volatile("s_waitcnt vmcnt(0)" ::: "memory");
    __syncthreads();
    if (threadIdx.x == 0) {
        unsigned* bar = b.bar;
        __builtin_amdgcn_s_waitcnt(0);
        unsigned nloc = b.st[0], nx = b.st[1];
        if (nloc == 0u) { xcd_barrier_complete(bar, b.x, nloc, nx); b.st[0] = nloc; b.st[1] = nx; }
        const unsigned old = xb_add(&bar[XB_XSUB(b.x)], 1u);
        const unsigned gen = old / nloc;
        if (old + 1u == (gen + 1u) * nloc) {
            __builtin_amdgcn_fence(__ATOMIC_RELEASE, "agent");
            asm volatile("s_waitcnt vmcnt(0)" ::: "memory");
            const unsigned og = xb_add(&bar[XB_TOP], 1u);
            const unsigned tg = og / nx;
            if (og + 1u == (tg + 1u) * nx) xb_add(&bar[XB_TOPGEN], 1u);
            else XB_SPIN(xb_ld(&bar[XB_TOPGEN]) == tg, bar);
            __builtin_amdgcn_fence(__ATOMIC_ACQUIRE, "agent");
            xb_add(&bar[XB_XGEN(b.x)], 1u);
            asm volatile("s_waitcnt vmcnt(0)" ::: "memory");
        } else {
            XB_SPIN(xb_ld(&bar[XB_XGEN(b.x)]) == gen, bar);
            __builtin_amdgcn_fence(__ATOMIC_ACQUIRE, "agent");
            asm volatile("s_waitcnt vmcnt(0)" ::: "memory");
        }
    }
    __syncthreads();
}

__device__ void transpose_job(float* tile, const float* __restrict__ src, int ld, int K, int N, bf16_t* __restrict__ dst, int dst_rows,
                              const float* __restrict__ kscale, const float* __restrict__ src2, int ld2, int n2lo, int n2hi, int& rot, int idx, int nidx) {
    const int nkt = (K + 63) >> 6, nnt = (dst_rows + 63) >> 6, ntiles = nkt * nnt;
    const int tid_ = otid(); const int tx = tid_ & 63, ty = tid_ >> 6;
    const int first = (idx + nidx - rot % nidx) % nidx;
    rot += ntiles;
    for (int t = first; t < ntiles; t += nidx) {
        const int kt = t % nkt, nt = t / nkt, k0 = kt * 64, n0 = nt * 64;
#pragma unroll 4
        for (int i = 0; i < 16; ++i) {
            const int k = k0 + ty + 4 * i, n = n0 + tx; float v = 0.f;
            if (k < K) {
                if (n < N) { v = src[(size_t)k * ld + n]; if (kscale) v *= kscale[k]; }
                else if (src2 && n >= n2lo && n < n2hi) v = src2[(size_t)k * ld2 + (n - n2lo)];
            }
            tile[(ty + 4 * i) * 65 + tx] = v;
        }
        __syncthreads();
#pragma unroll 4
        for (int i = 0; i < 16; ++i) {
            const int n = n0 + ty + 4 * i, k = k0 + tx;
            if (n < dst_rows && k < K) dst[(size_t)n * K + k] = (bf16_t)(pk_bf16(tile[tx * 65 + ty + 4 * i], 0.f) & 0xffffu);
        }
        __syncthreads();
    }
}

__device__ void mod_job(float* lds, const Params& p, float* __restrict__ mod) {
    float* cact = lds;
    float* red = lds + 8192;
    const int tid = otid();
    bool have = false;
    for (int it = (int)gridDim.x - 1 - (int)blockIdx.x; it < 192; it += gridDim.x) {
        if (!have) {
            for (int i = tid; i < 8192; i += 256) cact[i] = siluf_(p.c[i]);
            have = true;
            __syncthreads();
        }
        const int l = it / 48, n0 = (it % 48) * 64, kg = tid >> 6, n = n0 + (tid & 63);
        float a0 = 0.f, a1 = 0.f, a2 = 0.f, a3 = 0.f, a4 = 0.f, a5 = 0.f, a6 = 0.f, a7 = 0.f;
        const float* wp = p.w_ada + ((size_t)l * 1024 + kg * 256) * 3072 + n;
#pragma unroll 8
        for (int k = 0; k < 256; ++k) {
            const float w = wp[(size_t)k * 3072]; const int kk = kg * 256 + k;
            a0 += cact[kk] * w; a1 += cact[1024 + kk] * w; a2 += cact[2048 + kk] * w; a3 += cact[3072 + kk] * w;
            a4 += cact[4096 + kk] * w; a5 += cact[5120 + kk] * w; a6 += cact[6144 + kk] * w; a7 += cact[7168 + kk] * w;
        }
        float* rp = red + (kg * 64 + (tid & 63)) * 8;
        rp[0] = a0; rp[1] = a1; rp[2] = a2; rp[3] = a3; rp[4] = a4; rp[5] = a5; rp[6] = a6; rp[7] = a7;
        __syncthreads();
        {
#pragma unroll
            for (int q = 0; q < 2; ++q) {
                const int o = tid + 256 * q, nn = o >> 3, b = o & 7;
                const float s = red[(0 * 64 + nn) * 8 + b] + red[(1 * 64 + nn) * 8 + b] + red[(2 * 64 + nn) * 8 + b] + red[(3 * 64 + nn) * 8 + b];
                mod[((size_t)l * 8 + b) * 3072 + n0 + nn] = s + p.b_ada[l * 3072 + n0 + nn];
            }
        }
        __syncthreads();
    }
}

__device__ void convert_layer(char* smem, const Params& p, int l, int idx, int nidx) {
    char* ws = p.ws; float* tile = (float*)smem; int rot = 0;
    transpose_job(tile, p.w_in + (size_t)l * 1024 * INW, INW, 1024, INW, (bf16_t*)(ws + OFF_WIN) + (size_t)l * NP * 1024, NP, nullptr,
                  l > 0 ? p.w_vmd + (size_t)(l - 1) * 1024 * 32 : nullptr, 32, INW, INW + 32, rot, idx, nidx);
    transpose_job(tile, p.w_out + (size_t)l * 1024 * 1024, 1024, 1024, 1024, (bf16_t*)(ws + OFF_WOUT) + (size_t)l * 1024 * 1024, 1024, nullptr, nullptr, 0, 0, 0, rot, idx, nidx);
    transpose_job(tile, p.w_uq + (size_t)l * 384 * 768, 768, 384, 768, (bf16_t*)(ws + OFF_WUQ) + (size_t)l * 768 * 384, 768, p.qng + l * 384, nullptr, 0, 0, 0, rot, idx, nidx);
    transpose_job(tile, p.w_ukv + (size_t)l * 256 * 1024, 1024, 256, 1024, (bf16_t*)(ws + OFF_WUKV) + (size_t)l * 1024 * 256, 1024, p.kvng + l * 256, nullptr, 0, 0, 0, rot, idx, nidx);
    transpose_job(tile, p.w_dec + (size_t)l * 64 * 512, 512, 64, 512, (bf16_t*)(ws + OFF_WDEC) + (size_t)l * 512 * 64, 512, nullptr, nullptr, 0, 0, 0, rot, idx, nidx);
    transpose_job(tile, p.w_icl + (size_t)l * 64 * 512, 512, 64, 512, (bf16_t*)(ws + OFF_WICL) + (size_t)l * 512 * 64, 512, nullptr, nullptr, 0, 0, 0, rot, idx, nidx);
    if (l > 0)
        transpose_job(tile, p.w_vmu + (size_t)(l - 1) * 32 * 512, 512, 32, 512, (bf16_t*)(ws + OFF_WVM) + (size_t)l * 512 * 32, 512, nullptr, nullptr, 0, 0, 0, rot, idx, nidx);
}

__device__ void prologue(char* smem, const Params& p) {
    char* ws = p.ws;
    float* tile = (float*)smem;
    { const int t0_ = otid(); if (blockIdx.x == 0 && t0_ < 64) ((int*)(ws + OFF_CTRL))[t0_] = 0; }
    {
        float* cs = (float*)(ws + OFF_COS); float* sn = (float*)(ws + OFF_SIN);
        const int gt = blockIdx.x * 256 + otid(), ng = gridDim.x * 256;
        for (int e = gt; e < NT * 16; e += ng) {
            const int t = e >> 4, i = e & 15;
            const float inv = exp2f(-(float)i * (13.287712379549449f / 16.0f));
            const float ang = (float)p.pos[t] * inv;
            cs[e] = cosf(ang); sn[e] = sinf(ang);
        }
    }
    mod_job(tile, p, (float*)(ws + OFF_MOD));
    __syncthreads();
    convert_layer(smem, p, 0, blockIdx.x, gridDim.x);
}

__device__ void norm_phase(const float* __restrict__ xin, const float* __restrict__ g, const float* __restrict__ modl, bf16_t* __restrict__ h, int tbase) {
    const int tid_ = otid(); const int lane = tid_ & 63, gw = blockIdx.x * 4 + (tid_ >> 6), nw = gridDim.x * 4;
    for (int t = tbase + gw; t < tbase + TH; t += nw) {
        const float* xr = xin + (size_t)t * 1024;
        f32x4 v[4]; float ss = 0.f;
#pragma unroll
        for (int i = 0; i < 4; ++i) { v[i] = *(const f32x4*)(xr + i * 256 + lane * 4); ss += v[i].x * v[i].x + v[i].y * v[i].y + v[i].z * v[i].z + v[i].w * v[i].w; }
        ss = wave_sum64(ss);
        const float rstd = rsqrtf(ss * (1.0f / 1024.0f) + 1e-6f);
        const float* mb = modl + (size_t)(t >> 12) * 3072;
#pragma unroll
        for (int i = 0; i < 4; ++i) {
            const int col = i * 256 + lane * 4;
            const f32x4 gg = *(const f32x4*)(g + col), sh = *(const f32x4*)(mb + col), sc = *(const f32x4*)(mb + 1024 + col);
            const f32x4 o = v[i] * rstd * gg * (sc + 1.0f) + sh;
            u32x2 w; w.x = pk_bf16(o.x, o.y); w.y = pk_bf16(o.z, o.w);
            *(u32x2*)(h + (size_t)(t - tbase) * 1024 + col) = w;
        }
    }
}

__device__ void final_norm(float* __restrict__ xio, const float* __restrict__ g) {
    const int tid_ = otid(); const int lane = tid_ & 63, gw = blockIdx.x * 4 + (tid_ >> 6), nw = gridDim.x * 4;
    for (int t = gw; t < NT; t += nw) {
        float* xr = xio + (size_t)t * 1024;
        f32x4 v[4]; float ss = 0.f;
#pragma unroll
        for (int i = 0; i < 4; ++i) { v[i] = *(const f32x4*)(xr + i * 256 + lane * 4); ss += v[i].x * v[i].x + v[i].y * v[i].y + v[i].z * v[i].z + v[i].w * v[i].w; }
        ss = wave_sum64(ss);
        const float rstd = rsqrtf(ss * (1.0f / 1024.0f) + 1e-6f);
#pragma unroll
        for (int i = 0; i < 4; ++i) {
            const int col = i * 256 + lane * 4;
            const f32x4 gg = *(const f32x4*)(g + col);
            *(f32x4*)(xr + col) = v[i] * rstd * gg;
        }
    }
}

template <class Epi>
__device__ __forceinline__ void gemm_tile(char* smem, const bf16_t* __restrict__ A, int lda, const bf16_t* __restrict__ Bt, int ldb, int K, int row0, int col0, const Epi& epi) {
    const int tid = otid(), lane = tid & 63, wid = tid >> 6, wr = wid >> 1, wc = wid & 1, fr = lane & 15, fq = lane >> 4;
    f32x4 acc[4][4];
#pragma unroll
    for (int i = 0; i < 4; ++i)
#pragma unroll
        for (int j = 0; j < 4; ++j) acc[i][j] = (f32x4){0.f, 0.f, 0.f, 0.f};
    const int lrow = lane >> 3, lp = lane & 7;
    const int srow0 = wid * 32 + lrow;
    const bf16_t* gA = A + (size_t)(row0 + srow0) * lda;
    const bf16_t* gB = Bt + (size_t)(col0 + srow0) * ldb;
    int gc[4];
#pragma unroll
    for (int i = 0; i < 4; ++i) gc[i] = (lp ^ (((srow0 + 8 * i) >> 1) & 7)) * 8;
    LAS char* lbase = (LAS char*)smem + wid * 4096;
#define GEMM_STAGE(buf, kofs) do { _Pragma("unroll") for (int i = 0; i < 4; ++i) { \
        __builtin_amdgcn_global_load_lds((const unsigned*)(gA + (size_t)(8 * i) * lda + (kofs) + gc[i]), (LAS unsigned*)(lbase + (buf) * 32768 + i * 1024), 16, 0, 0); \
        __builtin_amdgcn_global_load_lds((const unsigned*)(gB + (size_t)(8 * i) * ldb + (kofs) + gc[i]), (LAS unsigned*)(lbase + (buf) * 32768 + 16384 + i * 1024), 16, 0, 0); } } while (0)
    GEMM_STAGE(0, 0);
    __syncthreads();
    const int nk = K >> 6;
    const int fsw = (fr >> 1) & 7;
    const int aoff = (wr * 64 + fr) * 128, boff = 16384 + (wc * 64 + fr) * 128;
#define GEMM_STEP(CB, NB_) do { \
        const char* cur = smem + (CB) * 32768; \
        bf16x8 af[2][4], bfr[2][4]; \
        _Pragma("unroll") for (int kk = 0; kk < 2; ++kk) { \
            const int csw = (((kk * 4 + fq) ^ fsw) << 4); \
            _Pragma("unroll") for (int i = 0; i < 4; ++i) { af[kk][i] = *(const bf16x8*)(cur + aoff + i * 2048 + csw); bfr[kk][i] = *(const bf16x8*)(cur + boff + i * 2048 + csw); } \
        } \
        __builtin_amdgcn_sched_barrier(0); \
        if (ks + 1 < nk) GEMM_STAGE(NB_, (ks + 1) * 64); \
        __builtin_amdgcn_sched_barrier(0); \
        _Pragma("unroll") for (int kk = 0; kk < 2; ++kk) \
            _Pragma("unroll") for (int mi = 0; mi < 4; ++mi) \
                _Pragma("unroll") for (int ni = 0; ni < 4; ++ni) acc[mi][ni] = __builtin_amdgcn_mfma_f32_16x16x32_bf16(bfr[kk][ni], af[kk][mi], acc[mi][ni], 0, 0, 0); \
        __builtin_amdgcn_sched_barrier(0); \
        __syncthreads(); \
        ++ks; } while (0)
#pragma unroll 1
    for (int ks = 0; ks < nk;) {
        GEMM_STEP(0, 1);
        GEMM_STEP(1, 0);
    }
#undef GEMM_STEP
#undef GEMM_STAGE
    epi(acc, row0 + wr * 64, col0 + wc * 64, fr, fq);
}

struct EpiProj {
    bf16_t* proj; float* rsq; float* rskv; char* smem;
    __device__ __forceinline__ void operator()(const f32x4 (&acc)[4][4], int rbase, int cbase, int fr, int fq) const {
        const bool isq = cbase >= O_CQ && cbase < O_CKV, iskv = cbase >= O_CKV && cbase < O_KR;
        const int row0 = rbase & ~127, col0 = cbase & ~127, wr = (rbase >> 6) & 1, wc = (cbase >> 6) & 1;
        const int tid = (wr * 2 + wc) * 64 + fq * 16 + fr;
#pragma unroll
        for (int mi = 0; mi < 4; ++mi) {
            const int tl = rbase + mi * 16 + fr; float ss = 0.f;
#pragma unroll
            for (int ni = 0; ni < 4; ++ni) {
                u32x2 w; w.x = pk_bf16(acc[mi][ni][0], acc[mi][ni][1]); w.y = pk_bf16(acc[mi][ni][2], acc[mi][ni][3]);
                *(u32x2*)(smem + (wr * 64 + mi * 16 + fr) * 272 + (wc * 64 + ni * 16 + fq * 4) * 2) = w;
                const float a = bf_lo(w.x), b = bf_hi(w.x), c = bf_lo(w.y), d = bf_hi(w.y);
                ss += a * a + b * b + c * c + d * d;
            }
            if (isq || iskv) {
                ss += __shfl_xor(ss, 16); ss += __shfl_xor(ss, 32);
                if (fq == 0) { if (isq) rsq[(size_t)tl * 8 + ((cbase - O_CQ) >> 6)] = ss; else rskv[(size_t)tl * 4 + ((cbase - O_CKV) >> 6)] = ss; }
            }
        }
        __syncthreads();
#pragma unroll
        for (int i = 0; i < 8; ++i) {
            const int q = tid + 256 * i, r = q >> 4, c = q & 15;
            *(u32x4*)(proj + (size_t)(row0 + r) * NP + col0 + c * 8) = *(const u32x4*)(smem + r * 272 + c * 16);
        }
        __syncthreads();
    }
};
struct EpiQ {
    bf16_t* Q; const float* rsq; const float* cs; const float* sn; int tgbase; char* smem;
    __device__ __forceinline__ void operator()(const f32x4 (&acc)[4][4], int rbase, int cbase, int fr, int fq) const {
        const int g0 = cbase >> 4;
        char* stg = smem + ((((rbase >> 6) & 1) * 2 + ((cbase >> 6) & 1)) * 9216);
#pragma unroll
        for (int mi = 0; mi < 4; ++mi) {
            const int tl = rbase + mi * 16 + fr;
            const f32x4 s0 = *(const f32x4*)(rsq + (size_t)tl * 8); const f32x2 s1 = *(const f32x2*)(rsq + (size_t)tl * 8 + 4);
            const float rs = rsqrtf((s0.x + s0.y + s0.z + s0.w + s1.x + s1.y) * (1.0f / 384.0f) + 1e-6f) * QSCALE;
            const f32x4 cc = *(const f32x4*)(cs + (size_t)(tgbase + tl) * 16 + fq * 4), sv = *(const f32x4*)(sn + (size_t)(tgbase + tl) * 16 + fq * 4);
            f32x4 v[4];
#pragma unroll
            for (int ni = 0; ni < 4; ++ni) v[ni] = acc[mi][ni] * rs;
#pragma unroll
            for (int ni = 0; ni < 4; ni += 2)
                if ((g0 + ni) % 6 == 4) { const f32x4 x1 = v[ni], x2 = v[ni + 1]; v[ni] = x1 * cc - x2 * sv; v[ni + 1] = x2 * cc + x1 * sv; }
#pragma unroll
            for (int ni = 0; ni < 4; ++ni) {
                u32x2 w; w.x = pk_bf16(v[ni][0], v[ni][1]); w.y = pk_bf16(v[ni][2], v[ni][3]);
                *(u32x2*)(stg + (mi * 16 + fr) * 144 + (ni * 16 + fq * 4) * 2) = w;
            }
        }
        {
            const int lane = fq * 16 + fr;
#pragma unroll
            for (int i = 0; i < 8; ++i) {
                const int q = lane + 64 * i, tk = q >> 3, c = q & 7;
                *(u32x4*)(Q + (size_t)(rbase + tk) * 768 + cbase + c * 8) = *(const u32x4*)(stg + tk * 144 + c * 16);
            }
        }
        __syncthreads();
    }
};
struct EpiKV {
    bf16_t* Kh; bf16_t* Vt; const float* rskv; char* smem;
    __device__ __forceinline__ void operator()(const f32x4 (&acc)[4][4], int rbase, int cbase, int fr, int fq) const {
        const int hh = cbase >> 7, part = (cbase >> 6) & 1, lane = fq * 16 + fr;
        char* stg = smem + ((((rbase >> 6) & 1) * 2 + part) * 9216);
#pragma unroll
        for (int mi = 0; mi < 4; ++mi) {
            const int tl = rbase + mi * 16 + fr;
            const f32x4 s0 = *(const f32x4*)(rskv + (size_t)tl * 4);
            const float rs = rsqrtf((s0.x + s0.y + s0.z + s0.w) * (1.0f / 256.0f) + 1e-6f);
#pragma unroll
            for (int ni = 0; ni < 4; ++ni) {
                const unsigned w0 = pk_bf16(acc[mi][ni][0] * rs, acc[mi][ni][1] * rs), w1 = pk_bf16(acc[mi][ni][2] * rs, acc[mi][ni][3] * rs);
                if (part == 0) { u32x2 w; w.x = w0; w.y = w1; *(u32x2*)(stg + (mi * 16 + fr) * 144 + (ni * 16 + fq * 4) * 2) = w; }
                else {
                    bf16_t* sp = (bf16_t*)(stg + (ni * 16 + fq * 4) * 144) + mi * 16 + fr;
                    sp[0] = (bf16_t)(w0 & 0xffffu); sp[72] = (bf16_t)(w0 >> 16); sp[144] = (bf16_t)(w1 & 0xffffu); sp[216] = (bf16_t)(w1 >> 16);
                }
            }
        }
        if (part == 0) {
#pragma unroll
            for (int i = 0; i < 8; ++i) {
                const int q = lane + 64 * i, tk = q >> 3, c = q & 7;
                *(u32x4*)(Kh + (size_t)(rbase + tk) * 768 + hh * 96 + c * 8) = *(const u32x4*)(stg + tk * 144 + c * 16);
            }
        } else {
            const int bl = rbase >> 12, s0 = rbase & 4095;
            bf16_t* vb = Vt + ((size_t)(bl * 8 + hh) * 64) * 4096 + s0;
#pragma unroll
            for (int i = 0; i < 8; ++i) {
                const int q = lane + 64 * i, dv = q >> 3, c = q & 7;
                *(u32x4*)(vb + (size_t)dv * 4096 + c * 8) = *(const u32x4*)(stg + dv * 144 + c * 16);
            }
        }
        __syncthreads();
    }
};
struct EpiOut {
    const float* xold; float* xnew; const float* modl; int tgbase; float fac;
    __device__ __forceinline__ void operator()(const f32x4 (&acc)[4][4], int rbase, int cbase, int fr, int fq) const {
#pragma unroll
        for (int mi = 0; mi < 4; ++mi) {
            const int tg = tgbase + rbase + mi * 16 + fr; const float* gp = modl + (size_t)(tg >> 12) * 3072 + 2048;
#pragma unroll
            for (int ni = 0; ni < 4; ++ni) {
                const int col = cbase + ni * 16 + fq * 4;
                const f32x4 xo = *(const f32x4*)(xold + (size_t)tg * 1024 + col), gt = *(const f32x4*)(gp + col);
                *(f32x4*)(xnew + (size_t)tg * 1024 + col) = xo + gt * acc[mi][ni] * fac;
            }
        }
    }
};

struct PrepArgs {
    const bf16_t* proj; const float* mu; const float* muv; const bf16_t* wdec; const bf16_t* wicl; const bf16_t* wvm;
    const float *w0, *a0, *v0, *k_k, *k_a; const float *cs, *sn;
    bf16_t *sr, *sk, *sv, *skk, *skka; bf16_t* se; bf16_t* vfirst; bf16_t* Kh; int layer; int tgbase;
};
__device__ __forceinline__ void lerp8(const bf16_t* cur, const bf16_t* prv, bool hp, const float* mu, float (&o)[8]) {
    const u32x4 c = *(const u32x4*)cur; u32x4 q = (u32x4){0u, 0u, 0u, 0u}; if (hp) q = *(const u32x4*)prv;
    const f32x4 m0 = *(const f32x4*)mu, m1 = *(const f32x4*)(mu + 4);
    const float cv[8] = {bf_lo(c.x), bf_hi(c.x), bf_lo(c.y), bf_hi(c.y), bf_lo(c.z), bf_hi(c.z), bf_lo(c.w), bf_hi(c.w)};
    const float pv[8] = {bf_lo(q.x), bf_hi(q.x), bf_lo(q.y), bf_hi(q.y), bf_lo(q.z), bf_hi(q.z), bf_lo(q.w), bf_hi(q.w)};
    const float mv[8] = {m0.x, m0.y, m0.z, m0.w, m1.x, m1.y, m1.z, m1.w};
#pragma unroll
    for (int j = 0; j < 8; ++j) o[j] = cv[j] + (pv[j] - cv[j]) * mv[j];
}
__device__ __forceinline__ f32x4 lerp4(const bf16_t* cur, const bf16_t* prv, bool hp, const float* mu) {
    const u32x2 c = *(const u32x2*)cur; u32x2 q = (u32x2){0u, 0u}; if (hp) q = *(const u32x2*)prv;
    const f32x4 m = *(const f32x4*)mu;
    const f32x4 cv = (f32x4){bf_lo(c.x), bf_hi(c.x), bf_lo(c.y), bf_hi(c.y)}, pv = (f32x4){bf_lo(q.x), bf_hi(q.x), bf_lo(q.y), bf_hi(q.y)};
    return cv + (pv - cv) * m;
}
__device__ __forceinline__ bf16x8 pack8(const float (&v)[8]) {
    u32x4 w; w.x = pk_bf16(v[0], v[1]); w.y = pk_bf16(v[2], v[3]); w.z = pk_bf16(v[4], v[5]); w.w = pk_bf16(v[6], v[7]);
    return __builtin_bit_cast(bf16x8, w);
}
__device__ __forceinline__ void store4(bf16_t* dst, const f32x4 v) { u32x2 w; w.x = pk_bf16(v.x, v.y); w.y = pk_bf16(v.z, v.w); *(u32x2*)dst = w; }

__device__ __forceinline__ void prep_tile(char* smem, const PrepArgs& a, int tile, int hg) {
    const int tid = otid(), lane = tid & 63, wid = tid >> 6, fr = lane & 15, fq = lane >> 4;
    const int tl = tile * 64 + wid * 16 + fr, tg = a.tgbase + tl;
    char* stg = smem + wid * 15872;
    const int tlw = tile * 64 + wid * 16;
    const bool hp = (tg & 4095) != 0;
    const bf16_t* pr = a.proj + (size_t)tl * NP; const bf16_t* pp = pr - NP;
    if (hg == 0) {
        const u32x2 u1 = *(const u32x2*)(pr + O_KR + fq * 4), u2 = *(const u32x2*)(pr + O_KR + 16 + fq * 4);
        const f32x4 x1 = (f32x4){bf_lo(u1.x), bf_hi(u1.x), bf_lo(u1.y), bf_hi(u1.y)}, x2 = (f32x4){bf_lo(u2.x), bf_hi(u2.x), bf_lo(u2.y), bf_hi(u2.y)};
        const f32x4 cc = *(const f32x4*)(a.cs + (size_t)tg * 16 + fq * 4), sv = *(const f32x4*)(a.sn + (size_t)tg * 16 + fq * 4);
        const f32x4 o1 = x1 * cc - x2 * sv, o2 = x2 * cc + x1 * sv;
        u32x2 w1, w2; w1.x = pk_bf16(o1.x, o1.y); w1.y = pk_bf16(o1.z, o1.w); w2.x = pk_bf16(o2.x, o2.y); w2.y = pk_bf16(o2.z, o2.w);
#pragma unroll
        for (int hh = 0; hh < 8; ++hh) { *(u32x2*)(a.Kh + (size_t)tl * 768 + hh * 96 + 64 + fq * 4) = w1; *(u32x2*)(a.Kh + (size_t)tl * 768 + hh * 96 + 80 + fq * 4) = w2; }
    }
    bf16x8 bw[2], ba[2], bv;
#pragma unroll
    for (int ks = 0; ks < 2; ++ks) {
        float t[8];
        lerp8(pr + 1536 + ks * 32 + fq * 8, pp + 1536 + ks * 32 + fq * 8, hp, a.mu + 1536 + ks * 32 + fq * 8, t);
#pragma unroll
        for (int j = 0; j < 8; ++j) t[j] = tanhf_(t[j]);
        bw[ks] = pack8(t);
        lerp8(pr + 1600 + ks * 32 + fq * 8, pp + 1600 + ks * 32 + fq * 8, hp, a.mu + 1600 + ks * 32 + fq * 8, t);
        ba[ks] = pack8(t);
    }
    const bool hasv = a.layer > 0;
    if (hasv) { float t[8]; lerp8(pr + INW + fq * 8, pp + INW + fq * 8, hp, a.muv + fq * 8, t); bv = pack8(t); }
    else bv = (bf16x8){0, 0, 0, 0, 0, 0, 0, 0};
#pragma unroll 1
    for (int hh = hg * 4; hh < hg * 4 + 4; ++hh) {
        float ss = 0.f;
#pragma unroll
        for (int nt = 0; nt < 4; ++nt) {
            const int ch = hh * 64 + nt * 16 + fq * 4;
            const f32x4 k4 = lerp4(pr + 512 + ch, pp + 512 + ch, hp, a.mu + 512 + ch);
            const f32x4 kr = k4 * *(const f32x4*)(a.k_k + ch);
            ss += kr.x * kr.x + kr.y * kr.y + kr.z * kr.z + kr.w * kr.w;
        }
        ss += __shfl_xor(ss, 16); ss += __shfl_xor(ss, 32);
        const float inv = 1.0f / fmaxf(sqrtf(ss), 1e-12f);
#pragma unroll
        for (int nt = 0; nt < 4; ++nt) {
            const int cb = hh * 64 + nt * 16, ch = cb + fq * 4;
            f32x4 accw = (f32x4){0.f, 0.f, 0.f, 0.f}, acca = accw, accv = accw;
#pragma unroll
            for (int ks = 0; ks < 2; ++ks) {
                const bf16x8 aw = *(const bf16x8*)(a.wdec + (size_t)(cb + fr) * 64 + ks * 32 + fq * 8);
                const bf16x8 ai = *(const bf16x8*)(a.wicl + (size_t)(cb + fr) * 64 + ks * 32 + fq * 8);
                accw = __builtin_amdgcn_mfma_f32_16x16x32_bf16(aw, bw[ks], accw, 0, 0, 0);
                acca = __builtin_amdgcn_mfma_f32_16x16x32_bf16(ai, ba[ks], acca, 0, 0, 0);
            }
            if (hasv) {
                const bf16x8 avm = *(const bf16x8*)(a.wvm + (size_t)(cb + fr) * 32 + fq * 8);
                accv = __builtin_amdgcn_mfma_f32_16x16x32_bf16(avm, bv, accv, 0, 0, 0);
            }
            const f32x4 r4 = lerp4(pr + ch, pp + ch, hp, a.mu + ch);
            const f32x4 k4 = lerp4(pr + 512 + ch, pp + 512 + ch, hp, a.mu + 512 + ch);
            f32x4 v4 = lerp4(pr + 1024 + ch, pp + 1024 + ch, hp, a.mu + 1024 + ch);
            const f32x4 w0v = *(const f32x4*)(a.w0 + ch), a0v = *(const f32x4*)(a.a0 + ch), kkv = *(const f32x4*)(a.k_k + ch), kav = *(const f32x4*)(a.k_a + ch);
            f32x4 dec, aa;
#pragma unroll
            for (int j = 0; j < 4; ++j) {
                dec[j] = 0.6065306597126334f * sigmoidf_(w0v[j] + accw[j]);
                aa[j] = sigmoidf_(a0v[j] + acca[j]);
            }
            if (hasv) {
                const f32x4 v0v = *(const f32x4*)(a.v0 + ch);
                const u32x2 uf = *(const u32x2*)(a.vfirst + (size_t)tg * 512 + ch);
                const f32x4 vf = (f32x4){bf_lo(uf.x), bf_hi(uf.x), bf_lo(uf.y), bf_hi(uf.y)};
#pragma unroll
                for (int j = 0; j < 4; ++j) v4[j] = v4[j] + (vf[j] - v4[j]) * sigmoidf_(v0v[j] + accv[j]);
            } else {
                store4(a.vfirst + (size_t)tg * 512 + ch, v4);
            }
            const f32x4 kk = k4 * kkv * inv;
            const f32x4 kp = k4 * ((aa - 1.0f) * kav + 1.0f);
            {
                const int so = fr * 144 + nt * 32 + fq * 8;
                store4((bf16_t*)(stg + so), r4); store4((bf16_t*)(stg + 2304 + so), kp); store4((bf16_t*)(stg + 4608 + so), v4);
                store4((bf16_t*)(stg + 6912 + so), kk); store4((bf16_t*)(stg + 9216 + so), kk * aa);
                store4((bf16_t*)(stg + 11520 + so), dec);
            }
        }
        {
#pragma unroll
            for (int i = 0; i < 2; ++i) {
                const int q = lane + 64 * i, tk = q >> 3, c = q & 7;
                const size_t go = (size_t)(tlw + tk) * 512 + hh * 64 + c * 8; const int lo = tk * 144 + c * 16;
                *(u32x4*)(a.sr + go) = *(const u32x4*)(stg + lo); *(u32x4*)(a.sk + go) = *(const u32x4*)(stg + 2304 + lo); *(u32x4*)(a.sv + go) = *(const u32x4*)(stg + 4608 + lo);
                *(u32x4*)(a.skk + go) = *(const u32x4*)(stg + 6912 + lo); *(u32x4*)(a.skka + go) = *(const u32x4*)(stg + 9216 + lo);
                *(u32x4*)(a.se + go) = *(const u32x4*)(stg + 11520 + lo);
            }
        }
    }
    __syncthreads();
}

struct ScanArgs { const bf16_t *sr, *sk, *sv, *skk, *skka; const float* sw; float* yraw; float* zbuf; float* sfin; };
__device__ __forceinline__ void cvt_store8(float* dst, const u32x4 u) {
    *(f32x4*)dst = (f32x4){bf_lo(u.x), bf_hi(u.x), bf_lo(u.y), bf_hi(u.y)};
    *(f32x4*)(dst + 4) = (f32x4){bf_lo(u.z), bf_hi(u.z), bf_lo(u.w), bf_hi(u.w)};
}
__device__ __forceinline__ void scan_tile(char* smem, const ScanArgs& a, int mode, int bl, int hh, int g) {
    const int tid = otid(), lane = tid & 63, wid = tid >> 6, rl = lane >> 4, c = lane & 15;
    float* L = (float*)smem;
    float* ybuf = L + 2 * 5376;
    const size_t tokbase = (size_t)bl * 4096 + (mode ? 2048 : 0);
    const int colh = hh * 64, i0 = g * 16;
    const bf16_t* src0 = (tid < 128) ? a.skk : a.skka;
    const bf16_t* src1 = (tid < 128) ? a.sk : a.sr;
    const int rem = tid & 127, tokA = rem >> 3, chA = rem & 7;
    const size_t gofsA = (size_t)tokA * 512 + colh + chA * 8;
    const int ldsA0 = (1 + (tid >> 7)) * 1024 + tokA * 64 + chA * 8, ldsA1 = (3 + (tid >> 7)) * 1024 + tokA * 64 + chA * 8;
    const size_t gofsW = (size_t)(tid >> 4) * 512 + colh + (tid & 15) * 4;
    const int ldsW = (tid >> 4) * 64 + (tid & 15) * 4;
    const size_t gofsV = (size_t)((tid & 31) >> 1) * 512 + colh + i0 + (tid & 1) * 8;
    const int ldsV = 5120 + ((tid & 31) >> 1) * 16 + (tid & 1) * 8;
    const bool ldv = tid < 32 && mode != 2;
    f32x2 S01 = (f32x2){0.f, 0.f}, S23 = (f32x2){0.f, 0.f};
    if (mode == 2) { const int d = (i0 + wid * 4 + rl) - c * 4; S01.x = d == 0 ? 1.f : 0.f; S01.y = d == 1 ? 1.f : 0.f; S23.x = d == 2 ? 1.f : 0.f; S23.y = d == 3 ? 1.f : 0.f; }
    u32x4 qa, qb, qv = (u32x4){0u, 0u, 0u, 0u}; f32x4 qw;
    {
        const size_t tb = tokbase * 512;
        qa = *(const u32x4*)(src0 + tb + gofsA); qb = *(const u32x4*)(src1 + tb + gofsA); qw = *(const f32x4*)(a.sw + tb + gofsW);
        if (ldv) qv = *(const u32x4*)(a.sv + tb + gofsV);
        cvt_store8(L + ldsA0, qa); cvt_store8(L + ldsA1, qb); *(f32x4*)(L + ldsW) = qw; if (tid < 32) { cvt_store8(L + ldsV, qv); if (mode == 2) cvt_store8(L + 5376 + ldsV, qv); }
    }
    __syncthreads();
    const int vofs = 5120 + wid * 4 + rl;
#pragma unroll 1
    for (int ch = 0; ch < 128; ++ch) {
        const float* cur = L + (ch & 1) * 5376;
        if (ch + 1 < 128) {
            const size_t tb = (tokbase + (size_t)(ch + 1) * 16) * 512;
            qa = *(const u32x4*)(src0 + tb + gofsA); qb = *(const u32x4*)(src1 + tb + gofsA); qw = *(const f32x4*)(a.sw + tb + gofsW);
            if (ldv) qv = *(const u32x4*)(a.sv + tb + gofsV);
        }
        float* yb = ybuf + (ch & 1) * 256;
        float ykeep = 0.f;
        f32x4 w4 = *(const f32x4*)(cur + c * 4), kk4 = *(const f32x4*)(cur + 1024 + c * 4), ka4 = *(const f32x4*)(cur + 2048 + c * 4);
        f32x4 k4 = *(const f32x4*)(cur + 3072 + c * 4), r4 = *(const f32x4*)(cur + 4096 + c * 4);
        float v = cur[vofs];
        float prevq = 0.f;
#pragma unroll
        for (int s = 0; s < 16; ++s) {
            f32x4 nw4 = w4, nkk4 = kk4, nka4 = ka4, nk4 = k4, nr4 = r4; float nv = v;
            if (s + 1 < 16) {
                nw4 = *(const f32x4*)(cur + (s + 1) * 64 + c * 4); nkk4 = *(const f32x4*)(cur + 1024 + (s + 1) * 64 + c * 4); nka4 = *(const f32x4*)(cur + 2048 + (s + 1) * 64 + c * 4);
                nk4 = *(const f32x4*)(cur + 3072 + (s + 1) * 64 + c * 4); nr4 = *(const f32x4*)(cur + 4096 + (s + 1) * 64 + c * 4);
                nv = cur[vofs + (s + 1) * 16];
            }
            const f32x2 pp = S01 * kk4.xy + S23 * kk4.zw;
            float sa = pp.x + pp.y;
            if (s > 0) { float yq = prevq; dpp_sum16x2(sa, yq); ykeep = (c == s - 1) ? yq : ykeep; }
            else sa = dpp_sum16(sa);
            const f32x2 sa2 = (f32x2){sa, sa}, v2 = (f32x2){v, v};
            S01 = S01 * w4.xy + (v2 * k4.xy - sa2 * ka4.xy);
            S23 = S23 * w4.zw + (v2 * k4.zw - sa2 * ka4.zw);
            const f32x2 qq = S01 * r4.xy + S23 * r4.zw;
            prevq = qq.x + qq.y;
            __builtin_amdgcn_sched_barrier(0);
            w4 = nw4; kk4 = nkk4; ka4 = nka4; k4 = nk4; r4 = nr4; v = nv;
        }
        { const float yq = dpp_sum16(prevq); ykeep = (c == 15) ? yq : ykeep; }
        yb[c * 16 + wid * 4 + rl] = ykeep;
        if (ch + 1 < 128) {
            float* nx = L + ((ch + 1) & 1) * 5376;
            cvt_store8(nx + ldsA0, qa); cvt_store8(nx + ldsA1, qb); *(f32x4*)(nx + ldsW) = qw; if (ldv) cvt_store8(nx + ldsV, qv);
        }
        __syncthreads();
        if (mode != 2) a.yraw[(tokbase + (size_t)ch * 16 + (tid >> 4)) * 512 + colh + i0 + (tid & 15)] = yb[tid];
        else a.zbuf[((size_t)bl * 2048 + (size_t)ch * 16 + (tid >> 4)) * 512 + colh + i0 + (tid & 15)] = yb[tid];
    }
    if (mode == 0) *(f32x4*)(a.sfin + ((size_t)((bl * 8 + hh) * 64 + i0 + wid * 4 + rl)) * 64 + c * 4) = (f32x4){S01.x, S01.y, S23.x, S23.y};
}

__device__ __forceinline__ void attn_tile(char* smem, const bf16_t* __restrict__ Qh, const bf16_t* __restrict__ Kh, const bf16_t* __restrict__ Vt,
                                          const bf16_t* __restrict__ proj, bf16_t* __restrict__ ycat, int bl, int hh, int qt) {
    const int tid = otid(), lane = tid & 63, wid = tid >> 6, fr = lane & 15, fq = lane >> 4;
    const int q0 = qt * 128, tok0 = bl * 4096, qw0 = q0 + wid * 32;
    bf16x8 qf[2][3];
#pragma unroll
    for (int qi = 0; qi < 2; ++qi)
#pragma unroll
        for (int ks = 0; ks < 3; ++ks) qf[qi][ks] = *(const bf16x8*)(Qh + (size_t)(tok0 + qw0 + qi * 16 + fr) * 768 + hh * 96 + ks * 32 + fq * 8);
    f32x4 o[4][2];
#pragma unroll
    for (int i = 0; i < 4; ++i) { o[i][0] = (f32x4){0.f, 0.f, 0.f, 0.f}; o[i][1] = o[i][0]; }
    float m[2] = {-1e30f, -1e30f}, lsum[2] = {0.f, 0.f};
    const int nkv = 2 * (qt + 1);
    const bf16_t* Kb = Kh + (size_t)tok0 * 768 + hh * 96;
    const bf16_t* Vb = Vt + ((size_t)((bl * 8 + hh) * 64)) * 4096;
    int gK[3], lK[3];
#pragma unroll
    for (int i = 0; i < 3; ++i) { const int cid = tid + 256 * i, key = cid / 12, cc = cid - key * 12; gK[i] = key * 768 + cc * 8; lK[i] = key * 224 + cc * 16; }
    int gV[2], lV[2];
#pragma unroll
    for (int i = 0; i < 2; ++i) { const int cid = tid + 256 * i, dv = cid >> 3, cc = cid & 7; gV[i] = dv * 4096 + cc * 8; lV[i] = 14336 + dv * 144 + cc * 16; }
    u32x4 rkA[3], rvA[2], rkB[3], rvB[2];
#define ATT_LOAD(RK, RV, T) do { _Pragma("unroll") for (int i = 0; i < 3; ++i) RK[i] = *(const u32x4*)(Kb + (size_t)((T) * 64) * 768 + gK[i]); \
                                 _Pragma("unroll") for (int i = 0; i < 2; ++i) RV[i] = *(const u32x4*)(Vb + (T) * 64 + gV[i]); } while (0)
#define ATT_WRITE(RK, RV, BUF) do { _Pragma("unroll") for (int i = 0; i < 3; ++i) *(u32x4*)(smem + (BUF) * 23552 + lK[i]) = RK[i]; \
                                    _Pragma("unroll") for (int i = 0; i < 2; ++i) *(u32x4*)(smem + (BUF) * 23552 + lV[i]) = RV[i]; } while (0)
    ATT_LOAD(rkA, rvA, 0);
    ATT_WRITE(rkA, rvA, 0);
    ATT_LOAD(rkA, rvA, 1);
    __syncthreads();
    auto compute = [&](const int j, const char* cur) {
        const int kv0 = j * 64;
        if (kv0 <= qw0 + 31) {
            f32x4 s[4][2];
            {
                bf16x8 kf[4][3];
#pragma unroll
                for (int kt = 0; kt < 4; ++kt)
#pragma unroll
                    for (int ks = 0; ks < 3; ++ks) kf[kt][ks] = *(const bf16x8*)(cur + (kt * 16 + fr) * 224 + (ks * 4 + fq) * 16);
                __builtin_amdgcn_sched_barrier(0);
#pragma unroll
                for (int kt = 0; kt < 4; ++kt)
#pragma unroll
                    for (int qi = 0; qi < 2; ++qi) {
                        f32x4 acc = (f32x4){0.f, 0.f, 0.f, 0.f};
#pragma unroll
                        for (int ks = 0; ks < 3; ++ks) acc = __builtin_amdgcn_mfma_f32_16x16x32_bf16(kf[kt][ks], qf[qi][ks], acc, 0, 0, 0);
                        s[kt][qi] = acc;
                    }
                __builtin_amdgcn_sched_barrier(0);
            }
            bf16x8 vfr[4][2];
#pragma unroll
            for (int dvt = 0; dvt < 4; ++dvt)
#pragma unroll
                for (int kb = 0; kb < 2; ++kb) {
                    const char* vp = cur + 14336 + (dvt * 16 + fr) * 144 + kb * 64 + fq * 8;
                    const u32x2 lo = *(const u32x2*)vp, hi = *(const u32x2*)(vp + 32);
                    vfr[dvt][kb] = __builtin_bit_cast(bf16x8, ((u32x4){lo.x, lo.y, hi.x, hi.y}));
                }
            __builtin_amdgcn_sched_barrier(0);
            if (kv0 + 63 > qw0) {
#pragma unroll
                for (int kt = 0; kt < 4; ++kt)
#pragma unroll
                    for (int qi = 0; qi < 2; ++qi)
#pragma unroll
                        for (int jj = 0; jj < 4; ++jj) { const int kpos = kv0 + kt * 16 + fq * 4 + jj, qpos = qw0 + qi * 16 + fr; if (kpos > qpos) s[kt][qi][jj] = -1e30f; }
            }
#pragma unroll
            for (int qi = 0; qi < 2; ++qi) {
                float mx = -1e30f;
#pragma unroll
                for (int kt = 0; kt < 4; ++kt) mx = fmaxf(mx, fmaxf(fmaxf(s[kt][qi][0], s[kt][qi][1]), fmaxf(s[kt][qi][2], s[kt][qi][3])));
                mx = fmaxf(mx, __shfl_xor(mx, 16)); mx = fmaxf(mx, __shfl_xor(mx, 32));
                const float mnew = fmaxf(m[qi], mx), alpha = __builtin_amdgcn_exp2f(m[qi] - mnew);
                m[qi] = mnew;
                float rs = 0.f;
#pragma unroll
                for (int kt = 0; kt < 4; ++kt)
#pragma unroll
                    for (int jj = 0; jj < 4; ++jj) { const float pexp = __builtin_amdgcn_exp2f(s[kt][qi][jj] - mnew); s[kt][qi][jj] = pexp; rs += pexp; }
                lsum[qi] = lsum[qi] * alpha + rs;
#pragma unroll
                for (int dvt = 0; dvt < 4; ++dvt) o[dvt][qi] = o[dvt][qi] * alpha;
            }
            bf16x8 pf[2][2];
#pragma unroll
            for (int kb = 0; kb < 2; ++kb)
#pragma unroll
                for (int qi = 0; qi < 2; ++qi) {
                    u32x4 t;
                    t.x = pk_bf16(s[2 * kb][qi][0], s[2 * kb][qi][1]); t.y = pk_bf16(s[2 * kb][qi][2], s[2 * kb][qi][3]);
                    t.z = pk_bf16(s[2 * kb + 1][qi][0], s[2 * kb + 1][qi][1]); t.w = pk_bf16(s[2 * kb + 1][qi][2], s[2 * kb + 1][qi][3]);
                    pf[kb][qi] = __builtin_bit_cast(bf16x8, t);
                }
            __builtin_amdgcn_sched_barrier(0);
#pragma unroll
            for (int dvt = 0; dvt < 4; ++dvt)
#pragma unroll
                for (int kb = 0; kb < 2; ++kb)
#pragma unroll
                    for (int qi = 0; qi < 2; ++qi) o[dvt][qi] = __builtin_amdgcn_mfma_f32_16x16x32_bf16(vfr[dvt][kb], pf[kb][qi], o[dvt][qi], 0, 0, 0);
        }
    };
#pragma unroll 1
    for (int j = 0; j < nkv; j += 2) {
        if (j + 2 < nkv) ATT_LOAD(rkB, rvB, j + 2);
        compute(j, smem);
        ATT_WRITE(rkA, rvA, 1);
        __syncthreads();
        if (j + 3 < nkv) ATT_LOAD(rkA, rvA, j + 3);
        compute(j + 1, smem + 23552);
        if (j + 2 < nkv) ATT_WRITE(rkB, rvB, 0);
        __syncthreads();
    }
#undef ATT_LOAD
#undef ATT_WRITE
#pragma unroll
    for (int qi = 0; qi < 2; ++qi) {
        float lt = lsum[qi]; lt += __shfl_xor(lt, 16); lt += __shfl_xor(lt, 32);
        const float inv = 1.0f / lt;
        const int tl = tok0 + qw0 + qi * 16 + fr;
#pragma unroll
        for (int dvt = 0; dvt < 4; ++dvt) {
            const int dv = dvt * 16 + fq * 4;
            const u32x2 gu = *(const u32x2*)(proj + (size_t)tl * NP + O_GM + hh * 64 + dv);
            const f32x4 gg = (f32x4){bf_lo(gu.x), bf_hi(gu.x), bf_lo(gu.y), bf_hi(gu.y)};
            f32x4 r;
#pragma unroll
            for (int jj = 0; jj < 4; ++jj) r[jj] = o[dvt][qi][jj] * inv * siluf_(gg[jj]);
            store4(ycat + (size_t)tl * 1024 + 512 + hh * 64 + dv, r);
        }
    }
}

struct FinArgs { const float* yraw; const bf16_t *sr, *sk, *sv; const bf16_t* proj; const float *lnw, *lnb, *rk; bf16_t* ycat; const float* zbuf; const float* sfin; };
__device__ void rwkv_finalize(const FinArgs& a) {
    const int tid_ = otid(); const int lane = tid_ & 63, gw = blockIdx.x * 4 + (tid_ >> 6), nw = gridDim.x * 4;
    for (int u = gw; u < TH * 2; u += nw) {
        const int tl = u >> 1, ch = ((u & 1) * 4 + (lane >> 4)) * 64 + (lane & 15) * 4;
        f32x4 y = *(const f32x4*)(a.yraw + (size_t)tl * 512 + ch);
        const float mean = dpp_sum16(y.x + y.y + y.z + y.w) * (1.0f / 64.0f);
        const f32x4 d = y - mean;
        const float var = dpp_sum16(d.x * d.x + d.y * d.y + d.z * d.z + d.w * d.w) * (1.0f / 64.0f);
        const float rstd = rsqrtf(var + 64e-5f);
        const u32x2 ur = *(const u32x2*)(a.sr + (size_t)tl * 512 + ch), uk = *(const u32x2*)(a.sk + (size_t)tl * 512 + ch), uv = *(const u32x2*)(a.sv + (size_t)tl * 512 + ch);
        const f32x4 r4 = (f32x4){bf_lo(ur.x), bf_hi(ur.x), bf_lo(ur.y), bf_hi(ur.y)}, k4 = (f32x4){bf_lo(uk.x), bf_hi(uk.x), bf_lo(uk.y), bf_hi(uk.y)};
        const f32x4 v4 = (f32x4){bf_lo(uv.x), bf_hi(uv.x), bf_lo(uv.y), bf_hi(uv.y)};
        const f32x4 rkv = *(const f32x4*)(a.rk + ch), lw = *(const f32x4*)(a.lnw + ch), lb = *(const f32x4*)(a.lnb + ch);
        const f32x4 t = r4 * k4 * rkv;
        const float bon = dpp_sum16(t.x + t.y + t.z + t.w);
        const u32x2 gu = *(const u32x2*)(a.proj + (size_t)tl * NP + O_GR + ch);
        const f32x4 gg = (f32x4){bf_lo(gu.x), bf_hi(gu.x), bf_lo(gu.y), bf_hi(gu.y)};
        f32x4 o = d * rstd * lw + lb + v4 * bon;
#pragma unroll
        for (int j = 0; j < 4; ++j) o[j] *= siluf_(gg[j]);
        store4(a.ycat + (size_t)tl * 1024 + ch, o);
    }
}


struct CopArgs { const bf16_t *sr, *sk, *sv, *skk, *skka; const bf16_t* se; char* cops; };
__device__ __forceinline__ float mm16(const float* A, float sa, float ia, const float* B, float sb, float ib, int t, int j) {
    float acc = 0.f;
#pragma unroll
    for (int i = 0; i < 16; ++i) { const float av = sa * A[t * 17 + i] + (i == t ? ia : 0.f); const float bv = sb * B[i * 17 + j] + (i == j ? ib : 0.f); acc += av * bv; }
    return acc;
}
__device__ __forceinline__ float mm16p(const float* A, const float* B, int t, int j) {
    float acc = 0.f;
#pragma unroll
    for (int q = 0; q < 4; ++q) {
        const f32x4 a4 = *(const f32x4*)(A + t * 20 + q * 4);
        acc += a4.x * B[(q * 4 + 0) * 20 + j] + a4.y * B[(q * 4 + 1) * 20 + j] + a4.z * B[(q * 4 + 2) * 20 + j] + a4.w * B[(q * 4 + 3) * 20 + j];
    }
    return acc;
}
__device__ __forceinline__ f32x4 mm16m(const float* A, const float* B, int fr, int fq) {
    f32x4 acc = (f32x4){0.f, 0.f, 0.f, 0.f};
#pragma unroll
    for (int m = 0; m < 4; ++m) acc = __builtin_amdgcn_mfma_f32_16x16x4f32(A[fr * 20 + 4 * m + fq], B[(4 * m + fq) * 20 + fr], acc, 0, 0, 0);
    return acc;
}
__device__ __forceinline__ void mm16st(float* D, const f32x4 acc, int fr, int fq, float diag) {
#pragma unroll
    for (int jj = 0; jj < 4; ++jj) D[(4 * fq + jj) * 20 + fr] = acc[jj] + ((4 * fq + jj) == fr ? diag : 0.f);
}
__device__ __forceinline__ f32x4 unpk4(const u32x2 u) { return (f32x4){bf_lo(u.x), bf_hi(u.x), bf_lo(u.y), bf_hi(u.y)}; }
__device__ __forceinline__ bf16_t bf1(float x) { return (bf16_t)(pk_bf16(x, 0.f) & 0xffffu); }
struct CopIn { u32x2 ue, ukk, uka, uk, ur, uv; };
__device__ __forceinline__ void cop_in_load(CopIn& r, const CopArgs& a, int unit, int t, int cq) {
    const int c = unit & 255, bh = unit >> 8;
    const size_t gofs = ((size_t)(bh >> 3) * 4096 + c * 16 + t) * 512 + (bh & 7) * 64 + cq * 4;
    r.ue = *(const u32x2*)(a.se + gofs);
    r.ukk = *(const u32x2*)(a.skk + gofs); r.uka = *(const u32x2*)(a.skka + gofs); r.uk = *(const u32x2*)(a.sk + gofs); r.ur = *(const u32x2*)(a.sr + gofs); r.uv = *(const u32x2*)(a.sv + gofs);
}
__device__ void cop_phase(char* smem, const CopArgs& a) {
    const int tid = otid(), t = tid >> 4, cq = tid & 15, j = cq;
    float* F = (float*)smem;
    float* Wc = F; float* KAP = F + 1088; float* RT = F + 2176; float* KT = F + 3264; float* BT = F + 4352;
    float* SM = F + 5440;
    bf16_t* STG = (bf16_t*)(F + 5440 + 15 * 320);
#define SMAT(i) (SM + (i) * 320)
    int unit = blockIdx.x;
    if (unit >= 8192) return;
    CopIn cur, nxt;
    cop_in_load(cur, a, unit, t, cq);
    nxt = cur;
#pragma unroll 1
    for (; unit < 8192; unit += gridDim.x) {
        if (unit + (int)gridDim.x < 8192) cop_in_load(nxt, a, unit + gridDim.x, t, cq);
        __syncthreads();
        *(f32x4*)(Wc + t * 68 + cq * 4) = unpk4(cur.ue);
        __syncthreads();
        if (tid < 64) {
            float x[16];
#pragma unroll
            for (int i = 0; i < 16; ++i) x[i] = Wc[i * 68 + tid];
#pragma unroll
            for (int i = 1; i < 16; ++i) x[i] += x[i - 1];
#pragma unroll
            for (int i = 0; i < 16; ++i) Wc[i * 68 + tid] = x[i];
        }
        __syncthreads();
        const f32x4 ct = *(const f32x4*)(Wc + t * 68 + cq * 4), cC = *(const f32x4*)(Wc + 15 * 68 + cq * 4);
        f32x4 cp = (f32x4){0.f, 0.f, 0.f, 0.f}; if (t > 0) cp = *(const f32x4*)(Wc + (t - 1) * 68 + cq * 4);
        const f32x4 Wt = (f32x4){__expf(-ct.x), __expf(-ct.y), __expf(-ct.z), __expf(-ct.w)}, Wp = (f32x4){__expf(-cp.x), __expf(-cp.y), __expf(-cp.z), __expf(-cp.w)};
        const f32x4 WC = (f32x4){__expf(-cC.x), __expf(-cC.y), __expf(-cC.z), __expf(-cC.w)};
        {
            const f32x4 rW = (f32x4){__expf(ct.x), __expf(ct.y), __expf(ct.z), __expf(ct.w)};
            *(f32x4*)(KAP + t * 68 + cq * 4) = unpk4(cur.ukk) * Wp;
            *(f32x4*)(RT + t * 68 + cq * 4) = unpk4(cur.ur) * Wt;
            *(f32x4*)(KT + t * 68 + cq * 4) = unpk4(cur.uk) * rW;
            *(f32x4*)(BT + t * 68 + cq * 4) = unpk4(cur.uka) * rW;
        }
        __syncthreads();
        {
            const int wv = tid >> 6, ln = tid & 63, gfr = ln & 15, gfq = ln >> 4;
            const float* X = (wv < 2 ? KAP : RT) + gfr * 68 + gfq * 16;
            const float* Y = ((wv & 1) ? BT : KT) + gfr * 68 + gfq * 16;
            f32x4 acc = (f32x4){0.f, 0.f, 0.f, 0.f};
#pragma unroll
            for (int q = 0; q < 4; ++q) {
                const f32x4 xa = *(const f32x4*)(X + q * 4), ya = *(const f32x4*)(Y + q * 4);
                acc = __builtin_amdgcn_mfma_f32_16x16x4f32(xa.x, ya.x, acc, 0, 0, 0);
                acc = __builtin_amdgcn_mfma_f32_16x16x4f32(xa.y, ya.y, acc, 0, 0, 0);
                acc = __builtin_amdgcn_mfma_f32_16x16x4f32(xa.z, ya.z, acc, 0, 0, 0);
                acc = __builtin_amdgcn_mfma_f32_16x16x4f32(xa.w, ya.w, acc, 0, 0, 0);
            }
#pragma unroll
            for (int jj = 0; jj < 4; ++jj) {
                const int tt = gfq * 4 + jj, jc = gfr;
                const float v = (wv < 2 ? jc < tt : jc <= tt) ? acc[jj] : 0.f;
                SMAT(wv)[tt * 20 + jc] = v;
                if (wv == 1) SMAT(12)[tt * 20 + jc] = (tt == jc ? 1.f : 0.f) - v;
            }
        }
        __syncthreads();
        {
            const int wv = tid >> 6, ln = tid & 63, mfr = ln & 15, mfq = ln >> 4;
            if (wv == 0) { const f32x4 v = mm16m(SMAT(1), SMAT(1), mfr, mfq); mm16st(SMAT(4), v, mfr, mfq, 0.f); mm16st(SMAT(13), v, mfr, mfq, 1.f); }
            __syncthreads();
            if (wv == 0) { const f32x4 v = mm16m(SMAT(4), SMAT(4), mfr, mfq); mm16st(SMAT(5), v, mfr, mfq, 0.f); mm16st(SMAT(14), v, mfr, mfq, 1.f); }
            else if (wv == 1) mm16st(SMAT(7), mm16m(SMAT(12), SMAT(13), mfr, mfq), mfr, mfq, 0.f);
            __syncthreads();
            if (wv == 0) mm16st(SMAT(6), mm16m(SMAT(5), SMAT(5), mfr, mfq), mfr, mfq, 1.f);
            else if (wv == 1) mm16st(SMAT(8), mm16m(SMAT(7), SMAT(14), mfr, mfq), mfr, mfq, 0.f);
            __syncthreads();
            if (wv == 0) mm16st(SMAT(9), mm16m(SMAT(8), SMAT(6), mfr, mfq), mfr, mfq, 0.f);
            __syncthreads();
            if (wv == 0) mm16st(SMAT(10), mm16m(SMAT(9), SMAT(0), mfr, mfq), mfr, mfq, 0.f);
            else if (wv == 1) mm16st(SMAT(11), mm16m(SMAT(3), SMAT(9), mfr, mfq), mfr, mfq, 0.f);
            __syncthreads();
        }
        char* U = a.cops + (size_t)unit * COP_STRIDE;
        if (tid < 64) {
            const int mfr = tid & 15, mfq = tid >> 4; const f32x4 v = mm16m(SMAT(11), SMAT(0), mfr, mfq);
#pragma unroll
            for (int jj = 0; jj < 4; ++jj) ((bf16_t*)(U + 4096))[(4 * mfq + jj) * 16 + mfr] = bf1(SMAT(2)[(4 * mfq + jj) * 20 + mfr] - v[jj]);
        }
        {
            const int wv = tid >> 6, ln = tid & 63, ofr = ln & 15, ofq = ln >> 4, k = wv * 16 + ofr;
            f32x4 a3 = (f32x4){0.f, 0.f, 0.f, 0.f}, a1 = a3, ak = a3;
#pragma unroll
            for (int m = 0; m < 4; ++m) {
                const int i = 4 * m + ofq;
                const float kapv = KAP[i * 68 + k], btv = BT[i * 68 + k];
                a3 = __builtin_amdgcn_mfma_f32_16x16x4f32(SMAT(9)[ofr * 20 + i], kapv, a3, 0, 0, 0);
                a1 = __builtin_amdgcn_mfma_f32_16x16x4f32(SMAT(11)[ofr * 20 + i], kapv, a1, 0, 0, 0);
                ak = __builtin_amdgcn_mfma_f32_16x16x4f32(SMAT(10)[i * 20 + ofr], btv, ak, 0, 0, 0);
            }
            const float wck = __expf(-Wc[15 * 68 + k]);
            const int pk = 32 * (k >> 5) + 8 * ((k >> 2) & 3) + 4 * ((k >> 4) & 1) + (k & 3);
            bf16_t* QST = STG + 3072;
            float bh[4], khv[4];
#pragma unroll
            for (int jj = 0; jj < 4; ++jj) {
                const int tt = 4 * ofq + jj;
                QST[tt * 64 + pk] = bf1(a3[jj]);
                QST[(16 + tt) * 64 + pk] = bf1(RT[tt * 68 + k] - a1[jj]);
                const float btk = BT[tt * 68 + k];
                bh[jj] = btk * wck; khv[jj] = (KT[tt * 68 + k] - ak[jj]) * wck;
            }
            u32x4 wbk; wbk.x = pk_bf16(bh[0], bh[1]); wbk.y = pk_bf16(bh[2], bh[3]); wbk.z = pk_bf16(khv[0], khv[1]); wbk.w = pk_bf16(khv[2], khv[3]);
            *(u32x4*)((char*)STG + (k * 32 + ofq * 8) * 2) = wbk;
        }
        STG[2048 + (cq * 4 + 0) * 16 + t] = (bf16_t)(cur.uv.x & 0xffffu); STG[2048 + (cq * 4 + 1) * 16 + t] = (bf16_t)(cur.uv.x >> 16);
        STG[2048 + (cq * 4 + 2) * 16 + t] = (bf16_t)(cur.uv.y & 0xffffu); STG[2048 + (cq * 4 + 3) * 16 + t] = (bf16_t)(cur.uv.y >> 16);
        if (tid < 64) ((float*)(U + 10752))[tid] = __expf(-Wc[15 * 68 + tid]);
        __syncthreads();
        *(u32x4*)(U + tid * 16) = *(const u32x4*)((const char*)STG + 6144 + tid * 16);
        *(u32x4*)(U + 4608 + tid * 16) = *(const u32x4*)((const char*)STG + tid * 16);
        if (tid < 128) *(u32x4*)(U + 8704 + tid * 16) = *(const u32x4*)((const char*)STG + 4096 + tid * 16);
        cur = nxt;
    }
#undef SMAT
}

__device__ __forceinline__ int cop_lds_of(int q) {
    if (q < 256) { const int row = q >> 3, pos = q & 7; return row * 128 + ((pos ^ ((row >> 1) & 7)) << 4); }
    if (q < 288) return q * 16;
    if (q < 544) { const int q2 = q - 288; return 4608 + (q2 & 3) * 1024 + (q2 >> 2) * 16; }
    return q * 16;
}
struct CopOps { u32x4 qc[2][2]; u32x2 q2; u32x4 bk[4]; u32x2 vt; f32x4 wc[4]; };
__device__ void chunk_scan(char* smem, const char* cops, float* yraw, int bl, int hh) {
    const int tid = otid(), lane = tid & 63, w = tid >> 6, fr = lane & 15, fq = lane >> 4;
    f32x4 st[4];
#pragma unroll
    for (int kt = 0; kt < 4; ++kt) st[kt] = (f32x4){0.f, 0.f, 0.f, 0.f};
    const char* U = cops + (size_t)((bl * 8 + hh) * 256) * COP_STRIDE + tid * 16;
    float* yp = yraw + ((size_t)bl * 4096 + fq * 4) * 512 + hh * 64 + w * 16 + fr;
    const int l0 = cop_lds_of(tid), l1 = cop_lds_of(tid + 256), l2 = cop_lds_of(tid < 176 ? tid + 512 : 0);
    const bool has2 = tid < 176;
    const int qo0 = fr * 128 + (((0 * 4 + fq) ^ ((fr >> 1) & 7)) << 4), qo1 = fr * 128 + (((1 * 4 + fq) ^ ((fr >> 1) & 7)) << 4);
    const int q2o = 4096 + fr * 32 + fq * 8, bko = 4608 + fq * 1024 + fr * 16, vto = 8704 + (w * 16 + fr) * 32 + fq * 8, wco = 10752 + fq * 16;
    u32x4 sA[3], sB[3], sC[3], sD[3];
    __builtin_amdgcn_s_setprio(3);
#define CS_LOAD(S, C) do { const char* g_ = U + (size_t)(C) * COP_STRIDE; S[0] = *(const u32x4*)g_; S[1] = *(const u32x4*)(g_ + 4096); if (has2) S[2] = *(const u32x4*)(g_ + 8192); } while (0)
#define CS_WRITE(S, SLOT) do { char* d_ = smem + (SLOT) * 11008; *(u32x4*)(d_ + l0) = S[0]; *(u32x4*)(d_ + l1) = S[1]; if (has2) *(u32x4*)(d_ + l2) = S[2]; } while (0)
    sA[2] = (u32x4){0u, 0u, 0u, 0u}; sB[2] = sA[2]; sC[2] = sA[2]; sD[2] = sA[2];
    CS_LOAD(sA, 0); CS_LOAD(sB, 1); CS_LOAD(sC, 2); CS_LOAD(sD, 3);
    CopOps R0, R1;
    auto ldsload = [&](CopOps& r, const char* L) {
        r.qc[0][0] = *(const u32x4*)(L + qo0); r.qc[0][1] = *(const u32x4*)(L + qo1); r.qc[1][0] = *(const u32x4*)(L + 2048 + qo0); r.qc[1][1] = *(const u32x4*)(L + 2048 + qo1);
        r.q2 = *(const u32x2*)(L + q2o); r.vt = *(const u32x2*)(L + vto);
#pragma unroll
        for (int kt = 0; kt < 4; ++kt) { r.bk[kt] = *(const u32x4*)(L + bko + kt * 256); r.wc[kt] = *(const f32x4*)(L + wco + kt * 64); }
    };
    auto compute = [&](const int c, const CopOps& r) {
        const u32x4 (&qc)[2][2] = r.qc; const u32x4 (&bk)[4] = r.bk; const f32x4 (&wc)[4] = r.wc; const u32x2 q2 = r.q2, vt = r.vt;
        u32x4 hi[2], lo[2];
#pragma unroll
        for (int s = 0; s < 2; ++s) {
            const f32x4 a0 = st[2 * s], a1 = st[2 * s + 1];
            hi[s].x = pk_bf16(a0.x, a0.y); hi[s].y = pk_bf16(a0.z, a0.w); hi[s].z = pk_bf16(a1.x, a1.y); hi[s].w = pk_bf16(a1.z, a1.w);
            lo[s].x = pk_bf16(a0.x - bf_lo(hi[s].x), a0.y - bf_hi(hi[s].x)); lo[s].y = pk_bf16(a0.z - bf_lo(hi[s].y), a0.w - bf_hi(hi[s].y));
            lo[s].z = pk_bf16(a1.x - bf_lo(hi[s].z), a1.y - bf_hi(hi[s].z)); lo[s].w = pk_bf16(a1.z - bf_lo(hi[s].w), a1.w - bf_hi(hi[s].w));
        }
        f32x4 p1 = (f32x4){0.f, 0.f, 0.f, 0.f}, p2 = p1;
#pragma unroll
        for (int s = 0; s < 2; ++s) {
            p1 = __builtin_amdgcn_mfma_f32_16x16x32_bf16(__builtin_bit_cast(bf16x8, qc[0][s]), __builtin_bit_cast(bf16x8, hi[s]), p1, 0, 0, 0);
            p2 = __builtin_amdgcn_mfma_f32_16x16x32_bf16(__builtin_bit_cast(bf16x8, qc[1][s]), __builtin_bit_cast(bf16x8, hi[s]), p2, 0, 0, 0);
            p1 = __builtin_amdgcn_mfma_f32_16x16x32_bf16(__builtin_bit_cast(bf16x8, qc[0][s]), __builtin_bit_cast(bf16x8, lo[s]), p1, 0, 0, 0);
            p2 = __builtin_amdgcn_mfma_f32_16x16x32_bf16(__builtin_bit_cast(bf16x8, qc[1][s]), __builtin_bit_cast(bf16x8, lo[s]), p2, 0, 0, 0);
        }
        p2 = __builtin_amdgcn_mfma_f32_16x16x32_bf16(__builtin_bit_cast(bf16x8, ((u32x4){q2.x, q2.y, 0u, 0u})), __builtin_bit_cast(bf16x8, ((u32x4){vt.x, vt.y, 0u, 0u})), p2, 0, 0, 0);
#pragma unroll
        for (int j = 0; j < 4; ++j) yp[(size_t)(c * 16 + j) * 512] = p2[j];
        u32x4 xh, xl;
        xh.x = pk_bf16(-p1.x, -p1.y); xh.y = pk_bf16(-p1.z, -p1.w); xh.z = vt.x; xh.w = vt.y;
        xl.x = pk_bf16(-p1.x - bf_lo(xh.x), -p1.y - bf_hi(xh.x)); xl.y = pk_bf16(-p1.z - bf_lo(xh.y), -p1.w - bf_hi(xh.y)); xl.z = 0u; xl.w = 0u;
#pragma unroll
        for (int kt = 0; kt < 4; ++kt) {
            f32x4 acc = st[kt] * wc[kt];
            acc = __builtin_amdgcn_mfma_f32_16x16x32_bf16(__builtin_bit_cast(bf16x8, bk[kt]), __builtin_bit_cast(bf16x8, xh), acc, 0, 0, 0);
            acc = __builtin_amdgcn_mfma_f32_16x16x32_bf16(__builtin_bit_cast(bf16x8, bk[kt]), __builtin_bit_cast(bf16x8, xl), acc, 0, 0, 0);
            st[kt] = acc;
        }
    };
    CS_WRITE(sA, 0); CS_LOAD(sA, 4);
    __syncthreads();
    ldsload(R0, smem);
#define CS_STEP(S, C, RC, RN) do { if ((C) + 1 < 256) CS_WRITE(S, ((C) + 1) & 1); if ((C) + 5 < 256) CS_LOAD(S, (C) + 5); __syncthreads(); \
        if ((C) + 1 < 256) ldsload(RN, smem + (((C) + 1) & 1) * 11008); compute((C), RC); } while (0)
#pragma unroll 1
    for (int c = 0; c < 256; c += 4) { CS_STEP(sB, c, R0, R1); CS_STEP(sC, c + 1, R1, R0); CS_STEP(sD, c + 2, R0, R1); CS_STEP(sA, c + 3, R1, R0); }
#undef CS_STEP
#undef CS_LOAD
#undef CS_WRITE
    __builtin_amdgcn_s_setprio(0);
    __syncthreads();
}

__global__ void __launch_bounds__(256, 2) fwd_megakernel(Params p) {
    __shared__ __attribute__((aligned(16))) char smem[65536 + 64];
    cg::grid_group grid = cg::this_grid();
    if (threadIdx.x == 0) { ((volatile LAS unsigned*)(smem + 65536))[0] = 0u; ((volatile LAS unsigned*)(smem + 65536))[1] = 0u; }
    __syncthreads();
    const XcdBarrier xb = xcd_barrier_post((unsigned*)(p.ws + OFF_BAR), (volatile LAS unsigned*)(smem + 65536));
    const unsigned cu_key = (xb.x & 7u) * 256u + ((unsigned)__builtin_amdgcn_s_getreg((7 << 11) | (8 << 6) | 4) & 0xffu);
    if (threadIdx.x == 0) (void)xb_add((unsigned*)(p.ws + OFF_CUCNT) + cu_key, 1u);
    char* ws = p.ws;
    float* mod = (float*)(ws + OFF_MOD);
    const float* cs = (const float*)(ws + OFF_COS); const float* sn = (const float*)(ws + OFF_SIN);
    bf16_t* hbuf = (bf16_t*)(ws + OFF_H);
    bf16_t* proj = (bf16_t*)(ws + OFF_PROJ);
    bf16_t *sr = (bf16_t*)(ws + OFF_SR), *sk = (bf16_t*)(ws + OFF_SK), *sv = (bf16_t*)(ws + OFF_SV), *skk = (bf16_t*)(ws + OFF_SKK), *skka = (bf16_t*)(ws + OFF_SKKA);
    bf16_t* se = (bf16_t*)(ws + OFF_SW);
    float *rsq = (float*)(ws + OFF_RSQ), *rskv = (float*)(ws + OFF_RSKV);
    bf16_t *Qh = (bf16_t*)(ws + OFF_Q), *Kh = (bf16_t*)(ws + OFF_K), *Vt = (bf16_t*)(ws + OFF_VT);
    float* yraw = (float*)(ws + OFF_YRAW);
    bf16_t* ycat = (bf16_t*)(ws + OFF_YCAT);
    bf16_t* vfirst = (bf16_t*)(ws + OFF_VFIRST);
    int* ctrl = (int*)(ws + OFF_CTRL);
    volatile int* s_item = (volatile int*)(smem + 65536 + 16);

    for (int rep = 0; rep < REP_P0; ++rep) prologue(smem, p);
    grid.sync();
    bool scan_role;
    {
        const unsigned k2 = (cu_key & ~255u) + threadIdx.x;
        const int lidx = __syncthreads_count(k2 < cu_key && xb_ld((unsigned*)(p.ws + OFF_CUCNT) + k2) > 0u);
        scan_role = lidx < 24;
    }

    norm_phase(p.x, p.norm_g, mod, hbuf, 0);
    GSYNC();
#pragma unroll 1
    for (int l = 0; l < NL; ++l) {
        const float* modl = mod + (size_t)l * 8 * 3072;
#pragma unroll 1
        for (int half = 0; half < 2; ++half) {
            const int tgbase = half * TH;
            {
                EpiProj e{proj, rsq, rskv, smem};
                const bf16_t* A = hbuf; const bf16_t* Bt = (const bf16_t*)(ws + OFF_WIN) + (size_t)l * NP * 1024;
                const int xcd = blockIdx.x & 7, loc = blockIdx.x >> 3, nloc = gridDim.x >> 3;
                for (int rep = 0; rep < REP_P2; ++rep) {
                if (rep) xcd_barrier(xb);
                for (int jn = loc; jn < 432; jn += nloc) {
                    const int mg = jn / 216, rem = jn - mg * 216, nt = rem >> 3, mi = rem & 7, mt = xcd * 16 + mg * 8 + mi;
                    gemm_tile(smem, A, 1024, Bt, 1024, 1024, mt * 128, nt * 128, e);
                }
                }
            }
            GSYNC();
            {
                PrepArgs pa;
                pa.proj = proj; pa.mu = p.mu_shift + l * 1664; pa.muv = p.mu_vmix + (l > 0 ? (l - 1) * 32 : 0);
                pa.wdec = (const bf16_t*)(ws + OFF_WDEC) + (size_t)l * 512 * 64; pa.wicl = (const bf16_t*)(ws + OFF_WICL) + (size_t)l * 512 * 64;
                pa.wvm = (const bf16_t*)(ws + OFF_WVM) + (size_t)l * 512 * 32;
                pa.w0 = p.w0 + l * 512; pa.a0 = p.a0 + l * 512; pa.v0 = p.v0 + (l > 0 ? (l - 1) * 512 : 0); pa.k_k = p.k_k + l * 512; pa.k_a = p.k_a + l * 512;
                pa.cs = cs; pa.sn = sn; pa.sr = sr; pa.sk = sk; pa.sv = sv; pa.skk = skk; pa.skka = skka; pa.se = se; pa.vfirst = vfirst; pa.Kh = Kh;
                pa.layer = l; pa.tgbase = tgbase;
                EpiKV ekv{Kh, Vt, rskv, smem};
                EpiQ eq{Qh, rsq, cs, sn, tgbase, smem};
                const bf16_t* Bkv = (const bf16_t*)(ws + OFF_WUKV) + (size_t)l * 1024 * 256; const bf16_t* Bq = (const bf16_t*)(ws + OFF_WUQ) + (size_t)l * 768 * 384;
                for (int rep = 0; rep < REP_P3; ++rep) {
                if (rep) xcd_barrier(xb);
                {
                    for (int it = blockIdx.x; it < 512; it += gridDim.x) prep_tile(smem, pa, it >> 1, it & 1);
                    const int xcd = blockIdx.x & 7, loc = blockIdx.x >> 3, nloc = gridDim.x >> 3;
                    for (int j = loc; j < 128; j += nloc) gemm_tile(smem, proj + O_CKV, NP, Bkv, 256, 256, (xcd * 16 + (j >> 3)) * 128, (j & 7) * 128, ekv);
                    for (int j = loc; j < 96; j += nloc) { const int ml = j / 6, nt = j - ml * 6; gemm_tile(smem, proj + O_CQ, NP, Bq, 384, 384, (xcd * 16 + ml) * 128, nt * 128, eq); }
                }
                }
            }
            GSYNC();
            {
                CopArgs ca{sr, sk, sv, skk, skka, se, ws + OFF_COPS};
                cop_phase(smem, ca);
            }
            GSYNC();
            {
                int* ctr = ctrl + (l * 2 + half);
                for (;;) {
                    __syncthreads();
                    if (threadIdx.x == 0) *s_item = atomicAdd(ctr, 1);
                    __syncthreads();
                    const int item = *s_item;
                    const int nconv = (half == 0 && l + 1 < NL) ? 512 : 0;
                    if (item >= 32 + 1024 + nconv) break;
                    if (item < 32) chunk_scan(smem, ws + OFF_COPS, yraw, item >> 3, item & 7);
                    else if (item < 32 + 1024) { const int t = item - 32, qt = 31 - (t >> 5), bh = t & 31; attn_tile(smem, Qh, Kh, Vt, proj, ycat, bh >> 3, bh & 7, qt); }
                    else convert_layer(smem, p, l + 1, item - (32 + 1024), 512);
                }
            }
            GSYNC();
            {
                FinArgs fa{yraw, sr, sk, sv, proj, p.lnx_w + l * 512, p.lnx_b + l * 512, p.r_k + l * 512, ycat, nullptr, nullptr};
                for (int rep = 0; rep < REP_P5; ++rep) { if (rep) xcd_barrier(xb); rwkv_finalize(fa); }
                const int ln = half == 0 ? l : l + 1, hn = half ^ 1;
                if (ln < NL) norm_phase(ln == 0 ? p.x : p.out, p.norm_g + ln * 1024, mod + (size_t)ln * 8 * 3072, hbuf, hn * TH);
            }
            GSYNC();
            {
                for (int rep = 0; rep < REP_P6; ++rep) {
                if (rep) xcd_barrier(xb);
                EpiOut eo{l == 0 ? p.x : p.out, p.out, modl, tgbase, rep == REP_P6 - 1 ? 1.0f : 0.0f};
                const bf16_t* Bo = (const bf16_t*)(ws + OFF_WOUT) + (size_t)l * 1024 * 1024;
                {
                    const int xcd = blockIdx.x & 7, loc = blockIdx.x >> 3, nloc = gridDim.x >> 3;
                    for (int j = loc; j < 128; j += nloc) gemm_tile(smem, ycat, 1024, Bo, 1024, 1024, (xcd * 16 + (j >> 3)) * 128, (j & 7) * 128, eo);
                }
                }
            }
        }
    }
    GSYNC();
    final_norm(p.out, p.final_g);
}

extern "C" void kernel_launch(void* const* d_in, const int* in_sizes, int n_in, void* d_out, int out_size, void* d_ws, size_t ws_size, hipStream_t stream) {
    static int grid_blocks = 0;
    if (!grid_blocks) {
        int dev = 0, cus = 0, per_cu = 0;
        (void)hipGetDevice(&dev);
        (void)hipDeviceGetAttribute(&cus, hipDeviceAttributeMultiprocessorCount, dev);
        (void)hipOccupancyMaxActiveBlocksPerMultiprocessor(&per_cu, fwd_megakernel, 256, 0);
        if (per_cu > 2) per_cu = 2;
        if (per_cu < 1) per_cu = 1;
        grid_blocks = cus * per_cu;
        if (grid_blocks % 8) grid_blocks -= grid_blocks % 8;
    }
    Params p{};
    p.x = (const float*)d_in[0]; p.c = (const float*)d_in[1]; p.pos = (const int*)d_in[2];
    p.norm_g = (const float*)d_in[3]; p.w_ada = (const float*)d_in[4]; p.b_ada = (const float*)d_in[5]; p.w_in = (const float*)d_in[6];
    p.w_vmd = (const float*)d_in[7]; p.mu_shift = (const float*)d_in[8]; p.mu_vmix = (const float*)d_in[9]; p.w0 = (const float*)d_in[10];
    p.w_dec = (const float*)d_in[11]; p.a0 = (const float*)d_in[12]; p.w_icl = (const float*)d_in[13]; p.v0 = (const float*)d_in[14];
    p.w_vmu = (const float*)d_in[15]; p.k_k = (const float*)d_in[16]; p.k_a = (const float*)d_in[17]; p.r_k = (const float*)d_in[18];
    p.lnx_w = (const float*)d_in[19]; p.lnx_b = (const float*)d_in[20]; p.qng = (const float*)d_in[21]; p.kvng = (const float*)d_in[22];
    p.w_uq = (const float*)d_in[23]; p.w_ukv = (const float*)d_in[24]; p.w_out = (const float*)d_in[25]; p.final_g = (const float*)d_in[26];
    p.out = (float*)d_out; p.ws = (char*)d_ws;
    (void)hipMemsetAsync((char*)d_ws + OFF_BAR, 0, 16384 + 4096 + 8192, stream);
    void* args[] = {&p};
    hipError_t e = hipLaunchCooperativeKernel((void*)fwd_megakernel, dim3(grid_blocks), dim3(256), args, 0, stream);
    if (e != hipSuccess) fprintf(stderr, "cooperative launch failed: %s (grid %d)\n", hipGetErrorString(e), grid_blocks);
}
```
